# Optimizing an MI355X kernel written in HIP

```python
import math
import jax, jax.numpy as jnp
from jax import lax
import numpy as np


D_MODEL = 1024
BATCH = 8
SEQ = 8192
DEPTH = 1

PLE_DIM = 256
D_FF = 2816
RWKV_HEADS = 8
RWKV_HEAD_DIM = 64
RWKV_WIDTH = RWKV_HEADS * RWKV_HEAD_DIM
DECAY_LORA = 64
AAA_LORA = 64
GATE_LORA = 128
RWKV_GN_EPS = 64e-5
DECAY_SCALE = math.exp(-0.5)
RET_HEADS = 4
RET_QK_DIM = 128
RET_V_DIM = 256
RET_QK_WIDTH = RET_HEADS * RET_QK_DIM
RET_V_WIDTH = RET_HEADS * RET_V_DIM
RET_CHUNK = 128
ROPE_BASE = 10000.0
RWKV_IN = 3 * RWKV_WIDTH + DECAY_LORA + AAA_LORA + GATE_LORA
RET_IN = 2 * RET_QK_WIDTH + 2 * RET_V_WIDTH
GATE_IN = 2 * D_MODEL
MIX_IN = RWKV_IN + RET_IN + GATE_IN
DN_ALPHA = (2 * DEPTH) ** 0.25
DN_BETA = (8 * DEPTH) ** -0.25
LN_EPS = 1e-5

kernel_name = "hybrid_rwkv7_retention_macaron_deepnorm"


def layer_norm(x, g, b, eps=LN_EPS):
    xf = x.astype(jnp.float32)
    mu = jnp.mean(xf, -1, keepdims=True)
    var = jnp.mean(jnp.square(xf - mu), -1, keepdims=True)
    return ((xf - mu) * lax.rsqrt(var + eps) * g + b).astype(x.dtype)


def head_norm(y, eps):
    mu = jnp.mean(y, -1, keepdims=True)
    var = jnp.mean(jnp.square(y - mu), -1, keepdims=True)
    return (y - mu) * lax.rsqrt(var + eps)


def swiglu(x, w_in, w_out):
    gate, up = jnp.split(x @ w_in, 2, axis=-1)
    return (jax.nn.silu(gate) * up) @ w_out


def token_shift(z):
    return jnp.pad(z[:, :-1], ((0, 0), (1, 0), (0, 0)))


def rwkv_step(state, inp):
    r_t, w_t, k_t, v_t, kk_t, a_t = inp
    sa = jnp.einsum('bhvk,bhk->bhv', state, kk_t)
    state = (state * w_t[:, :, None, :]
             - sa[..., None] * (kk_t * a_t)[:, :, None, :]
             + v_t[..., None] * k_t[:, :, None, :])
    return state, jnp.einsum('bhvk,bhk->bhv', state, r_t)


def rwkv7_mix(z, mu, w0, w_up, a0, a_up, g_up, k_k, k_a, r_k, gn_g, gn_b):
    B, S, _ = z.shape
    H, N, W = RWKV_HEADS, RWKV_HEAD_DIM, RWKV_WIDTH
    f32 = jnp.float32
    z = z + (token_shift(z) - z) * mu
    r, k, v, dw, da, dg = jnp.split(
        z, [W, 2 * W, 3 * W, 3 * W + DECAY_LORA, 3 * W + DECAY_LORA + AAA_LORA], axis=-1)
    log_w = -DECAY_SCALE * jax.nn.sigmoid((w0 + jnp.tanh(dw) @ w_up).astype(f32))
    a = jax.nn.sigmoid((a0 + da @ a_up).astype(f32))
    g = (jax.nn.sigmoid(dg) @ g_up).astype(f32)
    kk = (k * k_k).astype(f32).reshape(B, S, H, N)
    kk = kk * lax.rsqrt(jnp.maximum(jnp.sum(jnp.square(kk), -1, keepdims=True), 1e-24))
    k = (k.astype(f32) * (1.0 + (a - 1.0) * k_a)).reshape(B, S, H, N)
    r = r.astype(f32).reshape(B, S, H, N)
    v = v.astype(f32).reshape(B, S, H, N)
    a = a.reshape(B, S, H, N)
    w = jnp.exp(log_w).reshape(B, S, H, N)
    tm = lambda t: jnp.moveaxis(t, 1, 0)
    state0 = jnp.zeros((B, H, N, N), f32)
    _, y = lax.scan(rwkv_step, state0, (tm(r), tm(w), tm(k), tm(v), tm(kk), tm(a)))
    y = jnp.moveaxis(y, 0, 1)
    y = head_norm(y, RWKV_GN_EPS).reshape(B, S, W) * gn_g + gn_b
    bonus = jnp.sum(r * k * r_k, -1, keepdims=True) * v
    y = y + bonus.reshape(B, S, W)
    return (y * g).astype(z.dtype)


def rotary(x, positions):
    half = x.shape[-1] // 2
    inv_freq = ROPE_BASE ** (-jnp.arange(half, dtype=jnp.float32) / half)
    ang = positions.astype(jnp.float32)[..., None] * inv_freq
    cos = jnp.cos(ang)[:, :, None, :]
    sin = jnp.sin(ang)[:, :, None, :]
    x1, x2 = x[..., :half], x[..., half:]
    return jnp.concatenate([x1 * cos - x2 * sin, x2 * cos + x1 * sin], -1)


def retention_mix(z, positions):
    B, S, _ = z.shape
    H, Dk, Dv, C = RET_HEADS, RET_QK_DIM, RET_V_DIM, RET_CHUNK
    nC = S // C
    f32 = jnp.float32
    q, k, v, g = jnp.split(z, [RET_QK_WIDTH, 2 * RET_QK_WIDTH, 2 * RET_QK_WIDTH + RET_V_WIDTH], axis=-1)
    q = rotary(q.astype(f32).reshape(B, S, H, Dk), positions)
    k = rotary(k.astype(f32).reshape(B, S, H, Dk), positions) * (Dk ** -0.5)
    v = v.astype(f32).reshape(B, S, H, Dv)
    log_gamma = jnp.log(1.0 - jnp.exp2(-5.0 - jnp.arange(H, dtype=f32)))
    idx = jnp.arange(C, dtype=f32)
    rel = idx[:, None] - idx[None, :]
    decay_mask = jnp.where(rel >= 0, jnp.exp(log_gamma[:, None, None] * jnp.maximum(rel, 0.0)), 0.0)
    xi = jnp.exp(log_gamma[:, None] * (idx + 1.0))
    zeta = jnp.exp(log_gamma[:, None] * (C - 1.0 - idx))
    chunk_decay = jnp.exp(log_gamma * C)

    def to_chunks(t):
        return t.reshape(B, nC, C, H, t.shape[-1]).transpose(1, 0, 3, 2, 4)

    def step(R, qkv):
        qc, kc, vc = qkv
        scores = jnp.einsum('bhnd,bhmd->bhnm', qc, kc) * decay_mask
        inner = jnp.einsum('bhnm,bhme->bhne', scores, vc)
        cross = jnp.einsum('bhnd,bhde->bhne', qc, R) * xi[None, :, :, None]
        R = R * chunk_decay[None, :, None, None] + jnp.einsum('bhmd,bhme->bhde', kc * zeta[None, :, :, None], vc)
        return R, inner + cross

    R0 = jnp.zeros((B, H, Dk, Dv), f32)
    _, y = lax.scan(step, R0, (to_chunks(q), to_chunks(k), to_chunks(v)))
    y = y.transpose(1, 0, 3, 2, 4).reshape(B, S, H, Dv)
    y = head_norm(y, LN_EPS).reshape(B, S, RET_V_WIDTH)
    return (jax.nn.silu(g.astype(f32)) * y).astype(z.dtype)


def hybrid_mix(h, positions, w_in, mu, w0, w_up, a0, a_up, g_up, k_k, k_a, r_k, gn_g, gn_b,
               w_branch_rwkv, w_branch_ret, w_out):
    z = h @ w_in
    z_rwkv, z_ret, z_gate = jnp.split(z, [RWKV_IN, RWKV_IN + RET_IN], axis=-1)
    y_rwkv = rwkv7_mix(z_rwkv, mu, w0, w_up, a0, a_up, g_up, k_k, k_a, r_k, gn_g, gn_b) @ w_branch_rwkv
    y_ret = retention_mix(z_ret, positions) @ w_branch_ret
    gate_rwkv, gate_ret = jnp.split(jax.nn.sigmoid(z_gate), 2, axis=-1)
    return (gate_rwkv * y_rwkv + gate_ret * y_ret) @ w_out


def setup_inputs(seed: int = 0) -> dict:
    key = jax.random.key(seed)
    ks = iter(jax.random.split(key, 40))
    f32 = jnp.float32
    nrm = lambda shape, s: jax.random.normal(next(ks), shape, f32) * s
    L, D, F = DEPTH, D_MODEL, D_FF
    x = nrm((BATCH, SEQ, D), 1.0)
    p = nrm((DEPTH, BATCH, SEQ, PLE_DIM), 1.0)
    start = jax.random.randint(next(ks), (BATCH, 1), 0, 4096, dtype=jnp.int32)
    positions = (start + jnp.arange(SEQ, dtype=jnp.int32)[None, :]).astype(jnp.int32)
    return {
        "x": x,
        "p": p,
        "positions": positions,
        "ln1_g": 1.0 + nrm((L, D), 0.1),
        "ln1_b": nrm((L, D), 0.01),
        "ffn1_w_in": nrm((L, D, 2 * F), D ** -0.5),
        "ffn1_w_out": nrm((L, F, D), F ** -0.5 * DN_BETA),
        "w_mix_in": nrm((L, D, MIX_IN), D ** -0.5),
        "rwkv_mu": jax.random.uniform(next(ks), (L, RWKV_IN), f32),
        "rwkv_w0": nrm((L, RWKV_WIDTH), 1.0),
        "rwkv_w_up": nrm((L, DECAY_LORA, RWKV_WIDTH), 0.5 * DECAY_LORA ** -0.5),
        "rwkv_a0": nrm((L, RWKV_WIDTH), 0.5),
        "rwkv_a_up": nrm((L, AAA_LORA, RWKV_WIDTH), 0.5 * AAA_LORA ** -0.5),
        "rwkv_g_up": nrm((L, GATE_LORA, RWKV_WIDTH), GATE_LORA ** -0.5),
        "rwkv_k_k": 0.85 + nrm((L, RWKV_WIDTH), 0.1),
        "rwkv_k_a": 1.0 + nrm((L, RWKV_WIDTH), 0.1),
        "rwkv_r_k": nrm((L, RWKV_HEADS, RWKV_HEAD_DIM), 0.1),
        "rwkv_gn_g": 1.0 + nrm((L, RWKV_WIDTH), 0.1),
        "rwkv_gn_b": nrm((L, RWKV_WIDTH), 0.01),
        "w_branch_rwkv": nrm((L, RWKV_WIDTH, D), RWKV_WIDTH ** -0.5),
        "w_branch_ret": nrm((L, RET_V_WIDTH, D), RET_V_WIDTH ** -0.5),
        "w_mix_out": nrm((L, D, D), D ** -0.5 * DN_BETA),
        "ln2_g": 1.0 + nrm((L, D), 0.1),
        "ln2_b": nrm((L, D), 0.01),
        "ffn2_w_in": nrm((L, D, 2 * F), D ** -0.5),
        "ffn2_w_out": nrm((L, F, D), F ** -0.5 * DN_BETA),
        "ln3_g": 1.0 + nrm((L, D), 0.1),
        "ln3_b": nrm((L, D), 0.01),
        "ple_w_proj": nrm((L, PLE_DIM, D), PLE_DIM ** -0.5),
        "ple_w_gate": nrm((L, D, D), D ** -0.5),
    }


def reference(x, p, positions, ln1_g, ln1_b, ffn1_w_in, ffn1_w_out, w_mix_in, rwkv_mu, rwkv_w0, rwkv_w_up,
              rwkv_a0, rwkv_a_up, rwkv_g_up, rwkv_k_k, rwkv_k_a, rwkv_r_k, rwkv_gn_g, rwkv_gn_b,
              w_branch_rwkv, w_branch_ret, w_mix_out, ln2_g, ln2_b, ffn2_w_in, ffn2_w_out, ln3_g, ln3_b,
              ple_w_proj, ple_w_gate):
    h = x
    for i in range(DEPTH):
        h = layer_norm(DN_ALPHA * h + 0.5 * swiglu(h, ffn1_w_in[i], ffn1_w_out[i]), ln1_g[i], ln1_b[i])
        mix = hybrid_mix(h, positions, w_mix_in[i], rwkv_mu[i], rwkv_w0[i], rwkv_w_up[i], rwkv_a0[i],
                         rwkv_a_up[i], rwkv_g_up[i], rwkv_k_k[i], rwkv_k_a[i], rwkv_r_k[i], rwkv_gn_g[i],
                         rwkv_gn_b[i], w_branch_rwkv[i], w_branch_ret[i], w_mix_out[i])
        h = layer_norm(DN_ALPHA * h + mix, ln2_g[i], ln2_b[i])
        h = layer_norm(DN_ALPHA * h + 0.5 * swiglu(h, ffn2_w_in[i], ffn2_w_out[i]), ln3_g[i], ln3_b[i])
        h = h + jax.nn.sigmoid(h @ ple_w_gate[i]) * (p[i] @ ple_w_proj[i])
    return h
```

```cpp
#include <hip/hip_runtime.h>
#include <hip/hip_cooperative_groups.h>
#include <cstdio>
namespace cg = cooperative_groups;

#define LAS __attribute__((address_space(3)))
typedef unsigned short u16;
typedef short bf16x8 __attribute__((ext_vector_type(8)));
typedef float f32x4 __attribute__((ext_vector_type(4)));
typedef float f32x2 __attribute__((ext_vector_type(2)));
typedef unsigned u32x4 __attribute__((ext_vector_type(4)));
typedef unsigned u32x2 __attribute__((ext_vector_type(2)));
typedef _Float16 h16x4 __attribute__((ext_vector_type(4)));
typedef _Float16 h16x8 __attribute__((ext_vector_type(8)));

constexpr int MTOK = 65536, DM = 1024, FF = 2816, SEQ = 8192, MIXN = 6912;
constexpr float DN_ALPHA = 1.189207115f;
constexpr float LN_EPS = 1e-5f;
constexpr float DECAY_SCALE = 0.60653066f;

constexpr size_t MiB = 1ull << 20;
constexpr size_t O_W1T = 0;
constexpr size_t O_W2T = O_W1T + 5632ull * 1024 * 2;
constexpr size_t O_WMT = O_W2T + 1024ull * 2816 * 2;
constexpr size_t O_W3T = O_WMT + 6912ull * 1024 * 2;
constexpr size_t O_W4T = O_W3T + 5632ull * 1024 * 2;
constexpr size_t O_WLT = O_W4T + 1024ull * 2816 * 2;
constexpr size_t O_WBR = O_WLT + 1536ull * 256 * 2;
constexpr size_t O_WBT = O_WBR + 1024ull * 512 * 2;
constexpr size_t O_WMO = O_WBT + 1024ull * 1024 * 2;
constexpr size_t O_WGT = O_WMO + 1024ull * 1024 * 2;
constexpr size_t O_WPT = O_WGT + 1024ull * 1024 * 2;
static_assert(O_WPT + 1024ull * 256 * 2 <= 64 * MiB, "weights");
constexpr size_t O_BAR = 60 * MiB;
constexpr size_t O_CS = 64 * MiB;
constexpr size_t O_PB = 96 * MiB;
constexpr size_t O_H = 128 * MiB;
constexpr size_t O_XB = 256 * MiB;
constexpr size_t O_HID = 384 * MiB;
constexpr size_t O_ALORA = 256 * MiB;
constexpr size_t O_WBUF = 608 * MiB;
constexpr size_t O_ABUF = 672 * MiB;
constexpr size_t O_GBUF = 736 * MiB;
constexpr size_t O_YRAW = 288 * MiB;
constexpr size_t O_Y = 832 * MiB;
constexpr size_t O_QROT = 256 * MiB;
constexpr size_t O_KROT = 320 * MiB;
constexpr size_t O_KTZ = 384 * MiB;
constexpr size_t O_VT = 448 * MiB;
constexpr size_t O_GSILU = 576 * MiB;
constexpr size_t O_RT = 704 * MiB;
constexpr size_t O_TMP = 256 * MiB;
constexpr size_t O_MERGED = 512 * MiB;
constexpr size_t O_PPROJ = 384 * MiB;
constexpr size_t O_PRE = 256 * MiB;
constexpr size_t WS_NEED = 1024 * MiB;
static_assert(O_ABUF == O_WBUF + 64 * MiB && O_GBUF == O_ABUF + 64 * MiB, "EpiLora addresses W/A/G by stride");

struct Params { const float* in[30]; float* out; unsigned char* ws; };

__device__ __forceinline__ float bf2f(u16 v) { return __uint_as_float((unsigned)v << 16); }
__device__ __forceinline__ float bflo(unsigned v) { return __uint_as_float(v << 16); }
__device__ __forceinline__ float bfhi(unsigned v) { return __uint_as_float(v & 0xffff0000u); }
__device__ __forceinline__ f32x4 ld_bf4(const u16* p) { const u32x2 t = *(const u32x2*)p; return (f32x4){bflo(t.x), bfhi(t.x), bflo(t.y), bfhi(t.y)}; }
__device__ __forceinline__ unsigned cvt_pk_bf16(float lo, float hi) { unsigned r; asm volatile("v_cvt_pk_bf16_f32 %0, %1, %2" : "=v"(r) : "v"(lo), "v"(hi)); return r; }
__device__ __forceinline__ float sigm(float x) { return __builtin_amdgcn_rcpf(1.f + __builtin_amdgcn_exp2f(-1.44269504f * x)); }
__device__ __forceinline__ float siluf(float x) { return x * sigm(x); }
#define DPP_ADD(x, ctrl) ((x) + __builtin_bit_cast(float, __builtin_amdgcn_update_dpp(0, __builtin_bit_cast(int, (x)), (ctrl), 0xF, 0xF, true)))
__device__ __forceinline__ float red16(float x) {
    x = DPP_ADD(x, 0xB1); x = DPP_ADD(x, 0x4E); x = DPP_ADD(x, 0x141); x = DPP_ADD(x, 0x140); return x;
}
__device__ __forceinline__ float wave_sum(float v) {
#pragma unroll
    for (int o = 1; o < 64; o <<= 1) v += __shfl_xor(v, o);
    return v;
}

namespace pg8 {
constexpr int BM = 256, BK = 64, HALF = 128, HTB = HALF * BK * 2, STAGE_BYTES = 8 * HTB, NXCD = 8, WGM = 8;
__device__ __forceinline__ int lds_byte(int r, int c) { const int st = (r >> 4) * 2 + (c >> 5), rr = r & 15, cc = c & 31, ob = rr * 64 + cc * 2; return st * 1024 + (ob ^ (((ob >> 9) & 1) << 5)); }
__device__ __forceinline__ void stage_rc(int b, int& R, int& C) { const int st = b / 1024, sb = b % 1024, swz = sb ^ (((sb >> 9) & 1) << 5); R = (st >> 1) * 16 + swz / 64; C = (st & 1) * 32 + (swz % 64) / 2; }
__device__ __forceinline__ int perm32(int rho) { const int n = rho >> 4, i = rho & 15; return 8 * (i >> 2) + 4 * n + (i & 3); }
struct Unit { int pm, pn, part; };
struct Gemm { const u16* A; const u16* Bt; int lda, ldb, K; };
struct StaticOrder {
    int nM, nN, nwg, G, c;
    __device__ void init(int M, int N, int G_, int c_) { nM = M / BM; nN = N / BM; nwg = nM * nN; G = G_; c = c_; }
    __device__ bool next(int i, Unit& u) const {
        const long L = (long)i * G + c; if (L >= nwg) return false;
        int wgid = (int)L; { const int q = nwg / NXCD, r = nwg % NXCD, xcd = wgid % NXCD, off = wgid / NXCD; wgid = (xcd < r ? xcd * (q + 1) : r * (q + 1) + (xcd - r) * q) + off; }
        const int nig = WGM * nN, gid = wgid / nig, fm = gid * WGM, gsz = (nM - fm) < WGM ? (nM - fm) : WGM;
        u.pm = fm + ((wgid % nig) % gsz); u.pn = (wgid % nig) / gsz; return true;
    }
};

template <class Epi, bool SPLIT = false>
__device__ __forceinline__ void gemm_phase(LAS unsigned char* lds, const Gemm g, const StaticOrder& S, const Epi& E, int splitK = 0) {
    int tid_ = threadIdx.x; asm volatile("" : "+v"(tid_));
    const int tid = tid_, wid = __builtin_amdgcn_readfirstlane(tid >> 6), lane = tid & 63, wr = wid >> 2, wc = wid & 3, fr = lane & 15, fq = lane >> 4;
    int K_ = g.K, lda_ = g.lda, ldb_ = g.ldb; asm volatile("" : "+s"(K_), "+s"(lda_), "+s"(ldb_));
    const int K = K_;
    int nt = SPLIT ? splitK / BK : K / BK;
    unsigned voffA[2], voffB[2];
#pragma unroll
    for (int i = 0; i < 2; ++i) { int R, C; stage_rc(tid * 16 + i * 8192, R, C); const int Rb = Epi::PERM ? ((R & ~31) + perm32(R & 31)) : R;
        voffA[i] = (unsigned)(R * lda_ + C) * 2u; voffB[i] = (unsigned)(Rb * ldb_ + C) * 2u; }
    const size_t kstep = (size_t)(BK * 2);
    const size_t hstepA = (size_t)HALF * lda_ * 2, hstepB = (size_t)HALF * ldb_ * 2;
    const size_t tstepA = 2 * hstepA, tstepB = 2 * hstepB;
    const unsigned ldsw = (unsigned)wid * 1024u;
    const int aoff = lds_byte(wr * 64 + fr, fq * 8), boff = lds_byte(wc * 32 + fr, fq * 8);
#define PG8_SA(b, h) (((b) * 2 + (h)) * HTB)
#define PG8_SB(b, h) ((4 + (b) * 2 + (h)) * HTB)
#define PG8_STAGE(bufoff, gbase, voff) do { _Pragma("unroll") for (int _i = 0; _i < 2; ++_i) \
        __builtin_amdgcn_global_load_lds((const unsigned*)((const char*)(gbase) + (voff)[_i]), (LAS unsigned*)(lds + (bufoff) + ldsw + _i * 8192), 16, 0, 0); } while (0)
#define PG8_LDA(dst, b, h) do { _Pragma("unroll") for (int m = 0; m < 4; ++m) _Pragma("unroll") for (int k = 0; k < 2; ++k) dst[m][k] = *(const LAS bf16x8*)(lds + PG8_SA(b, h) + aoff + m * 2048 + k * 1024); } while (0)
#define PG8_LDB(dst, b, h) do { _Pragma("unroll") for (int n = 0; n < 2; ++n) _Pragma("unroll") for (int k = 0; k < 2; ++k) dst[n][k] = *(const LAS bf16x8*)(lds + PG8_SB(b, h) + boff + n * 2048 + k * 1024); } while (0)
#define PG8_MMA(ai, bj, At, Bt) do { __builtin_amdgcn_s_setprio(1); _Pragma("unroll") for (int m = 0; m < 4; ++m) _Pragma("unroll") for (int n = 0; n < 2; ++n) _Pragma("unroll") for (int k = 0; k < 2; ++k) \
        acc[ai][bj][m][n] = __builtin_amdgcn_mfma_f32_16x16x32_bf16(Bt[n][k], At[m][k], acc[ai][bj][m][n], 0, 0, 0); __builtin_amdgcn_s_setprio(0); } while (0)
#define PG8_WAIT_V(n) asm volatile("s_waitcnt vmcnt(" #n ")" ::: "memory")
#define PG8_WAIT_L(n) asm volatile("s_waitcnt lgkmcnt(" #n ")" ::: "memory")
#define PG8_BAR __builtin_amdgcn_s_barrier()
#define PG8_SCHED __builtin_amdgcn_sched_barrier(0)
    Unit cur, nxt; int ui = 0;
    cur.part = 0; nxt.part = 0;
    if (!S.next(0, cur)) return;
    f32x4 acc[2][2][4][2];
#pragma unroll
    for (int a = 0; a < 2; ++a)
#pragma unroll
        for (int b = 0; b < 2; ++b)
#pragma unroll
            for (int m = 0; m < 4; ++m)
#pragma unroll
                for (int n = 0; n < 2; ++n) acc[a][b][m][n] = (f32x4){0.f, 0.f, 0.f, 0.f};
    bf16x8 At[4][2], B0[2][2], B1[2][2];
    const char* cA = (const char*)g.A + (size_t)cur.pm * tstepA; const char* cB = (const char*)g.Bt + (size_t)cur.pn * tstepB;
    const size_t poff = (size_t)splitK * 2;
    PG8_STAGE(PG8_SB(0, 0), cB, voffB); PG8_STAGE(PG8_SA(0, 0), cA, voffA); PG8_STAGE(PG8_SB(0, 1), cB + hstepB, voffB); PG8_STAGE(PG8_SA(0, 1), cA + hstepA, voffA);
    if (wr == 1) PG8_BAR;
    PG8_WAIT_V(4); PG8_BAR;
    PG8_STAGE(PG8_SB(1, 0), cB + kstep, voffB); PG8_STAGE(PG8_SA(1, 0), cA + kstep, voffA); PG8_STAGE(PG8_SB(1, 1), cB + hstepB + kstep, voffB);
    PG8_WAIT_V(6); PG8_BAR;
    for (;;) {
        bool has_next;
        if constexpr (SPLIT) { has_next = S.next((ui + 1) >> 1, nxt); nxt.part = (ui + 1) & 1; } else has_next = S.next(ui + 1, nxt);
        const char* nA = has_next ? (const char*)g.A + (size_t)nxt.pm * tstepA + (SPLIT && nxt.part ? poff : 0) : cA;
        const char* nB = has_next ? (const char*)g.Bt + (size_t)nxt.pn * tstepB + (SPLIT && nxt.part ? poff : 0) : cB;
        for (int t = 0; t < nt; t += 2) {
            const bool last = (t == nt - 2);
            const char* a1 = cA + (size_t)(t + 1) * kstep;
            const char* a2 = last ? nA : cA + (size_t)(t + 2) * kstep; const char* b2 = last ? nB : cB + (size_t)(t + 2) * kstep;
            const char* a3 = a2 + kstep; const char* b3 = b2 + kstep;
            PG8_LDB(B0, 0, 0); PG8_SCHED; PG8_LDA(At, 0, 0); PG8_STAGE(PG8_SA(1, 1), a1 + hstepA, voffA);
            PG8_WAIT_L(8); PG8_BAR; PG8_WAIT_L(0); PG8_MMA(0, 0, At, B0); PG8_BAR; PG8_SCHED;
            PG8_LDB(B1, 0, 1); PG8_STAGE(PG8_SB(0, 0), b2, voffB);
            PG8_BAR; PG8_WAIT_L(0); PG8_MMA(0, 1, At, B1); PG8_BAR;
            PG8_LDA(At, 0, 1); PG8_STAGE(PG8_SA(0, 0), a2, voffA);
            PG8_BAR; PG8_WAIT_L(0); PG8_MMA(1, 0, At, B0); PG8_BAR; PG8_SCHED;
            PG8_STAGE(PG8_SB(0, 1), b2 + hstepB, voffB);
            PG8_WAIT_V(6); PG8_BAR; PG8_MMA(1, 1, At, B1); PG8_BAR;
            PG8_LDB(B0, 1, 0); PG8_SCHED; PG8_LDA(At, 1, 0); PG8_STAGE(PG8_SA(0, 1), a2 + hstepA, voffA);
            PG8_WAIT_L(8); PG8_BAR; PG8_WAIT_L(0); PG8_MMA(0, 0, At, B0); PG8_BAR; PG8_SCHED;
            PG8_LDB(B1, 1, 1); PG8_STAGE(PG8_SB(1, 0), b3, voffB);
            PG8_BAR; PG8_WAIT_L(0); PG8_MMA(0, 1, At, B1); PG8_BAR;
            PG8_LDA(At, 1, 1); PG8_STAGE(PG8_SA(1, 0), a3, voffA);
            PG8_BAR; PG8_WAIT_L(0); PG8_MMA(1, 0, At, B0); PG8_BAR; PG8_SCHED;
            PG8_STAGE(PG8_SB(1, 1), b3 + hstepB, voffB);
            PG8_WAIT_V(6); PG8_BAR; PG8_MMA(1, 1, At, B1); PG8_BAR;
        }
        E(acc, cur, wr, wc, fr, fq);
        if (!has_next) break;
        if (!SPLIT || cur.part == 1) {
#pragma unroll
            for (int a = 0; a < 2; ++a)
#pragma unroll
                for (int b = 0; b < 2; ++b)
#pragma unroll
                    for (int m = 0; m < 4; ++m)
#pragma unroll
                        for (int n = 0; n < 2; ++n) acc[a][b][m][n] = (f32x4){0.f, 0.f, 0.f, 0.f};
        }
        cur = nxt; cA = nA; cB = nB; ++ui;
        if constexpr (SPLIT) nt = cur.part ? (K - splitK) / BK : splitK / BK;
    }
    PG8_WAIT_V(0);
    if (wr == 0) PG8_BAR;
    PG8_BAR;
#undef PG8_SA
#undef PG8_SB
#undef PG8_STAGE
#undef PG8_LDA
#undef PG8_LDB
#undef PG8_MMA
#undef PG8_WAIT_V
#undef PG8_WAIT_L
#undef PG8_BAR
#undef PG8_SCHED
}
}
using pg8::Unit;
typedef f32x4 AccT[2][2][4][2];

struct EpiFfnIn {
    static constexpr bool PERM = true;
    u16* hid;
    __device__ __forceinline__ void operator()(const AccT& acc, const Unit& u, int wr, int wc, int fr, int fq) const {
        const int row0 = u.pm * 256 + wr * 64 + fr, col0 = u.pn * 128 + wc * 32 + 8 * fq;
#pragma unroll
        for (int ai = 0; ai < 2; ++ai)
#pragma unroll
            for (int m = 0; m < 4; ++m) {
                u16* rowp = hid + (size_t)(row0 + ai * 128 + m * 16) * FF + col0;
                const f32x4 g0 = acc[ai][0][m][0], g1 = acc[ai][0][m][1], u0 = acc[ai][1][m][0], u1 = acc[ai][1][m][1];
                u32x4 w;
                w.x = cvt_pk_bf16(siluf(g0[0]) * u0[0], siluf(g0[1]) * u0[1]); w.y = cvt_pk_bf16(siluf(g0[2]) * u0[2], siluf(g0[3]) * u0[3]);
                w.z = cvt_pk_bf16(siluf(g1[0]) * u1[0], siluf(g1[1]) * u1[1]); w.w = cvt_pk_bf16(siluf(g1[2]) * u1[2], siluf(g1[3]) * u1[3]);
                *(u32x4*)rowp = w;
            }
    }
};
struct EpiRes {
    static constexpr bool PERM = false;
    u16* pre; const float* resf; const u16* resb; float alpha, scale;
    __device__ __forceinline__ void operator()(const AccT& acc, const Unit& u, int wr, int wc, int fr, int fq) const {
        const int row0 = u.pm * 256 + wr * 64 + fr, col0 = u.pn * 256 + wc * 32 + 4 * fq;
#pragma unroll
        for (int ai = 0; ai < 2; ++ai)
#pragma unroll
            for (int m = 0; m < 4; ++m) {
                const size_t off = (size_t)(row0 + ai * 128 + m * 16) * DM + col0;
#pragma unroll
                for (int bj = 0; bj < 2; ++bj)
#pragma unroll
                    for (int n = 0; n < 2; ++n) {
                        f32x4 r;
                        if (resf) r = *(const f32x4*)(resf + off + bj * 128 + n * 16);
                        else r = ld_bf4(resb + off + bj * 128 + n * 16);
                        const f32x4 o = r * alpha + acc[ai][bj][m][n] * scale;
                        u32x2 w; w.x = cvt_pk_bf16(o[0], o[1]); w.y = cvt_pk_bf16(o[2], o[3]);
                        *(u32x2*)(pre + off + bj * 128 + n * 16) = w;
                    }
                asm volatile("" ::: "memory");
            }
    }
};
struct EpiMix {
    static constexpr bool PERM = true;
    int pn0; u16* zr; u16* qrot; u16* krot; u16* ktz; u16* vt; u16* gsilu; u16* gate; const f32x2* cs;
    __device__ __forceinline__ void operator()(const AccT& acc, const Unit& u, int wr, int wc, int fr, int fq) const {
        const int T = pn0 + u.pn;
        const int row0 = u.pm * 256 + wr * 64 + fr, c8 = wc * 32 + 8 * fq;
        if (T < 7 || T >= 15) {
            u16* base; int ld, colt, act;
            if (T < 7) { base = zr; ld = 1792; colt = T * 256; act = 0; }
            else if (T < 19) { base = gsilu; ld = 1024; colt = (T - 15) * 256; act = 1; }
            else { base = gate; ld = 2048; colt = (T - 19) * 256; act = 2; }
#pragma unroll
            for (int ai = 0; ai < 2; ++ai)
#pragma unroll
                for (int m = 0; m < 4; ++m) {
                    u16* rowp = base + (size_t)(row0 + ai * 128 + m * 16) * ld + colt + c8;
#pragma unroll
                    for (int bj = 0; bj < 2; ++bj) {
                        f32x4 v0 = acc[ai][bj][m][0], v1 = acc[ai][bj][m][1];
                        if (act == 1) {
#pragma unroll
                            for (int j = 0; j < 4; ++j) { v0[j] = siluf(v0[j]); v1[j] = siluf(v1[j]); }
                        } else if (act == 2) {
#pragma unroll
                            for (int j = 0; j < 4; ++j) { v0[j] = sigm(v0[j]); v1[j] = sigm(v1[j]); }
                        }
                        u32x4 w; w.x = cvt_pk_bf16(v0[0], v0[1]); w.y = cvt_pk_bf16(v0[2], v0[3]); w.z = cvt_pk_bf16(v1[0], v1[1]); w.w = cvt_pk_bf16(v1[2], v1[3]);
                        *(u32x4*)(rowp + bj * 128) = w;
                    }
                    asm volatile("" ::: "memory");
                }
        } else if (T < 11) {
            const bool isk = T >= 9; const int t = isk ? T - 9 : T - 7;
            const int head = 2 * t + (wc >> 1), idx0 = 32 * (wc & 1) + 8 * fq;
            const float sc = isk ? 0.08838834764831845f : 1.0f;
            const float l2g = __log2f(1.0f - __builtin_amdgcn_exp2f((float)(-5 - head)));
#pragma unroll
            for (int ai = 0; ai < 2; ++ai)
#pragma unroll
                for (int m = 0; m < 4; ++m) {
                    const int row = row0 + ai * 128 + m * 16;
                    const f32x4* cp = (const f32x4*)(cs + (size_t)row * 64 + idx0);
                    float o1[8], o2[8];
#pragma unroll
                    for (int q = 0; q < 4; ++q) {
                        const f32x4 c2 = cp[q];
                        const int n = q >> 1, j = (q & 1) * 2;
                        const float xa = acc[ai][0][m][n][j], xb = acc[ai][1][m][n][j], ya = acc[ai][0][m][n][j + 1], yb = acc[ai][1][m][n][j + 1];
                        o1[2 * q] = (xa * c2[0] - xb * c2[1]) * sc; o2[2 * q] = (xb * c2[0] + xa * c2[1]) * sc;
                        o1[2 * q + 1] = (ya * c2[2] - yb * c2[3]) * sc; o2[2 * q + 1] = (yb * c2[2] + ya * c2[3]) * sc;
                    }
                    u16* np = (isk ? krot : qrot) + (size_t)row * 512 + head * 128 + idx0;
                    u32x4 w; w.x = cvt_pk_bf16(o1[0], o1[1]); w.y = cvt_pk_bf16(o1[2], o1[3]); w.z = cvt_pk_bf16(o1[4], o1[5]); w.w = cvt_pk_bf16(o1[6], o1[7]);
                    *(u32x4*)np = w;
                    w.x = cvt_pk_bf16(o2[0], o2[1]); w.y = cvt_pk_bf16(o2[2], o2[3]); w.z = cvt_pk_bf16(o2[4], o2[5]); w.w = cvt_pk_bf16(o2[6], o2[7]);
                    *(u32x4*)(np + 64) = w;
                    if (isk) {
                        const int b = row >> 13, s = row & 8191, chunk = s >> 7, mm = s & 127;
                        const float zeta = __builtin_amdgcn_exp2f(l2g * (float)(127 - mm));
                        u16* tp = ktz + ((size_t)((b * 4 + head) * 64 + chunk) * 128 + idx0) * 128 + mm;
#pragma unroll
                        for (int i = 0; i < 8; ++i) {
                            tp[(size_t)i * 128] = (u16)(cvt_pk_bf16(o1[i] * zeta, 0.f) & 0xffffu);
                            tp[(size_t)(64 + i) * 128] = (u16)(cvt_pk_bf16(o2[i] * zeta, 0.f) & 0xffffu);
                        }
                    }
                    asm volatile("" ::: "memory");
                }
        } else {
            const int head = T - 11;
#pragma unroll
            for (int ai = 0; ai < 2; ++ai)
#pragma unroll
                for (int m = 0; m < 4; ++m) {
                    const int row = row0 + ai * 128 + m * 16;
                    const int b = row >> 13, s = row & 8191, chunk = s >> 7, mm = s & 127;
                    u16* tp = vt + ((size_t)((b * 4 + head) * 64 + chunk) * 256 + c8) * 128 + mm;
#pragma unroll
                    for (int bj = 0; bj < 2; ++bj)
#pragma unroll
                        for (int n = 0; n < 2; ++n)
#pragma unroll
                            for (int j = 0; j < 4; ++j)
                                tp[(size_t)(bj * 128 + 4 * n + j) * 128] = (u16)(cvt_pk_bf16(acc[ai][bj][m][n][j], 0.f) & 0xffffu);
                    asm volatile("" ::: "memory");
                }
        }
    }
};
struct EpiLora {
    static constexpr bool PERM = true;
    _Float16* wbuf; _Float16* abuf; _Float16* gbuf; const float* w0; const float* a0;
    __device__ __forceinline__ void operator()(const AccT& acc, const Unit& u, int wr, int wc, int fr, int fq) const {
        const int kind = u.pn >> 1;
        const int row0 = u.pm * 256 + wr * 64 + fr, ch0 = (u.pn & 1) * 256 + wc * 32 + 8 * fq;
        _Float16* dst = wbuf + (size_t)kind * (size_t)(32u << 20);
        const float* bias = kind == 0 ? w0 : a0;
#pragma unroll
        for (int bj = 0; bj < 2; ++bj) {
            const int ch = ch0 + bj * 128;
            f32x4 b0 = {0.f, 0.f, 0.f, 0.f}, b1 = b0;
            if (kind < 2) { b0 = *(const f32x4*)(bias + ch); b1 = *(const f32x4*)(bias + ch + 4); }
#pragma unroll
            for (int ai = 0; ai < 2; ++ai)
#pragma unroll
                for (int m = 0; m < 4; ++m) {
                    const int row = row0 + ai * 128 + m * 16;
                    f32x4 v0 = acc[ai][bj][m][0] + b0, v1 = acc[ai][bj][m][1] + b1;
                    if (kind < 2) {
#pragma unroll
                        for (int j = 0; j < 4; ++j) { v0[j] = sigm(v0[j]); v1[j] = sigm(v1[j]); }
                    }
                    if (kind == 0) {
#pragma unroll
                        for (int j = 0; j < 4; ++j) { v0[j] = __builtin_amdgcn_exp2f(-DECAY_SCALE * 1.44269504f * v0[j]); v1[j] = __builtin_amdgcn_exp2f(-DECAY_SCALE * 1.44269504f * v1[j]); }
                    }
                    *(h16x8*)(dst + (size_t)row * 512 + ch) = (h16x8){(_Float16)v0[0], (_Float16)v0[1], (_Float16)v0[2], (_Float16)v0[3], (_Float16)v1[0], (_Float16)v1[1], (_Float16)v1[2], (_Float16)v1[3]};
                    asm volatile("" ::: "memory"); __builtin_amdgcn_sched_barrier(0);
                }
        }
    }
};
struct EpiBr {
    static constexpr bool PERM = true;
    const u16* gate; u16* merged;
    __device__ __forceinline__ void operator()(AccT& acc, const Unit& u, int wr, int wc, int fr, int fq) const {
        if (u.part == 0) scale(acc, u, wr, wc, fr, fq); else store(acc, u, wr, wc, fr, fq);
    }
    __device__ __forceinline__ void scale(AccT& acc, const Unit& u, int wr, int wc, int fr, int fq) const {
        const int row0 = u.pm * 256 + wr * 64 + fr, col0 = u.pn * 256 + wc * 32 + 8 * fq;
#pragma unroll
        for (int ai = 0; ai < 2; ++ai)
#pragma unroll
            for (int m = 0; m < 4; ++m) {
                const int row = row0 + ai * 128 + m * 16;
#pragma unroll
                for (int bj = 0; bj < 2; ++bj) {
                    const int c = col0 + bj * 128;
                    const u32x4 g1 = *(const u32x4*)(gate + (size_t)row * 2048 + c), g2 = *(const u32x4*)(gate + (size_t)row * 2048 + 1024 + c);
                    f32x4 r0, r1;
                    r0[0] = bflo(g1.x) * __builtin_amdgcn_rcpf(bflo(g2.x)); r0[1] = bfhi(g1.x) * __builtin_amdgcn_rcpf(bfhi(g2.x));
                    r0[2] = bflo(g1.y) * __builtin_amdgcn_rcpf(bflo(g2.y)); r0[3] = bfhi(g1.y) * __builtin_amdgcn_rcpf(bfhi(g2.y));
                    r1[0] = bflo(g1.z) * __builtin_amdgcn_rcpf(bflo(g2.z)); r1[1] = bfhi(g1.z) * __builtin_amdgcn_rcpf(bfhi(g2.z));
                    r1[2] = bflo(g1.w) * __builtin_amdgcn_rcpf(bflo(g2.w)); r1[3] = bfhi(g1.w) * __builtin_amdgcn_rcpf(bfhi(g2.w));
                    acc[ai][bj][m][0] = acc[ai][bj][m][0] * r0; acc[ai][bj][m][1] = acc[ai][bj][m][1] * r1;
                    asm volatile("" ::: "memory"); __builtin_amdgcn_sched_barrier(0);
                }
            }
    }
    __device__ __forceinline__ void store(const AccT& acc, const Unit& u, int wr, int wc, int fr, int fq) const {
        const int row0 = u.pm * 256 + wr * 64 + fr, col0 = u.pn * 256 + wc * 32 + 8 * fq;
#pragma unroll
        for (int ai = 0; ai < 2; ++ai)
#pragma unroll
            for (int m = 0; m < 4; ++m) {
                const int row = row0 + ai * 128 + m * 16;
#pragma unroll
                for (int bj = 0; bj < 2; ++bj) {
                    const int c = col0 + bj * 128;
                    const u32x4 gv = *(const u32x4*)(gate + (size_t)row * 2048 + 1024 + c);
                    const f32x4 g0 = {bflo(gv.x), bfhi(gv.x), bflo(gv.y), bfhi(gv.y)}, g1 = {bflo(gv.z), bfhi(gv.z), bflo(gv.w), bfhi(gv.w)};
                    const f32x4 v0 = g0 * acc[ai][bj][m][0], v1 = g1 * acc[ai][bj][m][1];
                    u32x4 w; w.x = cvt_pk_bf16(v0[0], v0[1]); w.y = cvt_pk_bf16(v0[2], v0[3]); w.z = cvt_pk_bf16(v1[0], v1[1]); w.w = cvt_pk_bf16(v1[2], v1[3]);
                    *(u32x4*)(merged + (size_t)row * DM + c) = w;
                }
                asm volatile("" ::: "memory");
            }
    }
};
struct EpiFin {
    static constexpr bool PERM = false;
    int mode; float* out; u16* pproj;
    __device__ __forceinline__ void operator()(const AccT& acc, const Unit& u, int wr, int wc, int fr, int fq) const {
        const int row0 = u.pm * 256 + wr * 64 + fr, col0 = u.pn * 256 + wc * 32 + 4 * fq;
#pragma unroll
        for (int ai = 0; ai < 2; ++ai)
#pragma unroll
            for (int m = 0; m < 4; ++m) {
                const size_t off = (size_t)(row0 + ai * 128 + m * 16) * DM + col0;
#pragma unroll
                for (int bj = 0; bj < 2; ++bj)
#pragma unroll
                    for (int n = 0; n < 2; ++n) {
                        const size_t o = off + bj * 128 + n * 16;
                        const f32x4 a = acc[ai][bj][m][n];
                        if (mode == 0) { u32x2 w; w.x = cvt_pk_bf16(a[0], a[1]); w.y = cvt_pk_bf16(a[2], a[3]); *(u32x2*)(pproj + o) = w; }
                        else {
                            const f32x4 pp = ld_bf4(pproj + o), h = *(const f32x4*)(out + o);
                            f32x4 r; r[0] = h[0] + sigm(a[0]) * pp[0]; r[1] = h[1] + sigm(a[1]) * pp[1]; r[2] = h[2] + sigm(a[2]) * pp[2]; r[3] = h[3] + sigm(a[3]) * pp[3];
                            *(f32x4*)(out + o) = r;
                        }
                    }
                asm volatile("" ::: "memory");
            }
    }
};

__device__ __forceinline__ int map_row(int mode, int n) {
    if (mode == 1) { const int bj = n >= FF ? 1 : 0, cc = n - bj * FF; return (cc >> 7) * 256 + bj * 128 + (cc & 127); }
    if (mode == 2) {
        if (n < 1792 || n >= 2816) return n;
        const int base = n < 2304 ? 1792 : 2304, c = n - base, head = c >> 7, half = (c >> 6) & 1, idx = c & 63;
        return base + 256 * (head >> 1) + 128 * half + 64 * (head & 1) + idx;
    }
    return n;
}
__device__ __forceinline__ void conv_weight(const float* W, int K, int N, u16* dst, int mode, size_t gtid, size_t gth, int ldk = 0) {
    if (ldk == 0) ldk = K;
    const size_t total = (size_t)N * (K >> 3);
    for (size_t idx = gtid; idx < total; idx += gth) {
        const int n = (int)(idx % N), kc = (int)(idx / N);
        const float* s = W + (size_t)(kc * 8) * N + n;
        float v[8];
#pragma unroll
        for (int i = 0; i < 8; ++i) v[i] = s[(size_t)i * N];
        u32x4 w; w.x = cvt_pk_bf16(v[0], v[1]); w.y = cvt_pk_bf16(v[2], v[3]); w.z = cvt_pk_bf16(v[4], v[5]); w.w = cvt_pk_bf16(v[6], v[7]);
        *(u32x4*)(dst + (size_t)map_row(mode, n) * ldk + kc * 8) = w;
    }
}
__device__ __forceinline__ void conv_rows(const float* __restrict__ src, u16* __restrict__ dst, size_t n8, size_t gtid, size_t gth) {
    for (size_t i = gtid; i < n8; i += 4 * gth) {
        f32x4 a[4], b[4];
#pragma unroll
        for (int u = 0; u < 4; ++u) { const size_t j = i + u * gth; if (j < n8) { a[u] = *(const f32x4*)(src + j * 8); b[u] = *(const f32x4*)(src + j * 8 + 4); } }
#pragma unroll
        for (int u = 0; u < 4; ++u) { const size_t j = i + u * gth; if (j < n8) {
            u32x4 w; w.x = cvt_pk_bf16(a[u][0], a[u][1]); w.y = cvt_pk_bf16(a[u][2], a[u][3]); w.z = cvt_pk_bf16(b[u][0], b[u][1]); w.w = cvt_pk_bf16(b[u][2], b[u][3]);
            *(u32x4*)(dst + j * 8) = w; } }
    }
}
__device__ __forceinline__ void phase_convert(const Params& P, size_t gtid, size_t gth) {
    unsigned char* ws = P.ws;
    conv_rows(P.in[0], (u16*)(ws + O_XB), (size_t)MTOK * DM / 8, gtid, gth);
    conv_rows(P.in[1], (u16*)(ws + O_PB), (size_t)MTOK * 256 / 8, gtid, gth);
    conv_weight(P.in[5], DM, 2 * FF, (u16*)(ws + O_W1T), 1, gtid, gth);
    conv_weight(P.in[6], FF, DM, (u16*)(ws + O_W2T), 0, gtid, gth);
    conv_weight(P.in[7], DM, MIXN, (u16*)(ws + O_WMT), 2, gtid, gth);
    conv_weight(P.in[24], DM, 2 * FF, (u16*)(ws + O_W3T), 1, gtid, gth);
    conv_weight(P.in[25], FF, DM, (u16*)(ws + O_W4T), 0, gtid, gth);
    conv_weight(P.in[19], 512, DM, (u16*)(ws + O_WBR), 0, gtid, gth, 1536);
    conv_weight(P.in[20], DM, DM, (u16*)(ws + O_WBR) + 512, 0, gtid, gth, 1536);
    conv_weight(P.in[21], DM, DM, (u16*)(ws + O_WMO), 0, gtid, gth);
    conv_weight(P.in[29], DM, DM, (u16*)(ws + O_WGT), 0, gtid, gth);
    conv_weight(P.in[28], 256, DM, (u16*)(ws + O_WPT), 0, gtid, gth);
    {
        u16* dst = (u16*)(ws + O_WLT);
        for (size_t idx = gtid; idx < 1536 * 32; idx += gth) {
            const int n = (int)(idx % 1536), kc = (int)(idx / 1536), k0 = kc * 8;
            float v[8];
#pragma unroll
            for (int i = 0; i < 8; ++i) v[i] = 0.f;
            if (n < 512) { if (k0 < 64) {
#pragma unroll
                for (int i = 0; i < 8; ++i) v[i] = P.in[10][(size_t)(k0 + i) * 512 + n]; } }
            else if (n < 1024) { if (k0 >= 64 && k0 < 128) {
#pragma unroll
                for (int i = 0; i < 8; ++i) v[i] = P.in[12][(size_t)(k0 - 64 + i) * 512 + (n - 512)]; } }
            else { if (k0 >= 128) {
#pragma unroll
                for (int i = 0; i < 8; ++i) v[i] = P.in[13][(size_t)(k0 - 128 + i) * 512 + (n - 1024)]; } }
            u32x4 w; w.x = cvt_pk_bf16(v[0], v[1]); w.y = cvt_pk_bf16(v[2], v[3]); w.z = cvt_pk_bf16(v[4], v[5]); w.w = cvt_pk_bf16(v[6], v[7]);
            *(u32x4*)(dst + (size_t)n * 256 + k0) = w;
        }
    }
    {
        f32x2* cs = (f32x2*)(ws + O_CS); const int* pos = (const int*)P.in[2];
        for (size_t idx = gtid; idx < (size_t)MTOK * 64; idx += gth) {
            const int tok = (int)(idx >> 6), i = (int)(idx & 63);
            const float invf = exp2f(-(float)i * (13.287712379549449f / 64.0f));
            const float ang = (float)pos[tok] * invf;
            const double a = (double)ang; const double kq = rint(a * 0.6366197723675814); const float r = (float)(a - kq * 1.5707963267948966);
            const int q = (int)((long long)kq & 3);
            const float r2 = r * r;
            const float sn = r + r * r2 * (-1.6666667e-1f + r2 * (8.3333333e-3f + r2 * (-1.9841270e-4f + r2 * 2.7557319e-6f)));
            const float cn = 1.0f + r2 * (-0.5f + r2 * (4.1666668e-2f + r2 * (-1.3888889e-3f + r2 * (2.4801587e-5f - r2 * 2.7557319e-7f))));
            float c, s;
            if (q == 0) { c = cn; s = sn; } else if (q == 1) { c = -sn; s = cn; } else if (q == 2) { c = -cn; s = -sn; } else { c = sn; s = -cn; }
            cs[idx] = (f32x2){c, s};
        }
    }
}

__device__ __forceinline__ void phase_ln(const u16* pre, const float* g, const float* b, u16* hb, float* hf, int gw, int ngw, int lane) {
    f32x4 gv[4], bv[4];
#pragma unroll
    for (int j = 0; j < 4; ++j) { gv[j] = *(const f32x4*)(g + 4 * lane + 256 * j); bv[j] = *(const f32x4*)(b + 4 * lane + 256 * j); }
    for (int row = gw; row < MTOK; row += 2 * ngw) {
        const int row2 = row + ngw;
        const u16* xr = pre + (size_t)row * DM + 4 * lane; const u16* xr2 = pre + (size_t)row2 * DM + 4 * lane;
        f32x4 v[4], v2[4]; float s = 0.f, t = 0.f;
#pragma unroll
        for (int j = 0; j < 4; ++j) { v[j] = ld_bf4(xr + 256 * j); v2[j] = ld_bf4(xr2 + 256 * j); }
#pragma unroll
        for (int j = 0; j < 4; ++j) { s += (v[j][0] + v[j][1]) + (v[j][2] + v[j][3]); t += (v2[j][0] + v2[j][1]) + (v2[j][2] + v2[j][3]); }
        const float mean = wave_sum(s) * (1.f / DM), mean2 = wave_sum(t) * (1.f / DM); float s2 = 0.f, t2 = 0.f;
#pragma unroll
        for (int j = 0; j < 4; ++j) { v[j] = v[j] - mean; s2 += (v[j][0] * v[j][0] + v[j][1] * v[j][1]) + (v[j][2] * v[j][2] + v[j][3] * v[j][3]);
                                      v2[j] = v2[j] - mean2; t2 += (v2[j][0] * v2[j][0] + v2[j][1] * v2[j][1]) + (v2[j][2] * v2[j][2] + v2[j][3] * v2[j][3]); }
        const float rstd = 1.0f / sqrtf(wave_sum(s2) * (1.f / DM) + LN_EPS), rstd2 = 1.0f / sqrtf(wave_sum(t2) * (1.f / DM) + LN_EPS);
#pragma unroll
        for (int j = 0; j < 4; ++j) {
            const f32x4 o = v[j] * rstd * gv[j] + bv[j], o2 = v2[j] * rstd2 * gv[j] + bv[j];
            u32x2 w; w.x = cvt_pk_bf16(o[0], o[1]); w.y = cvt_pk_bf16(o[2], o[3]);
            *(u32x2*)(hb + (size_t)row * DM + 4 * lane + 256 * j) = w;
            w.x = cvt_pk_bf16(o2[0], o2[1]); w.y = cvt_pk_bf16(o2[2], o2[3]);
            *(u32x2*)(hb + (size_t)row2 * DM + 4 * lane + 256 * j) = w;
            if (hf) { *(f32x4*)(hf + (size_t)row * DM + 4 * lane + 256 * j) = o; *(f32x4*)(hf + (size_t)row2 * DM + 4 * lane + 256 * j) = o2; }
        }
    }
}

__device__ __forceinline__ void phase_lora_prep(const u16* __restrict__ zr, const float* __restrict__ mu, u16* __restrict__ alora, size_t gtid, size_t gth) {
    const int c = (int)(gtid & 31) * 8;
    const f32x4 m0 = *(const f32x4*)(mu + 1536 + c), m1 = *(const f32x4*)(mu + 1536 + c + 4);
    for (size_t idx = gtid; idx < (size_t)MTOK * 32; idx += 4 * gth) {
        u32x4 z[4], zp[4];
#pragma unroll
        for (int u = 0; u < 4; ++u) {
            const int tok = (int)((idx + u * gth) >> 5);
            z[u] = *(const u32x4*)(zr + (size_t)tok * 1792 + 1536 + c);
            zp[u] = ((tok & (SEQ - 1)) != 0) ? *(const u32x4*)(zr + (size_t)(tok - 1) * 1792 + 1536 + c) : (u32x4){0u, 0u, 0u, 0u};
        }
#pragma unroll
        for (int u = 0; u < 4; ++u) {
            const int tok = (int)((idx + u * gth) >> 5);
            const f32x4 a0 = {bflo(z[u].x), bfhi(z[u].x), bflo(z[u].y), bfhi(z[u].y)}, a1 = {bflo(z[u].z), bfhi(z[u].z), bflo(z[u].w), bfhi(z[u].w)};
            const f32x4 p0 = {bflo(zp[u].x), bfhi(zp[u].x), bflo(zp[u].y), bfhi(zp[u].y)}, p1 = {bflo(zp[u].z), bfhi(zp[u].z), bflo(zp[u].w), bfhi(zp[u].w)};
            f32x4 v0 = a0 + (p0 - a0) * m0, v1 = a1 + (p1 - a1) * m1;
            if (c < 64) {
#pragma unroll
                for (int j = 0; j < 4; ++j) { v0[j] = 2.f * sigm(2.f * v0[j]) - 1.f; v1[j] = 2.f * sigm(2.f * v1[j]) - 1.f; }
            } else if (c >= 128) {
#pragma unroll
                for (int j = 0; j < 4; ++j) { v0[j] = sigm(v0[j]); v1[j] = sigm(v1[j]); }
            }
            u32x4 w; w.x = cvt_pk_bf16(v0[0], v0[1]); w.y = cvt_pk_bf16(v0[2], v0[3]); w.z = cvt_pk_bf16(v1[0], v1[1]); w.w = cvt_pk_bf16(v1[2], v1[3]);
            *(u32x4*)(alora + (size_t)tok * 256 + c) = w;
        }
    }
}
struct RwkvConst { f32x4 mur, muk, muv, kk_, ka_; };
__device__ __forceinline__ RwkvConst rwkv_const(const float* mu, const float* k_k, const float* k_a, int ch) {
    RwkvConst c; c.mur = *(const f32x4*)(mu + ch); c.muk = *(const f32x4*)(mu + 512 + ch); c.muv = *(const f32x4*)(mu + 1024 + ch); c.kk_ = *(const f32x4*)(k_k + ch); c.ka_ = *(const f32x4*)(k_a + ch); return c;
}
typedef _Float16 h16x2 __attribute__((ext_vector_type(2)));
__device__ __forceinline__ h16x4 pk4h(const f32x4 x) {
    const h16x2 a = __builtin_bit_cast(h16x2, __builtin_amdgcn_cvt_pkrtz(x[0], x[1])), b = __builtin_bit_cast(h16x2, __builtin_amdgcn_cvt_pkrtz(x[2], x[3]));
    return (h16x4){a[0], a[1], b[0], b[1]};
}
struct RwkvRaw { u32x2 zr_, zk_, zv_, pr_, pk_, pv_; h16x4 ah; };
__device__ __forceinline__ f32x4 bf4(const u32x2 t) { return (f32x4){bflo(t.x), bfhi(t.x), bflo(t.y), bfhi(t.y)}; }
__device__ __forceinline__ RwkvRaw rwkv_load(const u16* zr, const _Float16* abuf, int tok, int ch) {
    const bool first = (tok & (SEQ - 1)) == 0;
    const u16* zt = zr + (size_t)tok * 1792 + ch; const u16* zq = first ? zt : zt - 1792;
    RwkvRaw w; w.zr_ = *(const u32x2*)zt; w.zk_ = *(const u32x2*)(zt + 512); w.zv_ = *(const u32x2*)(zt + 1024);
    w.pr_ = *(const u32x2*)zq; w.pk_ = *(const u32x2*)(zq + 512); w.pv_ = *(const u32x2*)(zq + 1024);
    w.ah = *(const h16x4*)(abuf + (size_t)tok * 512 + ch);
    return w;
}
__device__ __forceinline__ void rwkv_compute(const RwkvRaw& w, int tok, const RwkvConst& c, f32x4& r, f32x4& kh, f32x4& v, f32x4& kk, f32x4& bb) {
    const bool first = (tok & (SEQ - 1)) == 0;
    r = bf4(w.zr_); f32x4 k = bf4(w.zk_); v = bf4(w.zv_);
    f32x4 rp = bf4(w.pr_), kp = bf4(w.pk_), vp = bf4(w.pv_);
    if (first) { rp = (f32x4){0.f, 0.f, 0.f, 0.f}; kp = rp; vp = rp; }
    r = r + (rp - r) * c.mur; k = k + (kp - k) * c.muk; v = v + (vp - v) * c.muv;
    const f32x4 a = {(float)w.ah[0], (float)w.ah[1], (float)w.ah[2], (float)w.ah[3]};
    kk = k * c.kk_;
    const float ss = red16((kk[0] * kk[0] + kk[1] * kk[1]) + (kk[2] * kk[2] + kk[3] * kk[3]));
    kk = kk * __builtin_amdgcn_rsqf(fmaxf(ss, 1e-24f));
    kh = k * (1.0f + (a - 1.0f) * c.ka_); bb = kk * a;
}
__device__ __forceinline__ void rwkv_prep(const u16* zr, const _Float16* abuf, int tok, int ch, const RwkvConst& c, f32x4& r, f32x4& kh, f32x4& v, f32x4& kk, f32x4& bb) {
    const RwkvRaw w = rwkv_load(zr, abuf, tok, ch); rwkv_compute(w, tok, c, r, kh, v, kk, bb);
}
__device__ __forceinline__ void scan_load(const u16* zr, const _Float16* wbuf, const _Float16* abuf, int tok0, int pst, int pch, int c, RwkvRaw (&raw)[2], h16x4 (&wv)[2]) {
#pragma unroll
    for (int half = 0; half < 2; ++half) {
        const int tok = tok0 + c * 32 + pst + 16 * half;
        raw[half] = rwkv_load(zr, abuf, tok, pch);
        wv[half] = *(const h16x4*)(wbuf + (size_t)tok * 512 + pch);
    }
}
__device__ __forceinline__ void scan_write(LAS _Float16* lds, const RwkvConst& rc, int tok0, int pst, int pks, int c, int bufi, const RwkvRaw (&raw)[2], const h16x4 (&wv)[2]) {
    LAS _Float16* bp = lds + bufi * (32 * 384);
#pragma unroll
    for (int half = 0; half < 2; ++half) {
        const int st = pst + 16 * half, tok = tok0 + c * 32 + st;
        f32x4 r, kh, v, kk, bb; rwkv_compute(raw[half], tok, rc, r, kh, v, kk, bb);
        LAS _Float16* sp = bp + st * 384 + 4 * pks;
        *(LAS h16x4*)(sp) = wv[half];
        *(LAS h16x4*)(sp + 64) = pk4h(kk);
        *(LAS h16x4*)(sp + 128) = pk4h(bb);
        *(LAS h16x4*)(sp + 192) = pk4h(kh);
        *(LAS h16x4*)(sp + 256) = pk4h(r);
        *(LAS h16x4*)(sp + 320) = pk4h(v);
    }
}
__device__ __forceinline__ float fmix_lo(float a, unsigned h, float c) { float d; asm("v_fma_mix_f32 %0, %1, %2, %3 op_sel_hi:[0,1,0]" : "=v"(d) : "v"(a), "v"(h), "v"(c)); return d; }
__device__ __forceinline__ float fmix_hi(float a, unsigned h, float c) { float d; asm("v_fma_mix_f32 %0, %1, %2, %3 op_sel:[0,1,0] op_sel_hi:[0,1,0]" : "=v"(d) : "v"(a), "v"(h), "v"(c)); return d; }
__device__ __forceinline__ float fmix2_lo(unsigned a, unsigned h, float c) { float d; asm("v_fma_mix_f32 %0, %1, %2, %3 op_sel_hi:[1,1,0]" : "=v"(d) : "v"(a), "v"(h), "v"(c)); return d; }
__device__ __forceinline__ float fmix2_hi(unsigned a, unsigned h, float c) { float d; asm("v_fma_mix_f32 %0, %1, %2, %3 op_sel:[0,1,0] op_sel_hi:[1,1,0]" : "=v"(d) : "v"(a), "v"(h), "v"(c)); return d; }
__device__ __forceinline__ void scan_step_asm(float& s0, float& s1, float& s2, float& s3, float& q0, float& q1,
                                              unsigned kkx, unsigned kky, unsigned wx, unsigned wy, unsigned khx, unsigned khy, unsigned bbx, unsigned bby, unsigned rx, unsigned ry, unsigned v) {
    float p0, p1, u0, u1, u2, u3;
    asm("v_fma_mix_f32 %[p0], %[s0], %[kkx], 0 op_sel_hi:[0,1,0]\n\t"
        "v_fma_mix_f32 %[p0], %[s1], %[kkx], %[p0] op_sel:[0,1,0] op_sel_hi:[0,1,0]\n\t"
        "v_fma_mix_f32 %[p0], %[s2], %[kky], %[p0] op_sel_hi:[0,1,0]\n\t"
        "v_fma_mix_f32 %[p0], %[s3], %[kky], %[p0] op_sel:[0,1,0] op_sel_hi:[0,1,0]\n\t"
        "v_fma_mix_f32 %[u0], %[s0], %[wx], 0 op_sel_hi:[0,1,0]\n\t"
        "v_fma_mix_f32 %[u1], %[s1], %[wx], 0 op_sel:[0,1,0] op_sel_hi:[0,1,0]\n\t"
        "v_add_f32_dpp %[p0], %[p0], %[p0] quad_perm:[1,0,3,2] row_mask:0xf bank_mask:0xf bound_ctrl:1\n\t"
        "v_fma_mix_f32 %[u2], %[s2], %[wy], 0 op_sel_hi:[0,1,0]\n\t"
        "v_fma_mix_f32 %[u3], %[s3], %[wy], 0 op_sel:[0,1,0] op_sel_hi:[0,1,0]\n\t"
        "v_add_f32_dpp %[p0], %[p0], %[p0] quad_perm:[2,3,0,1] row_mask:0xf bank_mask:0xf bound_ctrl:1\n\t"
        "v_fma_mix_f32 %[u0], %[v], %[khx], %[u0] op_sel_hi:[1,1,0]\n\t"
        "v_fma_mix_f32 %[u1], %[v], %[khx], %[u1] op_sel:[0,1,0] op_sel_hi:[1,1,0]\n\t"
        "v_add_f32_dpp %[p0], %[p0], %[p0] row_half_mirror row_mask:0xf bank_mask:0xf bound_ctrl:1\n\t"
        "v_fma_mix_f32 %[u2], %[v], %[khy], %[u2] op_sel_hi:[1,1,0]\n\t"
        "v_fma_mix_f32 %[u3], %[v], %[khy], %[u3] op_sel:[0,1,0] op_sel_hi:[1,1,0]\n\t"
        "v_add_f32_dpp %[p0], %[p0], %[p0] row_mirror row_mask:0xf bank_mask:0xf bound_ctrl:1\n\t"
        "v_xor_b32 %[p1], 0x80000000, %[p0]\n\t"
        "v_fma_mix_f32 %[s0], %[p1], %[bbx], %[u0] op_sel_hi:[0,1,0]\n\t"
        "v_fma_mix_f32 %[s1], %[p1], %[bbx], %[u1] op_sel:[0,1,0] op_sel_hi:[0,1,0]\n\t"
        "v_fma_mix_f32 %[s2], %[p1], %[bby], %[u2] op_sel_hi:[0,1,0]\n\t"
        "v_fma_mix_f32 %[s3], %[p1], %[bby], %[u3] op_sel:[0,1,0] op_sel_hi:[0,1,0]\n\t"
        "v_fma_mix_f32 %[q0], %[s0], %[rx], 0 op_sel_hi:[0,1,0]\n\t"
        "v_fma_mix_f32 %[q0], %[s1], %[rx], %[q0] op_sel:[0,1,0] op_sel_hi:[0,1,0]\n\t"
        "v_fma_mix_f32 %[q0], %[s2], %[ry], %[q0] op_sel_hi:[0,1,0]\n\t"
        "v_fma_mix_f32 %[q0], %[s3], %[ry], %[q0] op_sel:[0,1,0] op_sel_hi:[0,1,0]"
        : [s0] "+v"(s0), [s1] "+v"(s1), [s2] "+v"(s2), [s3] "+v"(s3), [q0] "=&v"(q0),
          [p0] "=&v"(p0), [p1] "=&v"(p1), [u0] "=&v"(u0), [u1] "=&v"(u1), [u2] "=&v"(u2), [u3] "=&v"(u3)
        : [kkx] "v"(kkx), [kky] "v"(kky), [wx] "v"(wx), [wy] "v"(wy), [khx] "v"(khx), [khy] "v"(khy), [bbx] "v"(bbx), [bby] "v"(bby), [rx] "v"(rx), [ry] "v"(ry), [v] "v"(v));
    q1 = 0.f;
}
constexpr int TCH = 32;
constexpr int SCH = 6 * 64;
__device__ __forceinline__ void phase_scan(LAS unsigned char* ldsb, const u16* zr, const _Float16* wbuf, const _Float16* abuf, const float* mu, const float* k_k, const float* k_a,
                                           float* yraw, int tid, int bid) {
    LAS _Float16* lds = (LAS _Float16*)ldsb;
    LAS float* ypart = (LAS float*)(ldsb + 2 * TCH * SCH * 2);
    const int wid = tid >> 6, lane = tid & 63;
    const int blk = bid, xcd = blk & 7, slot = blk >> 3, bh = xcd * 8 + (slot >> 2), quarter = slot & 3;
    const int b = bh >> 3, h = bh & 7, tok0 = b * SEQ;
    const bool comp = wid < 4;
    const int rowl = quarter * 16 + (wid & 3) * 4 + (lane >> 4), ks = lane & 15;
    constexpr int NCH = SEQ / TCH;
    const int p = tid & 255, pst = p >> 4, pks = p & 15, pch = h * 64 + 4 * pks;
    RwkvConst rc = rwkv_const(mu, k_k, k_a, pch);
    RwkvRaw raw[2]; h16x4 wv[2];
    if (!comp) { scan_load(zr, wbuf, abuf, tok0, pst, pch, 0, raw, wv); scan_write(lds, rc, tok0, pst, pks, 0, 0, raw, wv); scan_load(zr, wbuf, abuf, tok0, pst, pch, 1, raw, wv); }
    __syncthreads();
    float s0 = 0.f, s1 = 0.f, s2 = 0.f, s3 = 0.f;
    LAS float* ypw = ypart + (wid & 3) * (TCH * 64);
#define SCAN_LD(W, KK, BB, KH, R, V, st) do { const LAS _Float16* sp_ = bp + (st) * SCH; W = *(const LAS u32x2*)(sp_ + 4 * ks); KK = *(const LAS u32x2*)(sp_ + 64 + 4 * ks); \
        BB = *(const LAS u32x2*)(sp_ + 128 + 4 * ks); KH = *(const LAS u32x2*)(sp_ + 192 + 4 * ks); R = *(const LAS u32x2*)(sp_ + 256 + 4 * ks); V = *(const LAS unsigned short*)(sp_ + 320 + rowl); } while (0)
#pragma nounroll
    for (int c = 0; c < NCH; ++c) {
        if (!comp) {
            if (c + 1 < NCH) scan_write(lds, rc, tok0, pst, pks, c + 1, (c + 1) & 1, raw, wv);
            if (c + 2 < NCH) scan_load(zr, wbuf, abuf, tok0, pst, pch, c + 2, raw, wv);
        }
        else {
            const LAS _Float16* bp = lds + (c & 1) * (TCH * SCH);
            u32x2 w, kk, bb, kh, r; unsigned v;
            SCAN_LD(w, kk, bb, kh, r, v, 0);
#pragma unroll
            for (int st = 0; st < TCH; ++st) {
                u32x2 nw, nkk, nbb, nkh, nr; unsigned nv;
                if (st + 1 < TCH) SCAN_LD(nw, nkk, nbb, nkh, nr, nv, st + 1);
                float q0, q1;
                scan_step_asm(s0, s1, s2, s3, q0, q1, kk.x, kk.y, w.x, w.y, kh.x, kh.y, bb.x, bb.y, r.x, r.y, v);
                ypw[st * 64 + lane] = q0;
                if (st + 1 < TCH) { w = nw; kk = nkk; bb = nbb; kh = nkh; r = nr; v = nv; }
            }
#pragma unroll
            for (int i = 0; i < 2; ++i) {
                const int pp = lane + 64 * i, st = pp >> 2, rw = pp & 3;
                const LAS f32x4* q = (const LAS f32x4*)(ypw + st * 64 + rw * 16);
                const f32x4 a0 = q[0], a1 = q[1], a2 = q[2], a3 = q[3];
                const f32x4 sm = (a0 + a1) + (a2 + a3);
                yraw[(size_t)(tok0 + c * TCH + st) * 512 + h * 64 + quarter * 16 + (wid & 3) * 4 + rw] = (sm[0] + sm[1]) + (sm[2] + sm[3]);
            }
        }
        asm volatile("s_waitcnt lgkmcnt(0)" ::: "memory"); __builtin_amdgcn_s_barrier(); asm volatile("" ::: "memory");
    }
#undef SCAN_LD
}
__device__ __forceinline__ void phase_rwkv_out(const float* __restrict__ yraw, const u16* __restrict__ zr, const _Float16* __restrict__ abuf, const _Float16* __restrict__ gbuf,
                                               const float* __restrict__ mu, const float* __restrict__ k_k, const float* __restrict__ k_a, const float* __restrict__ r_k,
                                               const float* __restrict__ gn_g, const float* __restrict__ gn_b, u16* __restrict__ yout, size_t gtid, size_t gth) {
    const int hk = (int)(gtid & 127), head = hk >> 4, ks = hk & 15, ch = head * 64 + ks * 4;
    const RwkvConst rc = rwkv_const(mu, k_k, k_a, ch);
    const f32x4 rk = *(const f32x4*)(r_k + ch), gg = *(const f32x4*)(gn_g + ch), gb = *(const f32x4*)(gn_b + ch);
#pragma unroll 2
    for (size_t idx = gtid; idx < (size_t)MTOK * 128; idx += gth) {
        const int tok = (int)(idx >> 7);
        const f32x4 y = *(const f32x4*)(yraw + (size_t)tok * 512 + ch);
        const h16x4 gh = *(const h16x4*)(gbuf + (size_t)tok * 512 + ch);
        f32x4 r, kh, v, kk, bb; rwkv_prep(zr, abuf, tok, ch, rc, r, kh, v, kk, bb);
        const float mean = red16((y[0] + y[1]) + (y[2] + y[3])) * (1.f / 64.f);
        const f32x4 d = y - mean;
        const float var = red16((d[0] * d[0] + d[1] * d[1]) + (d[2] * d[2] + d[3] * d[3])) * (1.f / 64.f);
        const float rstd = 1.0f / sqrtf(var + 64e-5f);
        const float bs = red16((r[0] * kh[0] * rk[0] + r[1] * kh[1] * rk[1]) + (r[2] * kh[2] * rk[2] + r[3] * kh[3] * rk[3]));
        float o[4];
#pragma unroll
        for (int j = 0; j < 4; ++j) o[j] = (d[j] * rstd * gg[j] + gb[j] + bs * v[j]) * (float)gh[j];
        u32x2 w; w.x = cvt_pk_bf16(o[0], o[1]); w.y = cvt_pk_bf16(o[2], o[3]);
        *(u32x2*)(yout + (size_t)tok * 1536 + ch) = w;
    }
}

__device__ __forceinline__ bf16x8 ldfrag(const u16* p) { return *(const bf16x8*)p; }
__device__ __forceinline__ void r1_issue(LAS unsigned char* lds, int it, int bid, int wid, int fr, int fq, const u16* ktz) {
    const int itc = it > 7 ? 7 : it, item = itc * 256 + bid;
    const u16* src = ktz + (size_t)item * 16384 + (size_t)(16 * wid + fr) * 128 + 8 * fq;
    LAS unsigned char* dst = lds + (it % 3) * 32768 + wid * 4096;
#pragma unroll
    for (int k = 0; k < 4; ++k) __builtin_amdgcn_global_load_lds((const unsigned*)(src + 32 * k), (LAS unsigned*)(dst + k * 1024), 16, 0, 0);
}
__device__ __forceinline__ void phase_r1(LAS unsigned char* lds, const u16* vt, const u16* ktz, u16* ut, int wid_, int lane, int bid) {
    const int wid = __builtin_amdgcn_readfirstlane(wid_), fr = lane & 15, fq = lane >> 4;
    r1_issue(lds, 0, bid, wid, fr, fq, ktz); r1_issue(lds, 1, bid, wid, fr, fq, ktz); r1_issue(lds, 2, bid, wid, fr, fq, ktz);
    bf16x8 xf[2][4];
    {
        const u16* V = vt + (size_t)bid * 32768 + (size_t)(wid * 32) * 128;
#pragma unroll
        for (int i = 0; i < 2; ++i)
#pragma unroll
            for (int k = 0; k < 4; ++k) xf[i][k] = ldfrag(V + (size_t)(16 * i + fr) * 128 + 32 * k + 8 * fq);
    }
#pragma unroll 1
    for (int it = 0; it < 8; ++it) {
        const int item = it * 256 + bid;
        asm volatile("s_waitcnt vmcnt(8)" ::: "memory");
        asm volatile("s_waitcnt lgkmcnt(0)" ::: "memory"); __builtin_amdgcn_s_barrier(); asm volatile("" ::: "memory");
        const LAS unsigned char* kb = lds + (it % 3) * 32768 + lane * 16;
        f32x4 acc[2][8];
#pragma unroll
        for (int i = 0; i < 2; ++i)
#pragma unroll
            for (int j = 0; j < 8; ++j) acc[i][j] = (f32x4){0.f, 0.f, 0.f, 0.f};
#pragma unroll
        for (int k = 0; k < 4; ++k)
#pragma unroll
            for (int j = 0; j < 8; ++j) {
                const bf16x8 yf = *(const LAS bf16x8*)(kb + (j * 4 + k) * 1024);
#pragma unroll
                for (int i = 0; i < 2; ++i) acc[i][j] = __builtin_amdgcn_mfma_f32_16x16x32_bf16(yf, xf[i][k], acc[i][j], 0, 0, 0);
            }
        u16* U = ut + (size_t)item * 256 * 128 + (size_t)(wid * 32) * 128;
#pragma unroll
        for (int i = 0; i < 2; ++i)
#pragma unroll
            for (int j = 0; j < 8; ++j) { u32x2 w; w.x = cvt_pk_bf16(acc[i][j][0], acc[i][j][1]); w.y = cvt_pk_bf16(acc[i][j][2], acc[i][j][3]);
                *(u32x2*)(U + (size_t)(16 * i + fr) * 128 + 16 * j + 4 * fq) = w; }
        {
            const int itn = it < 7 ? it + 1 : 7;
            const u16* V = vt + (size_t)(itn * 256 + bid) * 32768 + (size_t)(wid * 32) * 128;
#pragma unroll
            for (int i = 0; i < 2; ++i)
#pragma unroll
                for (int k = 0; k < 4; ++k) xf[i][k] = ldfrag(V + (size_t)(16 * i + fr) * 128 + 32 * k + 8 * fq);
        }
        asm volatile("s_waitcnt lgkmcnt(0)" ::: "memory"); __builtin_amdgcn_s_barrier(); asm volatile("" ::: "memory");
        r1_issue(lds, it + 3, bid, wid, fr, fq, ktz);
    }
    asm volatile("s_waitcnt vmcnt(0)" ::: "memory");
    asm volatile("s_waitcnt lgkmcnt(0)" ::: "memory"); __builtin_amdgcn_s_barrier(); asm volatile("" ::: "memory");
}
__device__ __forceinline__ void phase_r2(u16* rt, size_t gtid, size_t gth) {
    for (size_t idx = gtid; idx < (size_t)32 * 8192; idx += gth) {
        const int bh = (int)(idx >> 13), off = (int)(idx & 8191) * 4, head = bh & 3;
        const float cd = __builtin_amdgcn_exp2f(128.f * __log2f(1.0f - __builtin_amdgcn_exp2f((float)(-5 - head))));
        f32x4 R = {0.f, 0.f, 0.f, 0.f};
        u16* rp = rt + (size_t)bh * 64 * 32768 + off;
#pragma unroll 8
        for (int c = 0; c < 64; ++c) {
            const f32x4 uv = ld_bf4(rp + (size_t)c * 32768);
            u32x2 w; w.x = cvt_pk_bf16(R[0], R[1]); w.y = cvt_pk_bf16(R[2], R[3]);
            *(u32x2*)(rp + (size_t)c * 32768) = w;
            R = R * cd + uv;
        }
    }
}
#define R3_WAITV(n) asm volatile("s_waitcnt vmcnt(" #n ")" ::: "memory")
#define R3_BAR() do { asm volatile("s_waitcnt lgkmcnt(0)" ::: "memory"); __builtin_amdgcn_s_barrier(); asm volatile("" ::: "memory"); } while (0)
__device__ __forceinline__ void r3_issue(LAS unsigned char* lds, int g, int bid, int wid, int fr, int fq, const u16* krot, const u16* rt, const u16* vt) {
    int it = g / 5; const int st = g - it * 5; it = it > 7 ? 7 : it;
    const int item = it * 256 + bid, bh = item >> 6, chunk = item & 63, b = bh >> 2, head = bh & 3, tok0 = b * SEQ + chunk * 128;
    const u16* src;
    if (st == 0) src = krot + (size_t)(tok0 + 16 * wid + fr) * 512 + head * 128 + 8 * fq;
    else src = (wid < 4 ? rt : vt) + (size_t)item * 32768 + (size_t)(16 * (4 * (st - 1) + (wid & 3)) + fr) * 128 + 8 * fq;
    LAS unsigned char* dst = lds + (g % 3) * 32768 + wid * 4096;
#pragma unroll
    for (int k = 0; k < 4; ++k) __builtin_amdgcn_global_load_lds((const unsigned*)(src + 32 * k), (LAS unsigned*)(dst + k * 1024), 16, 0, 0);
}
__device__ __forceinline__ void phase_r3(LAS unsigned char* lds, const u16* qrot, const u16* krot, const u16* vt, const u16* rt, const u16* gsilu, u16* yret, int wid_, int lane, int bid) {
    const int wid = __builtin_amdgcn_readfirstlane(wid_), fr = lane & 15, fq = lane >> 4;
    LAS unsigned char* Pw = lds + 98304 + (16 * wid + fr) * 256;
    const int nK = (wid >> 1) + 1;
    const int n = 16 * wid + fr;
    r3_issue(lds, 0, bid, wid, fr, fq, krot, rt, vt); r3_issue(lds, 1, bid, wid, fr, fq, krot, rt, vt); r3_issue(lds, 2, bid, wid, fr, fq, krot, rt, vt);
#pragma unroll 1
    for (int it = 0; it < 8; ++it) {
        const int item = it * 256 + bid, bh = item >> 6, chunk = item & 63, b = bh >> 2, head = bh & 3, tok0 = b * SEQ + chunk * 128, g0 = it * 5;
        const float l2g = __log2f(1.0f - __builtin_amdgcn_exp2f((float)(-5 - head)));
        bf16x8 qf[4];
#pragma unroll
        for (int k = 0; k < 4; ++k) qf[k] = ldfrag(qrot + (size_t)(tok0 + n) * 512 + head * 128 + 32 * k + 8 * fq);
        R3_WAITV(8); R3_BAR();
        {
            const LAS unsigned char* kb = lds + (g0 % 3) * 32768 + lane * 16;
            for (int j = 0; j < 2 * nK; ++j) {
                f32x4 sc = {0.f, 0.f, 0.f, 0.f};
#pragma unroll
                for (int k = 0; k < 4; ++k) { const bf16x8 kf = *(const LAS bf16x8*)(kb + (j * 4 + k) * 1024); sc = __builtin_amdgcn_mfma_f32_16x16x32_bf16(kf, qf[k], sc, 0, 0, 0); }
                float pv[4];
#pragma unroll
                for (int r = 0; r < 4; ++r) { const int m = 16 * j + 4 * fq + r; pv[r] = (m <= n) ? sc[r] * __builtin_amdgcn_exp2f(l2g * (float)(n - m)) : 0.f; }
                u32x2 w; w.x = cvt_pk_bf16(pv[0], pv[1]); w.y = cvt_pk_bf16(pv[2], pv[3]);
                *(LAS u32x2*)(Pw + (16 * j + 4 * fq) * 2) = w;
            }
        }
        R3_BAR(); r3_issue(lds, g0 + 3, bid, wid, fr, fq, krot, rt, vt);
        f32x4 acc[16];
        const float xi = __builtin_amdgcn_exp2f(l2g * (float)(n + 1));
#pragma unroll
        for (int q = 0; q < 4; ++q) {
            R3_WAITV(8); R3_BAR();
            const LAS unsigned char* sb = lds + ((g0 + 1 + q) % 3) * 32768 + lane * 16;
#pragma unroll
            for (int jj = 0; jj < 4; ++jj) {
                f32x4 a = {0.f, 0.f, 0.f, 0.f};
#pragma unroll
                for (int k = 0; k < 4; ++k) { const bf16x8 rf = *(const LAS bf16x8*)(sb + (jj * 4 + k) * 1024); a = __builtin_amdgcn_mfma_f32_16x16x32_bf16(rf, qf[k], a, 0, 0, 0); }
                acc[4 * q + jj] = a * xi;
            }
            for (int k = 0; k < nK; ++k) {
                const bf16x8 pf = *(const LAS bf16x8*)(Pw + (32 * k + 8 * fq) * 2);
#pragma unroll
                for (int jj = 0; jj < 4; ++jj) { const bf16x8 vf = *(const LAS bf16x8*)(sb + (16 + jj * 4 + k) * 1024); acc[4 * q + jj] = __builtin_amdgcn_mfma_f32_16x16x32_bf16(vf, pf, acc[4 * q + jj], 0, 0, 0); }
            }
            R3_BAR(); r3_issue(lds, g0 + 4 + q, bid, wid, fr, fq, krot, rt, vt);
        }
        float s1 = 0.f;
#pragma unroll
        for (int j = 0; j < 16; ++j) s1 += (acc[j][0] + acc[j][1]) + (acc[j][2] + acc[j][3]);
        s1 += __shfl_xor(s1, 16); s1 += __shfl_xor(s1, 32);
        const float mean = s1 * (1.f / 256.f);
        float s2 = 0.f;
#pragma unroll
        for (int j = 0; j < 16; ++j) { acc[j] = acc[j] - mean; s2 += (acc[j][0] * acc[j][0] + acc[j][1] * acc[j][1]) + (acc[j][2] * acc[j][2] + acc[j][3] * acc[j][3]); }
        s2 += __shfl_xor(s2, 16); s2 += __shfl_xor(s2, 32);
        const float rstd = 1.0f / sqrtf(s2 * (1.f / 256.f) + LN_EPS);
        const u16* gp = gsilu + (size_t)(tok0 + n) * 1024 + head * 256 + 4 * fq;
        u16* op = yret + (size_t)(tok0 + n) * 1536 + head * 256 + 4 * fq;
#pragma unroll
        for (int j = 0; j < 16; ++j) {
            const f32x4 gv = ld_bf4(gp + 16 * j);
            const f32x4 o = acc[j] * rstd * gv;
            u32x2 w; w.x = cvt_pk_bf16(o[0], o[1]); w.y = cvt_pk_bf16(o[2], o[3]);
            *(u32x2*)(op + 16 * j) = w;
        }
    }
    R3_WAITV(0); R3_BAR();
}

#define XB_TMO      128
#define XB_XCNT(j)  (256  + 64 * (j))
#define XB_XSUB(j)  (1280 + 64 * (j))
#define XB_XGEN(j)  (2304 + 64 * (j))
#define XB_TOP      3328
#define XB_TOPGEN   3392
#define XCD_BAR_WORDS 3456
#define XB_SPIN_CAP (1u << 22)
__device__ __forceinline__ unsigned xb_ld(unsigned* p)              { return __hip_atomic_load(p, __ATOMIC_RELAXED, __HIP_MEMORY_SCOPE_AGENT); }
__device__ __forceinline__ unsigned xb_add(unsigned* p, unsigned v) { return __hip_atomic_fetch_add(p, v, __ATOMIC_RELAXED, __HIP_MEMORY_SCOPE_AGENT); }
__device__ __forceinline__ unsigned xb_xcc_id() { return (unsigned)__builtin_amdgcn_s_getreg((3 << 11) | 20) & 0xFu; }
#define XB_SPIN(cond, bar) do { unsigned _sp = 0; while (cond) { __builtin_amdgcn_s_sleep(1); \
    if ((++_sp & 255u) == 0u) { if (xb_ld(&(bar)[XB_TMO])) break; if (_sp > XB_SPIN_CAP) { atomicAdd(&(bar)[XB_TMO], 1u); break; } } } } while (0)
struct XcdBarrier { unsigned* bar; unsigned x; volatile LAS unsigned* st; };
__device__ __forceinline__ XcdBarrier xcd_barrier_post(unsigned* bar, volatile LAS unsigned* st) {
    XcdBarrier b; b.bar = bar; b.x = xb_xcc_id(); b.st = st;
    if (threadIdx.x == 0) (void)xb_add(&bar[XB_XCNT(b.x)], 1u);
    return b;
}
__device__ __forceinline__ void xcd_barrier_complete(unsigned* bar, unsigned x, unsigned& nloc, unsigned& nx) {
    const unsigned G = gridDim.x * gridDim.y * gridDim.z;
    unsigned sum, cnt, mine, sp = 0u;
    for (;;) {
        sum = 0u; cnt = 0u; mine = 0u;
#pragma unroll
        for (unsigned j = 0; j < 16; ++j) { const unsigned c = xb_ld(&bar[XB_XCNT(j)]); sum += c; cnt += (c > 0u) ? 1u : 0u; mine = (j == x) ? c : mine; }
        if (sum == G) break;
        __builtin_amdgcn_s_sleep(1);
        if ((++sp & 255u) == 0u) { if (xb_ld(&bar[XB_TMO])) break; if (sp > XB_SPIN_CAP) { atomicAdd(&bar[XB_TMO], 1u); break; } }
    }
    nloc = mine > 0u ? mine : 1u; nx = cnt > 0u ? cnt : 1u;
}
__device__ __forceinline__ void xcd_barrier(const XcdBarrier& b) {
    asm volatile("s_waitcnt vmcnt(0)" ::: "memory");
    __syncthreads();
    if (threadIdx.x == 0) {
        unsigned* bar = b.bar;
        __builtin_amdgcn_s_waitcnt(0);
        unsigned nloc = b.st[0], nx = b.st[1];
        if (nloc == 0u) { xcd_barrier_complete(bar, b.x, nloc, nx); b.st[0] = nloc; b.st[1] = nx; }
        const unsigned old = xb_add(&bar[XB_XSUB(b.x)], 1u);
        const unsigned gen = old / nloc;
        if (old + 1u == (gen + 1u) * nloc) {
            __builtin_amdgcn_fence(__ATOMIC_RELEASE, "agent");
            asm volatile("s_waitcnt vmcnt(0)" ::: "memory");
            const unsigned og = xb_add(&bar[XB_TOP], 1u);
            const unsigned tg = og / nx;
            if (og + 1u == (tg + 1u) * nx) xb_add(&bar[XB_TOPGEN], 1u);
            else XB_SPIN(xb_ld(&bar[XB_TOPGEN]) == tg, bar);
            __builtin_amdgcn_fence(__ATOMIC_ACQUIRE, "agent");
            xb_add(&bar[XB_XGEN(b.x)], 1u);
            asm volatile("s_waitcnt vmcnt(0)" ::: "memory");
        } else {
            XB_SPIN(xb_ld(&bar[XB_XGEN(b.x)]) == gen, bar);
            __builtin_amdgcn_fence(__ATOMIC_ACQUIRE, "agent");
            asm volatile("s_waitcnt vmcnt(0)" ::: "memory");
        }
    }
    __syncthreads();
}

#ifndef PHMASK
#define PHMASK 0xFFFFFF
#endif
#define PH_ON(p) ((PHMASK >> (p)) & 1)
#ifndef REPMASK
#define REPMASK 0
#endif
#define PH_BEGIN(p) _Pragma("nounroll") for (int rep_ = 0; rep_ < (int)PH_ON(p) * (1 + (int)((REPMASK >> (p)) & 1)); ++rep_) { int tid = threadIdx.x; asm volatile("" : "+v"(tid)); int bid = blockIdx.x; asm volatile("" : "+s"(bid)); \
        unsigned char* ws = P.ws; asm volatile("" : "+s"(ws)); float* dout = P.out; asm volatile("" : "+s"(dout)); \
        const int wid = tid >> 6, lane = tid & 63; const size_t gtid = (size_t)bid * 512 + tid, gth = (size_t)gridDim.x * 512; const int gw = bid * 8 + wid, ngw = gridDim.x * 8; \
        (void)wid; (void)lane; (void)gtid; (void)gth; (void)gw; (void)ngw; (void)ws; (void)dout;
#define PH_END xcd_barrier(xb); }

__device__ __forceinline__ void run_ffn_in(LAS unsigned char* lds, const u16* A, const u16* Wt, u16* hid, int bid) {
    pg8::Gemm g{A, Wt, DM, DM, DM}; pg8::StaticOrder S; S.init(MTOK, 2 * FF, gridDim.x, bid);
    EpiFfnIn E{hid}; pg8::gemm_phase(lds, g, S, E);
}
__device__ __forceinline__ void run_res(LAS unsigned char* lds, const u16* A, const u16* Wt, int K, u16* pre, const float* resf, const u16* resb, float scale, int bid) {
    pg8::Gemm g{A, Wt, K, K, K}; pg8::StaticOrder S; S.init(MTOK, DM, gridDim.x, bid);
    EpiRes E{pre, resf, resb, DN_ALPHA, scale}; pg8::gemm_phase(lds, g, S, E);
}
__device__ __forceinline__ void run_mix(LAS unsigned char* lds, unsigned char* ws, float* dout, int pn0, int npn, int bid) {
    pg8::Gemm g{(const u16*)(ws + O_H), (const u16*)(ws + O_WMT) + (size_t)pn0 * 256 * DM, DM, DM, DM};
    pg8::StaticOrder S; S.init(MTOK, npn * 256, gridDim.x, bid);
    EpiMix E{pn0, (u16*)dout, (u16*)(ws + O_QROT), (u16*)(ws + O_KROT), (u16*)(ws + O_KTZ), (u16*)(ws + O_VT), (u16*)(ws + O_GSILU), (u16*)dout, (const f32x2*)(ws + O_CS)};
    pg8::gemm_phase(lds, g, S, E);
}
__device__ __forceinline__ void run_fin(LAS unsigned char* lds, const u16* A, const u16* Wt, int K, int mode, float* out, u16* pproj, int bid) {
    pg8::Gemm g{A, Wt, K, K, K}; pg8::StaticOrder S; S.init(MTOK, DM, gridDim.x, bid);
    EpiFin E{mode, out, pproj}; pg8::gemm_phase(lds, g, S, E);
}

__global__ void __launch_bounds__(512, 2) mega(Params P) {
    extern __shared__ __attribute__((aligned(16))) unsigned char smem[];
    LAS unsigned char* lds = (LAS unsigned char*)smem;
    cg::grid_group grid = cg::this_grid();
    volatile LAS unsigned* xst = (volatile LAS unsigned*)(lds + pg8::STAGE_BYTES);
    if (threadIdx.x == 0) { xst[0] = 0u; xst[1] = 0u; }
    __syncthreads();
    const XcdBarrier xb = xcd_barrier_post((unsigned*)(P.ws + O_BAR), xst);
    grid.sync();

    PH_BEGIN(0) phase_convert(P, gtid, gth); PH_END
    PH_BEGIN(1) run_ffn_in(lds, (const u16*)(ws + O_XB), (const u16*)(ws + O_W1T), (u16*)(ws + O_HID), bid); PH_END
    PH_BEGIN(2) run_res(lds, (const u16*)(ws + O_HID), (const u16*)(ws + O_W2T), FF, (u16*)(ws + O_PRE), P.in[0], nullptr, 0.5f, bid); PH_END
    PH_BEGIN(3) phase_ln((const u16*)(ws + O_PRE), P.in[3], P.in[4], (u16*)(ws + O_H), nullptr, gw, ngw, lane); PH_END
    PH_BEGIN(4) run_mix(lds, ws, dout, 0, 7, bid); PH_END
    PH_BEGIN(5) phase_lora_prep((const u16*)dout, P.in[8], (u16*)(ws + O_ALORA), gtid, gth); PH_END
    PH_BEGIN(6) {
        pg8::Gemm g{(const u16*)(ws + O_ALORA), (const u16*)(ws + O_WLT), 256, 256, 256};
        pg8::StaticOrder S; S.init(MTOK, 1536, gridDim.x, bid);
        EpiLora E{(_Float16*)(ws + O_WBUF), (_Float16*)(ws + O_ABUF), (_Float16*)(ws + O_GBUF), P.in[9], P.in[11]};
        pg8::gemm_phase(lds, g, S, E);
    } PH_END
    PH_BEGIN(8) phase_scan(lds, (const u16*)dout, (const _Float16*)(ws + O_WBUF), (const _Float16*)(ws + O_ABUF), P.in[8], P.in[14], P.in[15], (float*)(ws + O_YRAW), tid, bid); PH_END
    PH_BEGIN(9) phase_rwkv_out((const float*)(ws + O_YRAW), (const u16*)dout, (const _Float16*)(ws + O_ABUF), (const _Float16*)(ws + O_GBUF), P.in[8], P.in[14], P.in[15], P.in[16], P.in[17], P.in[18], (u16*)(ws + O_Y), gtid, gth); PH_END
    PH_BEGIN(10) run_mix(lds, ws, dout, 7, 20, bid); PH_END
    PH_BEGIN(11) phase_r1(lds, (const u16*)(ws + O_VT), (const u16*)(ws + O_KTZ), (u16*)(ws + O_RT), wid, lane, bid); PH_END
    PH_BEGIN(12) phase_r2((u16*)(ws + O_RT), gtid, gth); PH_END
    PH_BEGIN(13) phase_r3(lds, (const u16*)(ws + O_QROT), (const u16*)(ws + O_KROT), (const u16*)(ws + O_VT), (const u16*)(ws + O_RT), (const u16*)(ws + O_GSILU), (u16*)(ws + O_Y) + 512, wid, lane, bid); PH_END
    PH_BEGIN(15) {
        pg8::Gemm g{(const u16*)(ws + O_Y), (const u16*)(ws + O_WBR), 1536, 1536, 1536};
        pg8::StaticOrder S; S.init(MTOK, DM, gridDim.x, bid);
        EpiBr E{(const u16*)dout, (u16*)(ws + O_MERGED)};
        pg8::gemm_phase<EpiBr, true>(lds, g, S, E, 512);
    } PH_END
    PH_BEGIN(17) run_res(lds, (const u16*)(ws + O_MERGED), (const u16*)(ws + O_WMO), DM, (u16*)(ws + O_PRE), nullptr, (const u16*)(ws + O_H), 1.0f, bid); PH_END
    PH_BEGIN(18) phase_ln((const u16*)(ws + O_PRE), P.in[22], P.in[23], (u16*)(ws + O_H), nullptr, gw, ngw, lane); PH_END
    PH_BEGIN(19) run_ffn_in(lds, (const u16*)(ws + O_H), (const u16*)(ws + O_W3T), (u16*)(ws + O_HID), bid); PH_END
    PH_BEGIN(20) run_res(lds, (const u16*)(ws + O_HID), (const u16*)(ws + O_W4T), FF, (u16*)(ws + O_PRE), nullptr, (const u16*)(ws + O_H), 0.5f, bid); PH_END
    PH_BEGIN(21) phase_ln((const u16*)(ws + O_PRE), P.in[26], P.in[27], (u16*)(ws + O_H), dout, gw, ngw, lane);
        run_fin(lds, (const u16*)(ws + O_PB), (const u16*)(ws + O_WPT), 256, 0, dout, (u16*)(ws + O_PPROJ), bid); PH_END
    PH_BEGIN(23) run_fin(lds, (const u16*)(ws + O_H), (const u16*)(ws + O_WGT), DM, 1, dout, (u16*)(ws + O_PPROJ), bid); PH_END
}

constexpr int LDS_BYTES = pg8::STAGE_BYTES + 16;

extern "C" void kernel_launch(void* const* d_in, const int* in_sizes, int n_in, void* d_out, int out_size, void* d_ws, size_t ws_size, hipStream_t stream) {
    static int grid = 0;
    if (grid == 0) {
        if (n_in != 30 || out_size != MTOK * DM || ws_size < WS_NEED) { fprintf(stderr, "kernel_launch: unexpected shapes (n_in %d out %d ws %zu)\n", n_in, out_size, ws_size); grid = -1; return; }
        int dev = 0, cus = 0, per_cu = 0;
        (void)hipGetDevice(&dev); (void)hipDeviceGetAttribute(&cus, hipDeviceAttributeMultiprocessorCount, dev);
        if (hipFuncSetAttribute((const void*)mega, hipFuncAttributeMaxDynamicSharedMemorySize, LDS_BYTES) != hipSuccess) { fprintf(stderr, "kernel_launch: hipFuncSetAttribute failed\n"); grid = -1; return; }
        (void)hipOccupancyMaxActiveBlocksPerMultiprocessor(&per_cu, (const void*)mega, 512, LDS_BYTES);
        (void)hipGetLastError();
        if (cus != 256 || per_cu < 1) { fprintf(stderr, "kernel_launch: needs 256 CUs with one resident workgroup each (cus %d per_cu %d)\n", cus, per_cu); grid = -1; return; }
        grid = 256;
    }
    if (grid < 0) return;
    if (hipMemsetAsync((char*)d_ws + O_BAR, 0, XCD_BAR_WORDS * 4, stream) != hipSuccess) { fprintf(stderr, "kernel_launch: memset of barrier words failed\n"); return; }
    Params p{};
    for (int i = 0; i < 30; ++i) p.in[i] = (const float*)d_in[i];
    p.out = (float*)d_out; p.ws = (unsigned char*)d_ws;
    void* args[] = {&p};
    hipError_t e = hipLaunchCooperativeKernel((const void*)mega, dim3(grid), dim3(512), args, LDS_BYTES, stream);
    if (e != hipSuccess) fprintf(stderr, "cooperative launch failed: %s\n", hipGetErrorString(e));
}
```

```cpp
#include <hip/hip_runtime.h>
#include <hip/hip_cooperative_groups.h>
#include <cstdio>
namespace cg = cooperative_groups;

#define LAS __attribute__((address_space(3)))
typedef unsigned short u16;
typedef short bf16x8 __attribute__((ext_vector_type(8)));
typedef float f32x4 __attribute__((ext_vector_type(4)));
typedef float f32x2 __attribute__((ext_vector_type(2)));
typedef unsigned u32x4 __attribute__((ext_vector_type(4)));
typedef unsigned u32x2 __attribute__((ext_vector_type(2)));
typedef _Float16 h16x4 __attribute__((ext_vector_type(4)));
typedef _Float16 h16x8 __attribute__((ext_vector_type(8)));

constexpr int MTOK = 65536, DM = 1024, FF = 2816, SEQ = 8192, MIXN = 6912;
constexpr float DN_ALPHA = 1.189207115f;
constexpr float LN_EPS = 1e-5f;
constexpr float DECAY_SCALE = 0.60653066f;

constexpr size_t MiB = 1ull << 20;
constexpr size_t O_W1T = 0;
constexpr size_t O_W2T = O_W1T + 5632ull * 1024 * 2;
constexpr size_t O_WMT = O_W2T + 1024ull * 2816 * 2;
constexpr size_t O_W3T = O_WMT + 6912ull * 1024 * 2;
constexpr size_t O_W4T = O_W3T + 5632ull * 1024 * 2;
constexpr size_t O_WLT = O_W4T + 1024ull * 2816 * 2;
constexpr size_t O_WBR = O_WLT + 1536ull * 256 * 2;
constexpr size_t O_WBT = O_WBR + 1024ull * 512 * 2;
constexpr size_t O_WMO = O_WBT + 1024ull * 1024 * 2;
constexpr size_t O_WGT = O_WMO + 1024ull * 1024 * 2;
constexpr size_t O_WPT = O_WGT + 1024ull * 1024 * 2;
static_assert(O_WPT + 1024ull * 256 * 2 <= 64 * MiB, "weights");
constexpr size_t O_BAR = 60 * MiB;
constexpr size_t O_CS = 64 * MiB;
constexpr size_t O_PB = 96 * MiB;
constexpr size_t O_H = 128 * MiB;
constexpr size_t O_XB = 256 * MiB;
constexpr size_t O_HID = 384 * MiB;
constexpr size_t O_ALORA = 256 * MiB;
constexpr size_t O_WBUF = 608 * MiB;
constexpr size_t O_ABUF = 672 * MiB;
constexpr size_t O_GBUF = 736 * MiB;
constexpr size_t O_YRAW = 288 * MiB;
constexpr size_t O_Y = 832 * MiB;
constexpr size_t O_QROT = 256 * MiB;
constexpr size_t O_KROT = 320 * MiB;
constexpr size_t O_KTZ = 384 * MiB;
constexpr size_t O_VT = 448 * MiB;
constexpr size_t O_GSILU = 576 * MiB;
constexpr size_t O_RT = 704 * MiB;
constexpr size_t O_TMP = 256 * MiB;
constexpr size_t O_MERGED = 512 * MiB;
constexpr size_t O_PPROJ = 384 * MiB;
constexpr size_t O_PRE = 256 * MiB;
constexpr size_t WS_NEED = 1024 * MiB;
static_assert(O_ABUF == O_WBUF + 64 * MiB && O_GBUF == O_ABUF + 64 * MiB, "EpiLora addresses W/A/G by stride");

struct Params { const float* in[30]; float* out; unsigned char* ws; };

__device__ __forceinline__ float bf2f(u16 v) { return __uint_as_float((unsigned)v << 16); }
__device__ __forceinline__ float bflo(unsigned v) { return __uint_as_float(v << 16); }
__device__ __forceinline__ float bfhi(unsigned v) { return __uint_as_float(v & 0xffff0000u); }
__device__ __forceinline__ f32x4 ld_bf4(const u16* p) { const u32x2 t = *(const u32x2*)p; return (f32x4){bflo(t.x), bfhi(t.x), bflo(t.y), bfhi(t.y)}; }
__device__ __forceinline__ unsigned cvt_pk_bf16(float lo, float hi) { unsigned r; asm volatile("v_cvt_pk_bf16_f32 %0, %1, %2" : "=v"(r) : "v"(lo), "v"(hi)); return r; }
__device__ __forceinline__ float sigm(float x) { return __builtin_amdgcn_rcpf(1.f + __builtin_amdgcn_exp2f(-1.44269504f * x)); }
__device__ __forceinline__ float siluf(float x) { return x * sigm(x); }
#define DPP_ADD(x, ctrl) ((x) + __builtin_bit_cast(float, __builtin_amdgcn_update_dpp(0, __builtin_bit_cast(int, (x)), (ctrl), 0xF, 0xF, true)))
__device__ __forceinline__ float red16(float x) {
    x = DPP_ADD(x, 0xB1); x = DPP_ADD(x, 0x4E); x = DPP_ADD(x, 0x141); x = DPP_ADD(x, 0x140); return x;
}
__device__ __forceinline__ float wave_sum(float v) {
#pragma unroll
    for (int o = 1; o < 64; o <<= 1) v += __shfl_xor(v, o);
    return v;
}

namespace pg8 {
constexpr int BM = 256, BK = 64, HALF = 128, HTB = HALF * BK * 2, STAGE_BYTES = 8 * HTB, NXCD = 8, WGM = 8;
__device__ __forceinline__ int lds_byte(int r, int c) { const int st = (r >> 4) * 2 + (c >> 5), rr = r & 15, cc = c & 31, ob = rr * 64 + cc * 2; return st * 1024 + (ob ^ (((ob >> 9) & 1) << 5)); }
__device__ __forceinline__ void stage_rc(int b, int& R, int& C) { const int st = b / 1024, sb = b % 1024, swz = sb ^ (((sb >> 9) & 1) << 5); R = (st >> 1) * 16 + swz / 64; C = (st & 1) * 32 + (swz % 64) / 2; }
__device__ __forceinline__ int perm32(int rho) { const int n = rho >> 4, i = rho & 15; return 8 * (i >> 2) + 4 * n + (i & 3); }
struct Unit { int pm, pn, part; };
struct Gemm { const u16* A; const u16* Bt; int lda, ldb, K; };
struct StaticOrder {
    int nM, nN, nwg, G, c;
    __device__ void init(int M, int N, int G_, int c_) { nM = M / BM; nN = N / BM; nwg = nM * nN; G = G_; c = c_; }
    __device__ bool next(int i, Unit& u) const {
        const long L = (long)i * G + c; if (L >= nwg) return false;
        int wgid = (int)L; { const int q = nwg / NXCD, r = nwg % NXCD, xcd = wgid % NXCD, off = wgid / NXCD; wgid = (xcd < r ? xcd * (q + 1) : r * (q + 1) + (xcd - r) * q) + off; }
        const int nig = WGM * nN, gid = wgid / nig, fm = gid * WGM, gsz = (nM - fm) < WGM ? (nM - fm) : WGM;
        u.pm = fm + ((wgid % nig) % gsz); u.pn = (wgid % nig) / gsz; return true;
    }
};

template <class Epi, bool SPLIT = false>
__device__ __forceinline__ void gemm_phase(LAS unsigned char* lds, const Gemm g, const StaticOrder& S, const Epi& E, int splitK = 0) {
    int tid_ = threadIdx.x; asm volatile("" : "+v"(tid_));
    const int tid = tid_, wid = __builtin_amdgcn_readfirstlane(tid >> 6), lane = tid & 63, wr = wid >> 2, wc = wid & 3, fr = lane & 15, fq = lane >> 4;
    int K_ = g.K, lda_ = g.lda, ldb_ = g.ldb; asm volatile("" : "+s"(K_), "+s"(lda_), "+s"(ldb_));
    const int K = K_;
    int nt = SPLIT ? splitK / BK : K / BK;
    unsigned voffA[2], voffB[2];
#pragma unroll
    for (int i = 0; i < 2; ++i) { int R, C; stage_rc(tid * 16 + i * 8192, R, C); const int Rb = Epi::PERM ? ((R & ~31) + perm32(R & 31)) : R;
        voffA[i] = (unsigned)(R * lda_ + C) * 2u; voffB[i] = (unsigned)(Rb * ldb_ + C) * 2u; }
    const size_t kstep = (size_t)(BK * 2);
    const size_t hstepA = (size_t)HALF * lda_ * 2, hstepB = (size_t)HALF * ldb_ * 2;
    const size_t tstepA = 2 * hstepA, tstepB = 2 * hstepB;
    const unsigned ldsw = (unsigned)wid * 1024u;
    const int aoff = lds_byte(wr * 64 + fr, fq * 8), boff = lds_byte(wc * 32 + fr, fq * 8);
#define PG8_SA(b, h) (((b) * 2 + (h)) * HTB)
#define PG8_SB(b, h) ((4 + (b) * 2 + (h)) * HTB)
#define PG8_STAGE(bufoff, gbase, voff) do { _Pragma("unroll") for (int _i = 0; _i < 2; ++_i) \
        __builtin_amdgcn_global_load_lds((const unsigned*)((const char*)(gbase) + (voff)[_i]), (LAS unsigned*)(lds + (bufoff) + ldsw + _i * 8192), 16, 0, 0); } while (0)
#define PG8_LDA(dst, b, h) do { _Pragma("unroll") for (int m = 0; m < 4; ++m) _Pragma("unroll") for (int k = 0; k < 2; ++k) dst[m][k] = *(const LAS bf16x8*)(lds + PG8_SA(b, h) + aoff + m * 2048 + k * 1024); } while (0)
#define PG8_LDB(dst, b, h) do { _Pragma("unroll") for (int n = 0; n < 2; ++n) _Pragma("unroll") for (int k = 0; k < 2; ++k) dst[n][k] = *(const LAS bf16x8*)(lds + PG8_SB(b, h) + boff + n * 2048 + k * 1024); } while (0)
#define PG8_MMA(ai, bj, At, Bt) do { __builtin_amdgcn_s_setprio(1); _Pragma("unroll") for (int m = 0; m < 4; ++m) _Pragma("unroll") for (int n = 0; n < 2; ++n) _Pragma("unroll") for (int k = 0; k < 2; ++k) \
        acc[ai][bj][m][n] = __builtin_amdgcn_mfma_f32_16x16x32_bf16(Bt[n][k], At[m][k], acc[ai][bj][m][n], 0, 0, 0); __builtin_amdgcn_s_setprio(0); } while (0)
#define PG8_WAIT_V(n) asm volatile("s_waitcnt vmcnt(" #n ")" ::: "memory")
#define PG8_WAIT_L(n) asm volatile("s_waitcnt lgkmcnt(" #n ")" ::: "memory")
#define PG8_BAR __builtin_amdgcn_s_barrier()
#define PG8_SCHED __builtin_amdgcn_sched_barrier(0)
    Unit cur, nxt; int ui = 0;
    cur.part = 0; nxt.part = 0;
    if (!S.next(0, cur)) return;
    f32x4 acc[2][2][4][2];
#pragma unroll
    for (int a = 0; a < 2; ++a)
#pragma unroll
        for (int b = 0; b < 2; ++b)
#pragma unroll
            for (int m = 0; m < 4; ++m)
#pragma unroll
                for (int n = 0; n < 2; ++n) acc[a][b][m][n] = (f32x4){0.f, 0.f, 0.f, 0.f};
    bf16x8 At[4][2], B0[2][2], B1[2][2];
    const char* cA = (const char*)g.A + (size_t)cur.pm * tstepA; const char* cB = (const char*)g.Bt + (size_t)cur.pn * tstepB;
    const size_t poff = (size_t)splitK * 2;
    PG8_STAGE(PG8_SB(0, 0), cB, voffB); PG8_STAGE(PG8_SA(0, 0), cA, voffA); PG8_STAGE(PG8_SB(0, 1), cB + hstepB, voffB); PG8_STAGE(PG8_SA(0, 1), cA + hstepA, voffA);
    if (wr == 1) PG8_BAR;
    PG8_WAIT_V(4); PG8_BAR;
    PG8_STAGE(PG8_SB(1, 0), cB + kstep, voffB); PG8_STAGE(PG8_SA(1, 0), cA + kstep, voffA); PG8_STAGE(PG8_SB(1, 1), cB + hstepB + kstep, voffB);
    PG8_WAIT_V(6); PG8_BAR;
    for (;;) {
        bool has_next;
        if constexpr (SPLIT) { has_next = S.next((ui + 1) >> 1, nxt); nxt.part = (ui + 1) & 1; } else has_next = S.next(ui + 1, nxt);
        const char* nA = has_next ? (const char*)g.A + (size_t)nxt.pm * tstepA + (SPLIT && nxt.part ? poff : 0) : cA;
        const char* nB = has_next ? (const char*)g.Bt + (size_t)nxt.pn * tstepB + (SPLIT && nxt.part ? poff : 0) : cB;
        for (int t = 0; t < nt; t += 2) {
            const bool last = (t == nt - 2);
            const char* a1 = cA + (size_t)(t + 1) * kstep;
            const char* a2 = last ? nA : cA + (size_t)(t + 2) * kstep; const char* b2 = last ? nB : cB + (size_t)(t + 2) * kstep;
            const char* a3 = a2 + kstep; const char* b3 = b2 + kstep;
            PG8_LDB(B0, 0, 0); PG8_SCHED; PG8_LDA(At, 0, 0); PG8_STAGE(PG8_SA(1, 1), a1 + hstepA, voffA);
            PG8_WAIT_L(8); PG8_BAR; PG8_WAIT_L(0); PG8_MMA(0, 0, At, B0); PG8_BAR; PG8_SCHED;
            PG8_LDB(B1, 0, 1); PG8_STAGE(PG8_SB(0, 0), b2, voffB);
            PG8_BAR; PG8_WAIT_L(0); PG8_MMA(0, 1, At, B1); PG8_BAR;
            PG8_LDA(At, 0, 1); PG8_STAGE(PG8_SA(0, 0), a2, voffA);
            PG8_BAR; PG8_WAIT_L(0); PG8_MMA(1, 0, At, B0); PG8_BAR; PG8_SCHED;
            PG8_STAGE(PG8_SB(0, 1), b2 + hstepB, voffB);
            PG8_WAIT_V(6); PG8_BAR; PG8_MMA(1, 1, At, B1); PG8_BAR;
            PG8_LDB(B0, 1, 0); PG8_SCHED; PG8_LDA(At, 1, 0); PG8_STAGE(PG8_SA(0, 1), a2 + hstepA, voffA);
            PG8_WAIT_L(8); PG8_BAR; PG8_WAIT_L(0); PG8_MMA(0, 0, At, B0); PG8_BAR; PG8_SCHED;
            PG8_LDB(B1, 1, 1); PG8_STAGE(PG8_SB(1, 0), b3, voffB);
            PG8_BAR; PG8_WAIT_L(0); PG8_MMA(0, 1, At, B1); PG8_BAR;
            PG8_LDA(At, 1, 1); PG8_STAGE(PG8_SA(1, 0), a3, voffA);
            PG8_BAR; PG8_WAIT_L(0); PG8_MMA(1, 0, At, B0); PG8_BAR; PG8_SCHED;
            PG8_STAGE(PG8_SB(1, 1), b3 + hstepB, voffB);
            PG8_WAIT_V(6); PG8_BAR; PG8_MMA(1, 1, At, B1); PG8_BAR;
        }
        E(acc, cur, wr, wc, fr, fq);
        if (!has_next) break;
        if (!SPLIT || cur.part == 1) {
#pragma unroll
            for (int a = 0; a < 2; ++a)
#pragma unroll
                for (int b = 0; b < 2; ++b)
#pragma unroll
                    for (int m = 0; m < 4; ++m)
#pragma unroll
                        for (int n = 0; n < 2; ++n) acc[a][b][m][n] = (f32x4){0.f, 0.f, 0.f, 0.f};
        }
        cur = nxt; cA = nA; cB = nB; ++ui;
        if constexpr (SPLIT) nt = cur.part ? (K - splitK) / BK : splitK / BK;
    }
    PG8_WAIT_V(0);
    if (wr == 0) PG8_BAR;
    PG8_BAR;
#undef PG8_SA
#undef PG8_SB
#undef PG8_STAGE
#undef PG8_LDA
#undef PG8_LDB
#undef PG8_MMA
#undef PG8_WAIT_V
#undef PG8_WAIT_L
#undef PG8_BAR
#undef PG8_SCHED
}
}
using pg8::Unit;
typedef f32x4 AccT[2][2][4][2];

struct EpiFfnIn {
    static constexpr bool PERM = true;
    u16* hid;
    __device__ __forceinline__ void operator()(const AccT& acc, const Unit& u, int wr, int wc, int fr, int fq) const {
        const int row0 = u.pm * 256 + wr * 64 + fr, col0 = u.pn * 128 + wc * 32 + 8 * fq;
#pragma unroll
        for (int ai = 0; ai < 2; ++ai)
#pragma unroll
            for (int m = 0; m < 4; ++m) {
                u16* rowp = hid + (size_t)(row0 + ai * 128 + m * 16) * FF + col0;
                const f32x4 g0 = acc[ai][0][m][0], g1 = acc[ai][0][m][1], u0 = acc[ai][1][m][0], u1 = acc[ai][1][m][1];
                u32x4 w;
                w.x = cvt_pk_bf16(siluf(g0[0]) * u0[0], siluf(g0[1]) * u0[1]); w.y = cvt_pk_bf16(siluf(g0[2]) * u0[2], siluf(g0[3]) * u0[3]);
                w.z = cvt_pk_bf16(siluf(g1[0]) * u1[0], siluf(g1[1]) * u1[1]); w.w = cvt_pk_bf16(siluf(g1[2]) * u1[2], siluf(g1[3]) * u1[3]);
                *(u32x4*)rowp = w;
            }
    }
};
struct EpiRes {
    static constexpr bool PERM = false;
    u16* pre; const float* resf; const u16* resb; float alpha, scale;
    __device__ __forceinline__ void operator()(const AccT& acc, const Unit& u, int wr, int wc, int fr, int fq) const {
        const int row0 = u.pm * 256 + wr * 64 + fr, col0 = u.pn * 256 + wc * 32 + 4 * fq;
#pragma unroll
        for (int ai = 0; ai < 2; ++ai)
#pragma unroll
            for (int m = 0; m < 4; ++m) {
                const size_t off = (size_t)(row0 + ai * 128 + m * 16) * DM + col0;
#pragma unroll
                for (int bj = 0; bj < 2; ++bj)
#pragma unroll
                    for (int n = 0; n < 2; ++n) {
                        f32x4 r;
                        if (resf) r = *(const f32x4*)(resf + off + bj * 128 + n * 16);
                        else r = ld_bf4(resb + off + bj * 128 + n * 16);
                        const f32x4 o = r * alpha + acc[ai][bj][m][n] * scale;
                        u32x2 w; w.x = cvt_pk_bf16(o[0], o[1]); w.y = cvt_pk_bf16(o[2], o[3]);
                        *(u32x2*)(pre + off + bj * 128 + n * 16) = w;
                    }
                asm volatile("" ::: "memory");
            }
    }
};
struct EpiMix {
    static constexpr bool PERM = true;
    int pn0; u16* zr; u16* qrot; u16* krot; u16* ktz; u16* vt; u16* gsilu; u16* gate; const f32x2* cs;
    __device__ __forceinline__ void operator()(const AccT& acc, const Unit& u, int wr, int wc, int fr, int fq) const {
        const int T = pn0 + u.pn;
        const int row0 = u.pm * 256 + wr * 64 + fr, c8 = wc * 32 + 8 * fq;
        if (T < 7 || T >= 15) {
            u16* base; int ld, colt, act;
            if (T < 7) { base = zr; ld = 1792; colt = T * 256; act = 0; }
            else if (T < 19) { base = gsilu; ld = 1024; colt = (T - 15) * 256; act = 1; }
            else { base = gate; ld = 2048; colt = (T - 19) * 256; act = 2; }
#pragma unroll
            for (int ai = 0; ai < 2; ++ai)
#pragma unroll
                for (int m = 0; m < 4; ++m) {
                    u16* rowp = base + (size_t)(row0 + ai * 128 + m * 16) * ld + colt + c8;
#pragma unroll
                    for (int bj = 0; bj < 2; ++bj) {
                        f32x4 v0 = acc[ai][bj][m][0], v1 = acc[ai][bj][m][1];
                        if (act == 1) {
#pragma unroll
                            for (int j = 0; j < 4; ++j) { v0[j] = siluf(v0[j]); v1[j] = siluf(v1[j]); }
                        } else if (act == 2) {
#pragma unroll
                            for (int j = 0; j < 4; ++j) { v0[j] = sigm(v0[j]); v1[j] = sigm(v1[j]); }
                        }
                        u32x4 w; w.x = cvt_pk_bf16(v0[0], v0[1]); w.y = cvt_pk_bf16(v0[2], v0[3]); w.z = cvt_pk_bf16(v1[0], v1[1]); w.w = cvt_pk_bf16(v1[2], v1[3]);
                        *(u32x4*)(rowp + bj * 128) = w;
                    }
                    asm volatile("" ::: "memory");
                }
        } else if (T < 11) {
            const bool isk = T >= 9; const int t = isk ? T - 9 : T - 7;
            const int head = 2 * t + (wc >> 1), idx0 = 32 * (wc & 1) + 8 * fq;
            const float sc = isk ? 0.08838834764831845f : 1.0f;
            const float l2g = __log2f(1.0f - __builtin_amdgcn_exp2f((float)(-5 - head)));
#pragma unroll
            for (int ai = 0; ai < 2; ++ai)
#pragma unroll
                for (int m = 0; m < 4; ++m) {
                    const int row = row0 + ai * 128 + m * 16;
                    const f32x4* cp = (const f32x4*)(cs + (size_t)row * 64 + idx0);
                    float o1[8], o2[8];
#pragma unroll
                    for (int q = 0; q < 4; ++q) {
                        const f32x4 c2 = cp[q];
                        const int n = q >> 1, j = (q & 1) * 2;
                        const float xa = acc[ai][0][m][n][j], xb = acc[ai][1][m][n][j], ya = acc[ai][0][m][n][j + 1], yb = acc[ai][1][m][n][j + 1];
                        o1[2 * q] = (xa * c2[0] - xb * c2[1]) * sc; o2[2 * q] = (xb * c2[0] + xa * c2[1]) * sc;
                        o1[2 * q + 1] = (ya * c2[2] - yb * c2[3]) * sc; o2[2 * q + 1] = (yb * c2[2] + ya * c2[3]) * sc;
                    }
                    u16* np = (isk ? krot : qrot) + (size_t)row * 512 + head * 128 + idx0;
                    u32x4 w; w.x = cvt_pk_bf16(o1[0], o1[1]); w.y = cvt_pk_bf16(o1[2], o1[3]); w.z = cvt_pk_bf16(o1[4], o1[5]); w.w = cvt_pk_bf16(o1[6], o1[7]);
                    *(u32x4*)np = w;
                    w.x = cvt_pk_bf16(o2[0], o2[1]); w.y = cvt_pk_bf16(o2[2], o2[3]); w.z = cvt_pk_bf16(o2[4], o2[5]); w.w = cvt_pk_bf16(o2[6], o2[7]);
                    *(u32x4*)(np + 64) = w;
                    if (isk) {
                        const int b = row >> 13, s = row & 8191, chunk = s >> 7, mm = s & 127;
                        const float zeta = __builtin_amdgcn_exp2f(l2g * (float)(127 - mm));
                        u16* tp = ktz + ((size_t)((b * 4 + head) * 64 + chunk) * 128 + idx0) * 128 + mm;
#pragma unroll
                        for (int i = 0; i < 8; ++i) {
                            tp[(size_t)i * 128] = (u16)(cvt_pk_bf16(o1[i] * zeta, 0.f) & 0xffffu);
                            tp[(size_t)(64 + i) * 128] = (u16)(cvt_pk_bf16(o2[i] * zeta, 0.f) & 0xffffu);
                        }
                    }
                    asm volatile("" ::: "memory");
                }
        } else {
            const int head = T - 11;
#pragma unroll
            for (int ai = 0; ai < 2; ++ai)
#pragma unroll
                for (int m = 0; m < 4; ++m) {
                    const int row = row0 + ai * 128 + m * 16;
                    const int b = row >> 13, s = row & 8191, chunk = s >> 7, mm = s & 127;
                    u16* tp = vt + ((size_t)((b * 4 + head) * 64 + chunk) * 256 + c8) * 128 + mm;
#pragma unroll
                    for (int bj = 0; bj < 2; ++bj)
#pragma unroll
                        for (int n = 0; n < 2; ++n)
#pragma unroll
                            for (int j = 0; j < 4; ++j)
                                tp[(size_t)(bj * 128 + 4 * n + j) * 128] = (u16)(cvt_pk_bf16(acc[ai][bj][m][n][j], 0.f) & 0xffffu);
                    asm volatile("" ::: "memory");
                }
        }
    }
};
struct EpiLora {
    static constexpr bool PERM = true;
    _Float16* wbuf; _Float16* abuf; _Float16* gbuf; const float* w0; const float* a0;
    __device__ __forceinline__ void operator()(const AccT& acc, const Unit& u, int wr, int wc, int fr, int fq) const {
        const int kind = u.pn >> 1;
        const int row0 = u.pm * 256 + wr * 64 + fr, ch0 = (u.pn & 1) * 256 + wc * 32 + 8 * fq;
        _Float16* dst = wbuf + (size_t)kind * (size_t)(32u << 20);
        const float* bias = kind == 0 ? w0 : a0;
#pragma unroll
        for (int bj = 0; bj < 2; ++bj) {
            const int ch = ch0 + bj * 128;
            f32x4 b0 = {0.f, 0.f, 0.f, 0.f}, b1 = b0;
            if (kind < 2) { b0 = *(const f32x4*)(bias + ch); b1 = *(const f32x4*)(bias + ch + 4); }
#pragma unroll
            for (int ai = 0; ai < 2; ++ai)
#pragma unroll
                for (int m = 0; m < 4; ++m) {
                    const int row = row0 + ai * 128 + m * 16;
                    f32x4 v0 = acc[ai][bj][m][0] + b0, v1 = acc[ai][bj][m][1] + b1;
                    if (kind < 2) {
#pragma unroll
                        for (int j = 0; j < 4; ++j) { v0[j] = sigm(v0[j]); v1[j] = sigm(v1[j]); }
                    }
                    if (kind == 0) {
#pragma unroll
                        for (int j = 0; j < 4; ++j) { v0[j] = __builtin_amdgcn_exp2f(-DECAY_SCALE * 1.44269504f * v0[j]); v1[j] = __builtin_amdgcn_exp2f(-DECAY_SCALE * 1.44269504f * v1[j]); }
                    }
                    *(h16x8*)(dst + (size_t)row * 512 + ch) = (h16x8){(_Float16)v0[0], (_Float16)v0[1], (_Float16)v0[2], (_Float16)v0[3], (_Float16)v1[0], (_Float16)v1[1], (_Float16)v1[2], (_Float16)v1[3]};
                    asm volatile("" ::: "memory"); __builtin_amdgcn_sched_barrier(0);
                }
        }
    }
};
struct EpiBr {
    static constexpr bool PERM = true;
    const u16* gate; u16* merged;
    __device__ __forceinline__ void operator()(AccT& acc, const Unit& u, int wr, int wc, int fr, int fq) const {
        if (u.part == 0) scale(acc, u, wr, wc, fr, fq); else store(acc, u, wr, wc, fr, fq);
    }
    __device__ __forceinline__ void scale(AccT& acc, const Unit& u, int wr, int wc, int fr, int fq) const {
        const int row0 = u.pm * 256 + wr * 64 + fr, col0 = u.pn * 256 + wc * 32 + 8 * fq;
#pragma unroll
        for (int ai = 0; ai < 2; ++ai)
#pragma unroll
            for (int m = 0; m < 4; ++m) {
                const int row = row0 + ai * 128 + m * 16;
#pragma unroll
                for (int bj = 0; bj < 2; ++bj) {
                    const int c = col0 + bj * 128;
                    const u32x4 g1 = *(const u32x4*)(gate + (size_t)row * 2048 + c), g2 = *(const u32x4*)(gate + (size_t)row * 2048 + 1024 + c);
                    f32x4 r0, r1;
                    r0[0] = bflo(g1.x) * __builtin_amdgcn_rcpf(bflo(g2.x)); r0[1] = bfhi(g1.x) * __builtin_amdgcn_rcpf(bfhi(g2.x));
                    r0[2] = bflo(g1.y) * __builtin_amdgcn_rcpf(bflo(g2.y)); r0[3] = bfhi(g1.y) * __builtin_amdgcn_rcpf(bfhi(g2.y));
                    r1[0] = bflo(g1.z) * __builtin_amdgcn_rcpf(bflo(g2.z)); r1[1] = bfhi(g1.z) * __builtin_amdgcn_rcpf(bfhi(g2.z));
                    r1[2] = bflo(g1.w) * __builtin_amdgcn_rcpf(bflo(g2.w)); r1[3] = bfhi(g1.w) * __builtin_amdgcn_rcpf(bfhi(g2.w));
                    acc[ai][bj][m][0] = acc[ai][bj][m][0] * r0; acc[ai][bj][m][1] = acc[ai][bj][m][1] * r1;
                    asm volatile("" ::: "memory"); __builtin_amdgcn_sched_barrier(0);
                }
            }
    }
    __device__ __forceinline__ void store(const AccT& acc, const Unit& u, int wr, int wc, int fr, int fq) const {
        const int row0 = u.pm * 256 + wr * 64 + fr, col0 = u.pn * 256 + wc * 32 + 8 * fq;
#pragma unroll
        for (int ai = 0; ai < 2; ++ai)
#pragma unroll
            for (int m = 0; m < 4; ++m) {
                const int row = row0 + ai * 128 + m * 16;
#pragma unroll
                for (int bj = 0; bj < 2; ++bj) {
                    const int c = col0 + bj * 128;
                    const u32x4 gv = *(const u32x4*)(gate + (size_t)row * 2048 + 1024 + c);
                    const f32x4 g0 = {bflo(gv.x), bfhi(gv.x), bflo(gv.y), bfhi(gv.y)}, g1 = {bflo(gv.z), bfhi(gv.z), bflo(gv.w), bfhi(gv.w)};
                    const f32x4 v0 = g0 * acc[ai][bj][m][0], v1 = g1 * acc[ai][bj][m][1];
                    u32x4 w; w.x = cvt_pk_bf16(v0[0], v0[1]); w.y = cvt_pk_bf16(v0[2], v0[3]); w.z = cvt_pk_bf16(v1[0], v1[1]); w.w = cvt_pk_bf16(v1[2], v1[3]);
                    *(u32x4*)(merged + (size_t)row * DM + c) = w;
                }
                asm volatile("" ::: "memory");
            }
    }
};
struct EpiFin {
    static constexpr bool PERM = false;
    int mode; float* out; u16* pproj;
    __device__ __forceinline__ void operator()(const AccT& acc, const Unit& u, int wr, int wc, int fr, int fq) const {
        const int row0 = u.pm * 256 + wr * 64 + fr, col0 = u.pn * 256 + wc * 32 + 4 * fq;
#pragma unroll
        for (int ai = 0; ai < 2; ++ai)
#pragma unroll
            for (int m = 0; m < 4; ++m) {
                const size_t off = (size_t)(row0 + ai * 128 + m * 16) * DM + col0;
#pragma unroll
                for (int bj = 0; bj < 2; ++bj)
#pragma unroll
                    for (int n = 0; n < 2; ++n) {
                        const size_t o = off + bj * 128 + n * 16;
                        const f32x4 a = acc[ai][bj][m][n];
                        if (mode == 0) { u32x2 w; w.x = cvt_pk_bf16(a[0], a[1]); w.y = cvt_pk_bf16(a[2], a[3]); *(u32x2*)(pproj + o) = w; }
                        else {
                            const f32x4 pp = ld_bf4(pproj + o), h = *(const f32x4*)(out + o);
                            f32x4 r; r[0] = h[0] + sigm(a[0]) * pp[0]; r[1] = h[1] + sigm(a[1]) * pp[1]; r[2] = h[2] + sigm(a[2]) * pp[2]; r[3] = h[3] + sigm(a[3]) * pp[3];
                            *(f32x4*)(out + o) = r;
                        }
                    }
                asm volatile("" ::: "memory");
            }
    }
};

__device__ __forceinline__ int map_row(int mode, int n) {
    if (mode == 1) { const int bj = n >= FF ? 1 : 0, cc = n - bj * FF; return (cc >> 7) * 256 + bj * 128 + (cc & 127); }
    if (mode == 2) {
        if (n < 1792 || n >= 2816) return n;
        const int base = n < 2304 ? 1792 : 2304, c = n - base, head = c >> 7, half = (c >> 6) & 1, idx = c & 63;
        return base + 256 * (head >> 1) + 128 * half + 64 * (head & 1) + idx;
    }
    return n;
}
__device__ __forceinline__ void conv_weight(const float* W, int K, int N, u16* dst, int mode, size_t gtid, size_t gth, int ldk = 0) {
    if (ldk == 0) ldk = K;
    const size_t total = (size_t)N * (K >> 3);
    for (size_t idx = gtid; idx < total; idx += gth) {
        const int n = (int)(idx % N), kc = (int)(idx / N);
        const float* s = W + (size_t)(kc * 8) * N + n;
        float v[8];
#pragma unroll
        for (int i = 0; i < 8; ++i) v[i] = s[(size_t)i * N];
        u32x4 w; w.x = cvt_pk_bf16(v[0], v[1]); w.y = cvt_pk_bf16(v[2], v[3]); w.z = cvt_pk_bf16(v[4], v[5]); w.w = cvt_pk_bf16(v[6], v[7]);
        *(u32x4*)(dst + (size_t)map_row(mode, n) * ldk + kc * 8) = w;
    }
}
__device__ __forceinline__ void conv_rows(const float* __restrict__ src, u16* __restrict__ dst, size_t n8, size_t gtid, size_t gth) {
    for (size_t i = gtid; i < n8; i += 4 * gth) {
        f32x4 a[4], b[4];
#pragma unroll
        for (int u = 0; u < 4; ++u) { const size_t j = i + u * gth; if (j < n8) { a[u] = *(const f32x4*)(src + j * 8); b[u] = *(const f32x4*)(src + j * 8 + 4); } }
#pragma unroll
        for (int u = 0; u < 4; ++u) { const size_t j = i + u * gth; if (j < n8) {
            u32x4 w; w.x = cvt_pk_bf16(a[u][0], a[u][1]); w.y = cvt_pk_bf16(a[u][2], a[u][3]); w.z = cvt_pk_bf16(b[u][0], b[u][1]); w.w = cvt_pk_bf16(b[u][2], b[u][3]);
            *(u32x4*)(dst + j * 8) = w; } }
    }
}
__device__ __forceinline__ void phase_convert(const Params& P, size_t gtid, size_t gth) {
    unsigned char* ws = P.ws;
    conv_rows(P.in[0], (u16*)(ws + O_XB), (size_t)MTOK * DM / 8, gtid, gth);
    conv_rows(P.in[1], (u16*)(ws + O_PB), (size_t)MTOK * 256 / 8, gtid, gth);
    conv_weight(P.in[5], DM, 2 * FF, (u16*)(ws + O_W1T), 1, gtid, gth);
    conv_weight(P.in[6], FF, DM, (u16*)(ws + O_W2T), 0, gtid, gth);
    conv_weight(P.in[7], DM, MIXN, (u16*)(ws + O_WMT), 2, gtid, gth);
    conv_weight(P.in[24], DM, 2 * FF, (u16*)(ws + O_W3T), 1, gtid, gth);
    conv_weight(P.in[25], FF, DM, (u16*)(ws + O_W4T), 0, gtid, gth);
    conv_weight(P.in[19], 512, DM, (u16*)(ws + O_WBR), 0, gtid, gth, 1536);
    conv_weight(P.in[20], DM, DM, (u16*)(ws + O_WBR) + 512, 0, gtid, gth, 1536);
    conv_weight(P.in[21], DM, DM, (u16*)(ws + O_WMO), 0, gtid, gth);
    conv_weight(P.in[29], DM, DM, (u16*)(ws + O_WGT), 0, gtid, gth);
    conv_weight(P.in[28], 256, DM, (u16*)(ws + O_WPT), 0, gtid, gth);
    {
        u16* dst = (u16*)(ws + O_WLT);
        for (size_t idx = gtid; idx < 1536 * 32; idx += gth) {
            const int n = (int)(idx % 1536), kc = (int)(idx / 1536), k0 = kc * 8;
            float v[8];
#pragma unroll
            for (int i = 0; i < 8; ++i) v[i] = 0.f;
            if (n < 512) { if (k0 < 64) {
#pragma unroll
                for (int i = 0; i < 8; ++i) v[i] = P.in[10][(size_t)(k0 + i) * 512 + n]; } }
            else if (n < 1024) { if (k0 >= 64 && k0 < 128) {
#pragma unroll
                for (int i = 0; i < 8; ++i) v[i] = P.in[12][(size_t)(k0 - 64 + i) * 512 + (n - 512)]; } }
            else { if (k0 >= 128) {
#pragma unroll
                for (int i = 0; i < 8; ++i) v[i] = P.in[13][(size_t)(k0 - 128 + i) * 512 + (n - 1024)]; } }
            u32x4 w; w.x = cvt_pk_bf16(v[0], v[1]); w.y = cvt_pk_bf16(v[2], v[3]); w.z = cvt_pk_bf16(v[4], v[5]); w.w = cvt_pk_bf16(v[6], v[7]);
            *(u32x4*)(dst + (size_t)n * 256 + k0) = w;
        }
    }
    {
        f32x2* cs = (f32x2*)(ws + O_CS); const int* pos = (const int*)P.in[2];
        for (size_t idx = gtid; idx < (size_t)MTOK * 64; idx += gth) {
            const int tok = (int)(idx >> 6), i = (int)(idx & 63);
            const float invf = exp2f(-(float)i * (13.287712379549449f / 64.0f));
            const float ang = (float)pos[tok] * invf;
            const double a = (double)ang; const double kq = rint(a * 0.6366197723675814); const float r = (float)(a - kq * 1.5707963267948966);
            const int q = (int)((long long)kq & 3);
            const float r2 = r * r;
            const float sn = r + r * r2 * (-1.6666667e-1f + r2 * (8.3333333e-3f + r2 * (-1.9841270e-4f + r2 * 2.7557319e-6f)));
            const float cn = 1.0f + r2 * (-0.5f + r2 * (4.1666668e-2f + r2 * (-1.3888889e-3f + r2 * (2.4801587e-5f - r2 * 2.7557319e-7f))));
            float c, s;
            if (q == 0) { c = cn; s = sn; } else if (q == 1) { c = -sn; s = cn; } else if (q == 2) { c = -cn; s = -sn; } else { c = sn; s = -cn; }
            cs[idx] = (f32x2){c, s};
        }
    }
}

__device__ __forceinline__ void phase_ln(const u16* pre, const float* g, const float* b, u16* hb, float* hf, int gw, int ngw, int lane) {
    f32x4 gv[4], bv[4];
#pragma unroll
    for (int j = 0; j < 4; ++j) { gv[j] = *(const f32x4*)(g + 4 * lane + 256 * j); bv[j] = *(const f32x4*)(b + 4 * lane + 256 * j); }
    for (int row = gw; row < MTOK; row += 2 * ngw) {
        const int row2 = row + ngw;
        const u16* xr = pre + (size_t)row * DM + 4 * lane; const u16* xr2 = pre + (size_t)row2 * DM + 4 * lane;
        f32x4 v[4], v2[4]; float s = 0.f, t = 0.f;
#pragma unroll
        for (int j = 0; j < 4; ++j) { v[j] = ld_bf4(xr + 256 * j); v2[j] = ld_bf4(xr2 + 256 * j); }
#pragma unroll
        for (int j = 0; j < 4; ++j) { s += (v[j][0] + v[j][1]) + (v[j][2] + v[j][3]); t += (v2[j][0] + v2[j][1]) + (v2[j][2] + v2[j][3]); }
        const float mean = wave_sum(s) * (1.f / DM), mean2 = wave_sum(t) * (1.f / DM); float s2 = 0.f, t2 = 0.f;
#pragma unroll
        for (int j = 0; j < 4; ++j) { v[j] = v[j] - mean; s2 += (v[j][0] * v[j][0] + v[j][1] * v[j][1]) + (v[j][2] * v[j][2] + v[j][3] * v[j][3]);
                                      v2[j] = v2[j] - mean2; t2 += (v2[j][0] * v2[j][0] + v2[j][1] * v2[j][1]) + (v2[j][2] * v2[j][2] + v2[j][3] * v2[j][3]); }
        const float rstd = 1.0f / sqrtf(wave_sum(s2) * (1.f / DM) + LN_EPS), rstd2 = 1.0f / sqrtf(wave_sum(t2) * (1.f / DM) + LN_EPS);
#pragma unroll
        for (int j = 0; j < 4; ++j) {
            const f32x4 o = v[j] * rstd * gv[j] + bv[j], o2 = v2[j] * rstd2 * gv[j] + bv[j];
            u32x2 w; w.x = cvt_pk_bf16(o[0], o[1]); w.y = cvt_pk_bf16(o[2], o[3]);
            *(u32x2*)(hb + (size_t)row * DM + 4 * lane + 256 * j) = w;
            w.x = cvt_pk_bf16(o2[0], o2[1]); w.y = cvt_pk_bf16(o2[2], o2[3]);
            *(u32x2*)(hb + (size_t)row2 * DM + 4 * lane + 256 * j) = w;
            if (hf) { *(f32x4*)(hf + (size_t)row * DM + 4 * lane + 256 * j) = o; *(f32x4*)(hf + (size_t)row2 * DM + 4 * lane + 256 * j) = o2; }
        }
    }
}

__device__ __forceinline__ void phase_lora_prep(const u16* __restrict__ zr, const float* __restrict__ mu, u16* __restrict__ alora, size_t gtid, size_t gth) {
    const int c = (int)(gtid & 31) * 8;
    const f32x4 m0 = *(const f32x4*)(mu + 1536 + c), m1 = *(const f32x4*)(mu + 1536 + c + 4);
    for (size_t idx = gtid; idx < (size_t)MTOK * 32; idx += 4 * gth) {
        u32x4 z[4], zp[4];
#pragma unroll
        for (int u = 0; u < 4; ++u) {
            const int tok = (int)((idx + u * gth) >> 5);
            z[u] = *(const u32x4*)(zr + (size_t)tok * 1792 + 1536 + c);
            zp[u] = ((tok & (SEQ - 1)) != 0) ? *(const u32x4*)(zr + (size_t)(tok - 1) * 1792 + 1536 + c) : (u32x4){0u, 0u, 0u, 0u};
        }
#pragma unroll
        for (int u = 0; u < 4; ++u) {
            const int tok = (int)((idx + u * gth) >> 5);
            const f32x4 a0 = {bflo(z[u].x), bfhi(z[u].x), bflo(z[u].y), bfhi(z[u].y)}, a1 = {bflo(z[u].z), bfhi(z[u].z), bflo(z[u].w), bfhi(z[u].w)};
            const f32x4 p0 = {bflo(zp[u].x), bfhi(zp[u].x), bflo(zp[u].y), bfhi(zp[u].y)}, p1 = {bflo(zp[u].z), bfhi(zp[u].z), bflo(zp[u].w), bfhi(zp[u].w)};
            f32x4 v0 = a0 + (p0 - a0) * m0, v1 = a1 + (p1 - a1) * m1;
            if (c < 64) {
#pragma unroll
                for (int j = 0; j < 4; ++j) { v0[j] = 2.f * sigm(2.f * v0[j]) - 1.f; v1[j] = 2.f * sigm(2.f * v1[j]) - 1.f; }
            } else if (c >= 128) {
#pragma unroll
                for (int j = 0; j < 4; ++j) { v0[j] = sigm(v0[j]); v1[j] = sigm(v1[j]); }
            }
            u32x4 w; w.x = cvt_pk_bf16(v0[0], v0[1]); w.y = cvt_pk_bf16(v0[2], v0[3]); w.z = cvt_pk_bf16(v1[0], v1[1]); w.w = cvt_pk_bf16(v1[2], v1[3]);
            *(u32x4*)(alora + (size_t)tok * 256 + c) = w;
        }
    }
}
struct RwkvConst { f32x4 mur, muk, muv, kk_, ka_; };
__device__ __forceinline__ RwkvConst rwkv_const(const float* mu, const float* k_k, const float* k_a, int ch) {
    RwkvConst c; c.mur = *(const f32x4*)(mu + ch); c.muk = *(const f32x4*)(mu + 512 + ch); c.muv = *(const f32x4*)(mu + 1024 + ch); c.kk_ = *(const f32x4*)(k_k + ch); c.ka_ = *(const f32x4*)(k_a + ch); return c;
}
struct RwkvRaw { u32x2 zr_, zk_, zv_, pr_, pk_, pv_; h16x4 ah; };
__device__ __forceinline__ f32x4 bf4(const u32x2 t) { return (f32x4){bflo(t.x), bfhi(t.x), bflo(t.y), bfhi(t.y)}; }
__device__ __forceinline__ RwkvRaw rwkv_load(const u16* zr, const _Float16* abuf, int tok, int ch) {
    const bool first = (tok & (SEQ - 1)) == 0;
    const u16* zt = zr + (size_t)tok * 1792 + ch; const u16* zq = first ? zt : zt - 1792;
    RwkvRaw w; w.zr_ = *(const u32x2*)zt; w.zk_ = *(const u32x2*)(zt + 512); w.zv_ = *(const u32x2*)(zt + 1024);
    w.pr_ = *(const u32x2*)zq; w.pk_ = *(const u32x2*)(zq + 512); w.pv_ = *(const u32x2*)(zq + 1024);
    w.ah = *(const h16x4*)(abuf + (size_t)tok * 512 + ch);
    return w;
}
__device__ __forceinline__ void rwkv_compute(const RwkvRaw& w, int tok, const RwkvConst& c, f32x4& r, f32x4& kh, f32x4& v, f32x4& kk, f32x4& bb) {
    const bool first = (tok & (SEQ - 1)) == 0;
    r = bf4(w.zr_); f32x4 k = bf4(w.zk_); v = bf4(w.zv_);
    f32x4 rp = bf4(w.pr_), kp = bf4(w.pk_), vp = bf4(w.pv_);
    if (first) { rp = (f32x4){0.f, 0.f, 0.f, 0.f}; kp = rp; vp = rp; }
    r = r + (rp - r) * c.mur; k = k + (kp - k) * c.muk; v = v + (vp - v) * c.muv;
    const f32x4 a = {(float)w.ah[0], (float)w.ah[1], (float)w.ah[2], (float)w.ah[3]};
    kk = k * c.kk_;
    const float ss = red16((kk[0] * kk[0] + kk[1] * kk[1]) + (kk[2] * kk[2] + kk[3] * kk[3]));
    kk = kk * __builtin_amdgcn_rsqf(fmaxf(ss, 1e-24f));
    kh = k * (1.0f + (a - 1.0f) * c.ka_); bb = kk * a;
}
__device__ __forceinline__ void rwkv_prep(const u16* zr, const _Float16* abuf, int tok, int ch, const RwkvConst& c, f32x4& r, f32x4& kh, f32x4& v, f32x4& kk, f32x4& bb) {
    const RwkvRaw w = rwkv_load(zr, abuf, tok, ch); rwkv_compute(w, tok, c, r, kh, v, kk, bb);
}
__device__ __forceinline__ void scan_load(const u16* zr, const _Float16* wbuf, const _Float16* abuf, int tok0, int pst, int pch, int c, RwkvRaw (&raw)[2], h16x4 (&wv)[2]) {
#pragma unroll
    for (int half = 0; half < 2; ++half) {
        const int tok = tok0 + c * 32 + pst + 16 * half;
        raw[half] = rwkv_load(zr, abuf, tok, pch);
        wv[half] = *(const h16x4*)(wbuf + (size_t)tok * 512 + pch);
    }
}
__device__ __forceinline__ void scan_write(LAS _Float16* lds, const RwkvConst& rc, int tok0, int pst, int pks, int c, int bufi, const RwkvRaw (&raw)[2], const h16x4 (&wv)[2]) {
    LAS _Float16* bp = lds + bufi * (32 * 384);
#pragma unroll
    for (int half = 0; half < 2; ++half) {
        const int st = pst + 16 * half, tok = tok0 + c * 32 + st;
        f32x4 r, kh, v, kk, bb; rwkv_compute(raw[half], tok, rc, r, kh, v, kk, bb);
        LAS _Float16* sp = bp + st * 384 + 4 * pks;
        *(LAS h16x4*)(sp) = wv[half];
        *(LAS h16x4*)(sp + 64) = (h16x4){(_Float16)kk[0], (_Float16)kk[1], (_Float16)kk[2], (_Float16)kk[3]};
        *(LAS h16x4*)(sp + 128) = (h16x4){(_Float16)bb[0], (_Float16)bb[1], (_Float16)bb[2], (_Float16)bb[3]};
        *(LAS h16x4*)(sp + 192) = (h16x4){(_Float16)kh[0], (_Float16)kh[1], (_Float16)kh[2], (_Float16)kh[3]};
        *(LAS h16x4*)(sp + 256) = (h16x4){(_Float16)r[0], (_Float16)r[1], (_Float16)r[2], (_Float16)r[3]};
        *(LAS h16x4*)(sp + 320) = (h16x4){(_Float16)v[0], (_Float16)v[1], (_Float16)v[2], (_Float16)v[3]};
    }
}
__device__ __forceinline__ float fmix_lo(float a, unsigned h, float c) { float d; asm("v_fma_mix_f32 %0, %1, %2, %3 op_sel_hi:[0,1,0]" : "=v"(d) : "v"(a), "v"(h), "v"(c)); return d; }
__device__ __forceinline__ float fmix_hi(float a, unsigned h, float c) { float d; asm("v_fma_mix_f32 %0, %1, %2, %3 op_sel:[0,1,0] op_sel_hi:[0,1,0]" : "=v"(d) : "v"(a), "v"(h), "v"(c)); return d; }
__device__ __forceinline__ float fmix2_lo(unsigned a, unsigned h, float c) { float d; asm("v_fma_mix_f32 %0, %1, %2, %3 op_sel_hi:[1,1,0]" : "=v"(d) : "v"(a), "v"(h), "v"(c)); return d; }
__device__ __forceinline__ float fmix2_hi(unsigned a, unsigned h, float c) { float d; asm("v_fma_mix_f32 %0, %1, %2, %3 op_sel:[0,1,0] op_sel_hi:[1,1,0]" : "=v"(d) : "v"(a), "v"(h), "v"(c)); return d; }
__device__ __forceinline__ void scan_step_asm(float& s0, float& s1, float& s2, float& s3, float& q0, float& q1,
                                              unsigned kkx, unsigned kky, unsigned wx, unsigned wy, unsigned khx, unsigned khy, unsigned bbx, unsigned bby, unsigned rx, unsigned ry, unsigned v) {
    float p0, p1, u0, u1, u2, u3;
    asm("v_fma_mix_f32 %[p0], %[s0], %[kkx], 0 op_sel_hi:[0,1,0]\n\t"
        "v_fma_mix_f32 %[p0], %[s1], %[kkx], %[p0] op_sel:[0,1,0] op_sel_hi:[0,1,0]\n\t"
        "v_fma_mix_f32 %[p0], %[s2], %[kky], %[p0] op_sel_hi:[0,1,0]\n\t"
        "v_fma_mix_f32 %[p0], %[s3], %[kky], %[p0] op_sel:[0,1,0] op_sel_hi:[0,1,0]\n\t"
        "v_fma_mix_f32 %[u0], %[s0], %[wx], 0 op_sel_hi:[0,1,0]\n\t"
        "v_fma_mix_f32 %[u1], %[s1], %[wx], 0 op_sel:[0,1,0] op_sel_hi:[0,1,0]\n\t"
        "v_add_f32_dpp %[p0], %[p0], %[p0] quad_perm:[1,0,3,2] row_mask:0xf bank_mask:0xf bound_ctrl:1\n\t"
        "v_fma_mix_f32 %[u2], %[s2], %[wy], 0 op_sel_hi:[0,1,0]\n\t"
        "v_fma_mix_f32 %[u3], %[s3], %[wy], 0 op_sel:[0,1,0] op_sel_hi:[0,1,0]\n\t"
        "v_add_f32_dpp %[p0], %[p0], %[p0] quad_perm:[2,3,0,1] row_mask:0xf bank_mask:0xf bound_ctrl:1\n\t"
        "v_fma_mix_f32 %[u0], %[v], %[khx], %[u0] op_sel_hi:[1,1,0]\n\t"
        "v_fma_mix_f32 %[u1], %[v], %[khx], %[u1] op_sel:[0,1,0] op_sel_hi:[1,1,0]\n\t"
        "v_add_f32_dpp %[p0], %[p0], %[p0] row_half_mirror row_mask:0xf bank_mask:0xf bound_ctrl:1\n\t"
        "v_fma_mix_f32 %[u2], %[v], %[khy], %[u2] op_sel_hi:[1,1,0]\n\t"
        "v_fma_mix_f32 %[u3], %[v], %[khy], %[u3] op_sel:[0,1,0] op_sel_hi:[1,1,0]\n\t"
        "v_add_f32_dpp %[p0], %[p0], %[p0] row_mirror row_mask:0xf bank_mask:0xf bound_ctrl:1\n\t"
        "v_xor_b32 %[p1], 0x80000000, %[p0]\n\t"
        "v_fma_mix_f32 %[s0], %[p1], %[bbx], %[u0] op_sel_hi:[0,1,0]\n\t"
        "v_fma_mix_f32 %[s1], %[p1], %[bbx], %[u1] op_sel:[0,1,0] op_sel_hi:[0,1,0]\n\t"
        "v_fma_mix_f32 %[s2], %[p1], %[bby], %[u2] op_sel_hi:[0,1,0]\n\t"
        "v_fma_mix_f32 %[s3], %[p1], %[bby], %[u3] op_sel:[0,1,0] op_sel_hi:[0,1,0]\n\t"
        "v_fma_mix_f32 %[q0], %[s0], %[rx], 0 op_sel_hi:[0,1,0]\n\t"
        "v_fma_mix_f32 %[q0], %[s1], %[rx], %[q0] op_sel:[0,1,0] op_sel_hi:[0,1,0]\n\t"
        "v_fma_mix_f32 %[q0], %[s2], %[ry], %[q0] op_sel_hi:[0,1,0]\n\t"
        "v_fma_mix_f32 %[q0], %[s3], %[ry], %[q0] op_sel:[0,1,0] op_sel_hi:[0,1,0]"
        : [s0] "+v"(s0), [s1] "+v"(s1), [s2] "+v"(s2), [s3] "+v"(s3), [q0] "=&v"(q0),
          [p0] "=&v"(p0), [p1] "=&v"(p1), [u0] "=&v"(u0), [u1] "=&v"(u1), [u2] "=&v"(u2), [u3] "=&v"(u3)
        : [kkx] "v"(kkx), [kky] "v"(kky), [wx] "v"(wx), [wy] "v"(wy), [khx] "v"(khx), [khy] "v"(khy), [bbx] "v"(bbx), [bby] "v"(bby), [rx] "v"(rx), [ry] "v"(ry), [v] "v"(v));
    q1 = 0.f;
}
constexpr int TCH = 32;
constexpr int SCH = 6 * 64;
__device__ __forceinline__ void phase_scan(LAS unsigned char* ldsb, const u16* zr, const _Float16* wbuf, const _Float16* abuf, const float* mu, const float* k_k, const float* k_a,
                                           float* yraw, int tid, int bid) {
    LAS _Float16* lds = (LAS _Float16*)ldsb;
    LAS float* ypart = (LAS float*)(ldsb + 2 * TCH * SCH * 2);
    const int wid = tid >> 6, lane = tid & 63;
    const int blk = bid, xcd = blk & 7, slot = blk >> 3, bh = xcd * 8 + (slot >> 2), quarter = slot & 3;
    const int b = bh >> 3, h = bh & 7, tok0 = b * SEQ;
    const bool comp = wid < 4;
    const int rowl = quarter * 16 + (wid & 3) * 4 + (lane >> 4), ks = lane & 15;
    constexpr int NCH = SEQ / TCH;
    const int p = tid & 255, pst = p >> 4, pks = p & 15, pch = h * 64 + 4 * pks;
    RwkvConst rc = rwkv_const(mu, k_k, k_a, pch);
    RwkvRaw raw[2]; h16x4 wv[2];
    if (!comp) { scan_load(zr, wbuf, abuf, tok0, pst, pch, 0, raw, wv); scan_write(lds, rc, tok0, pst, pks, 0, 0, raw, wv); scan_load(zr, wbuf, abuf, tok0, pst, pch, 1, raw, wv); }
    __syncthreads();
    float s0 = 0.f, s1 = 0.f, s2 = 0.f, s3 = 0.f;
    LAS float* ypw = ypart + (wid & 3) * (TCH * 64);
#define SCAN_LD(W, KK, BB, KH, R, V, st) do { const LAS _Float16* sp_ = bp + (st) * SCH; W = *(const LAS u32x2*)(sp_ + 4 * ks); KK = *(const LAS u32x2*)(sp_ + 64 + 4 * ks); \
        BB = *(const LAS u32x2*)(sp_ + 128 + 4 * ks); KH = *(const LAS u32x2*)(sp_ + 192 + 4 * ks); R = *(const LAS u32x2*)(sp_ + 256 + 4 * ks); V = *(const LAS unsigned short*)(sp_ + 320 + rowl); } while (0)
#pragma nounroll
    for (int c = 0; c < NCH; ++c) {
        if (!comp) {
            if (c + 1 < NCH) scan_write(lds, rc, tok0, pst, pks, c + 1, (c + 1) & 1, raw, wv);
            if (c + 2 < NCH) scan_load(zr, wbuf, abuf, tok0, pst, pch, c + 2, raw, wv);
        }
        else {
            const LAS _Float16* bp = lds + (c & 1) * (TCH * SCH);
            u32x2 w, kk, bb, kh, r; unsigned v;
            SCAN_LD(w, kk, bb, kh, r, v, 0);
#pragma unroll
            for (int st = 0; st < TCH; ++st) {
                u32x2 nw, nkk, nbb, nkh, nr; unsigned nv;
                if (st + 1 < TCH) SCAN_LD(nw, nkk, nbb, nkh, nr, nv, st + 1);
                float q0, q1;
                scan_step_asm(s0, s1, s2, s3, q0, q1, kk.x, kk.y, w.x, w.y, kh.x, kh.y, bb.x, bb.y, r.x, r.y, v);
                ypw[st * 64 + lane] = q0;
                if (st + 1 < TCH) { w = nw; kk = nkk; bb = nbb; kh = nkh; r = nr; v = nv; }
            }
#pragma unroll
            for (int i = 0; i < 2; ++i) {
                const int pp = lane + 64 * i, st = pp >> 2, rw = pp & 3;
                const LAS f32x4* q = (const LAS f32x4*)(ypw + st * 64 + rw * 16);
                const f32x4 a0 = q[0], a1 = q[1], a2 = q[2], a3 = q[3];
                const f32x4 sm = (a0 + a1) + (a2 + a3);
                yraw[(size_t)(tok0 + c * TCH + st) * 512 + h * 64 + quarter * 16 + (wid & 3) * 4 + rw] = (sm[0] + sm[1]) + (sm[2] + sm[3]);
            }
        }
        asm volatile("s_waitcnt lgkmcnt(0)" ::: "memory"); __builtin_amdgcn_s_barrier(); asm volatile("" ::: "memory");
    }
#undef SCAN_LD
}
__device__ __forceinline__ void phase_rwkv_out(const float* __restrict__ yraw, const u16* __restrict__ zr, const _Float16* __restrict__ abuf, const _Float16* __restrict__ gbuf,
                                               const float* __restrict__ mu, const float* __restrict__ k_k, const float* __restrict__ k_a, const float* __restrict__ r_k,
                                               const float* __restrict__ gn_g, const float* __restrict__ gn_b, u16* __restrict__ yout, size_t gtid, size_t gth) {
    const int hk = (int)(gtid & 127), head = hk >> 4, ks = hk & 15, ch = head * 64 + ks * 4;
    const RwkvConst rc = rwkv_const(mu, k_k, k_a, ch);
    const f32x4 rk = *(const f32x4*)(r_k + ch), gg = *(const f32x4*)(gn_g + ch), gb = *(const f32x4*)(gn_b + ch);
#pragma unroll 2
    for (size_t idx = gtid; idx < (size_t)MTOK * 128; idx += gth) {
        const int tok = (int)(idx >> 7);
        const f32x4 y = *(const f32x4*)(yraw + (size_t)tok * 512 + ch);
        const h16x4 gh = *(const h16x4*)(gbuf + (size_t)tok * 512 + ch);
        f32x4 r, kh, v, kk, bb; rwkv_prep(zr, abuf, tok, ch, rc, r, kh, v, kk, bb);
        const float mean = red16((y[0] + y[1]) + (y[2] + y[3])) * (1.f / 64.f);
        const f32x4 d = y - mean;
        const float var = red16((d[0] * d[0] + d[1] * d[1]) + (d[2] * d[2] + d[3] * d[3])) * (1.f / 64.f);
        const float rstd = 1.0f / sqrtf(var + 64e-5f);
        const float bs = red16((r[0] * kh[0] * rk[0] + r[1] * kh[1] * rk[1]) + (r[2] * kh[2] * rk[2] + r[3] * kh[3] * rk[3]));
        float o[4];
#pragma unroll
        for (int j = 0; j < 4; ++j) o[j] = (d[j] * rstd * gg[j] + gb[j] + bs * v[j]) * (float)gh[j];
        u32x2 w; w.x = cvt_pk_bf16(o[0], o[1]); w.y = cvt_pk_bf16(o[2], o[3]);
        *(u32x2*)(yout + (size_t)tok * 1536 + ch) = w;
    }
}

__device__ __forceinline__ bf16x8 ldfrag(const u16* p) { return *(const bf16x8*)p; }
__device__ __forceinline__ void r1_issue(LAS unsigned char* lds, int it, int bid, int wid, int fr, int fq, const u16* ktz) {
    const int itc = it > 7 ? 7 : it, item = itc * 256 + bid;
    const u16* src = ktz + (size_t)item * 16384 + (size_t)(16 * wid + fr) * 128 + 8 * fq;
    LAS unsigned char* dst = lds + (it % 3) * 32768 + wid * 4096;
#pragma unroll
    for (int k = 0; k < 4; ++k) __builtin_amdgcn_global_load_lds((const unsigned*)(src + 32 * k), (LAS unsigned*)(dst + k * 1024), 16, 0, 0);
}
__device__ __forceinline__ void phase_r1(LAS unsigned char* lds, const u16* vt, const u16* ktz, u16* ut, int wid_, int lane, int bid) {
    const int wid = __builtin_amdgcn_readfirstlane(wid_), fr = lane & 15, fq = lane >> 4;
    r1_issue(lds, 0, bid, wid, fr, fq, ktz); r1_issue(lds, 1, bid, wid, fr, fq, ktz); r1_issue(lds, 2, bid, wid, fr, fq, ktz);
    bf16x8 xf[2][4];
    {
        const u16* V = vt + (size_t)bid * 32768 + (size_t)(wid * 32) * 128;
#pragma unroll
        for (int i = 0; i < 2; ++i)
#pragma unroll
            for (int k = 0; k < 4; ++k) xf[i][k] = ldfrag(V + (size_t)(16 * i + fr) * 128 + 32 * k + 8 * fq);
    }
#pragma unroll 1
    for (int it = 0; it < 8; ++it) {
        const int item = it * 256 + bid;
        asm volatile("s_waitcnt vmcnt(8)" ::: "memory");
        asm volatile("s_waitcnt lgkmcnt(0)" ::: "memory"); __builtin_amdgcn_s_barrier(); asm volatile("" ::: "memory");
        const LAS unsigned char* kb = lds + (it % 3) * 32768 + lane * 16;
        f32x4 acc[2][8];
#pragma unroll
        for (int i = 0; i < 2; ++i)
#pragma unroll
            for (int j = 0; j < 8; ++j) acc[i][j] = (f32x4){0.f, 0.f, 0.f, 0.f};
#pragma unroll
        for (int k = 0; k < 4; ++k)
#pragma unroll
            for (int j = 0; j < 8; ++j) {
                const bf16x8 yf = *(const LAS bf16x8*)(kb + (j * 4 + k) * 1024);
#pragma unroll
                for (int i = 0; i < 2; ++i) acc[i][j] = __builtin_amdgcn_mfma_f32_16x16x32_bf16(yf, xf[i][k], acc[i][j], 0, 0, 0);
            }
        u16* U = ut + (size_t)item * 256 * 128 + (size_t)(wid * 32) * 128;
#pragma unroll
        for (int i = 0; i < 2; ++i)
#pragma unroll
            for (int j = 0; j < 8; ++j) { u32x2 w; w.x = cvt_pk_bf16(acc[i][j][0], acc[i][j][1]); w.y = cvt_pk_bf16(acc[i][j][2], acc[i][j][3]);
                *(u32x2*)(U + (size_t)(16 * i + fr) * 128 + 16 * j + 4 * fq) = w; }
        {
            const int itn = it < 7 ? it + 1 : 7;
            const u16* V = vt + (size_t)(itn * 256 + bid) * 32768 + (size_t)(wid * 32) * 128;
#pragma unroll
            for (int i = 0; i < 2; ++i)
#pragma unroll
                for (int k = 0; k < 4; ++k) xf[i][k] = ldfrag(V + (size_t)(16 * i + fr) * 128 + 32 * k + 8 * fq);
        }
        asm volatile("s_waitcnt lgkmcnt(0)" ::: "memory"); __builtin_amdgcn_s_barrier(); asm volatile("" ::: "memory");
        r1_issue(lds, it + 3, bid, wid, fr, fq, ktz);
    }
    asm volatile("s_waitcnt vmcnt(0)" ::: "memory");
    asm volatile("s_waitcnt lgkmcnt(0)" ::: "memory"); __builtin_amdgcn_s_barrier(); asm volatile("" ::: "memory");
}
__device__ __forceinline__ void phase_r2(u16* rt, size_t gtid, size_t gth) {
    for (size_t idx = gtid; idx < (size_t)32 * 8192; idx += gth) {
        const int bh = (int)(idx >> 13), off = (int)(idx & 8191) * 4, head = bh & 3;
        const float cd = __builtin_amdgcn_exp2f(128.f * __log2f(1.0f - __builtin_amdgcn_exp2f((float)(-5 - head))));
        f32x4 R = {0.f, 0.f, 0.f, 0.f};
        u16* rp = rt + (size_t)bh * 64 * 32768 + off;
#pragma unroll 8
        for (int c = 0; c < 64; ++c) {
            const f32x4 uv = ld_bf4(rp + (size_t)c * 32768);
            u32x2 w; w.x = cvt_pk_bf16(R[0], R[1]); w.y = cvt_pk_bf16(R[2], R[3]);
            *(u32x2*)(rp + (size_t)c * 32768) = w;
            R = R * cd + uv;
        }
    }
}
#define R3_WAITV(n) asm volatile("s_waitcnt vmcnt(" #n ")" ::: "memory")
#define R3_BAR() do { asm volatile("s_waitcnt lgkmcnt(0)" ::: "memory"); __builtin_amdgcn_s_barrier(); asm volatile("" ::: "memory"); } while (0)
__device__ __forceinline__ void r3_issue(LAS unsigned char* lds, int g, int bid, int wid, int fr, int fq, const u16* krot, const u16* rt, const u16* vt) {
    int it = g / 5; const int st = g - it * 5; it = it > 7 ? 7 : it;
    const int item = it * 256 + bid, bh = item >> 6, chunk = item & 63, b = bh >> 2, head = bh & 3, tok0 = b * SEQ + chunk * 128;
    const u16* src;
    if (st == 0) src = krot + (size_t)(tok0 + 16 * wid + fr) * 512 + head * 128 + 8 * fq;
    else src = (wid < 4 ? rt : vt) + (size_t)item * 32768 + (size_t)(16 * (4 * (st - 1) + (wid & 3)) + fr) * 128 + 8 * fq;
    LAS unsigned char* dst = lds + (g % 3) * 32768 + wid * 4096;
#pragma unroll
    for (int k = 0; k < 4; ++k) __builtin_amdgcn_global_load_lds((const unsigned*)(src + 32 * k), (LAS unsigned*)(dst + k * 1024), 16, 0, 0);
}
__device__ __forceinline__ void phase_r3(LAS unsigned char* lds, const u16* qrot, const u16* krot, const u16* vt, const u16* rt, const u16* gsilu, u16* yret, int wid_, int lane, int bid) {
    const int wid = __builtin_amdgcn_readfirstlane(wid_), fr = lane & 15, fq = lane >> 4;
    LAS unsigned char* Pw = lds + 98304 + (16 * wid + fr) * 256;
    const int nK = (wid >> 1) + 1;
    const int n = 16 * wid + fr;
    r3_issue(lds, 0, bid, wid, fr, fq, krot, rt, vt); r3_issue(lds, 1, bid, wid, fr, fq, krot, rt, vt); r3_issue(lds, 2, bid, wid, fr, fq, krot, rt, vt);
#pragma unroll 1
    for (int it = 0; it < 8; ++it) {
        const int item = it * 256 + bid, bh = item >> 6, chunk = item & 63, b = bh >> 2, head = bh & 3, tok0 = b * SEQ + chunk * 128, g0 = it * 5;
        const float l2g = __log2f(1.0f - __builtin_amdgcn_exp2f((float)(-5 - head)));
        bf16x8 qf[4];
#pragma unroll
        for (int k = 0; k < 4; ++k) qf[k] = ldfrag(qrot + (size_t)(tok0 + n) * 512 + head * 128 + 32 * k + 8 * fq);
        R3_WAITV(8); R3_BAR();
        {
            const LAS unsigned char* kb = lds + (g0 % 3) * 32768 + lane * 16;
            for (int j = 0; j < 2 * nK; ++j) {
                f32x4 sc = {0.f, 0.f, 0.f, 0.f};
#pragma unroll
                for (int k = 0; k < 4; ++k) { const bf16x8 kf = *(const LAS bf16x8*)(kb + (j * 4 + k) * 1024); sc = __builtin_amdgcn_mfma_f32_16x16x32_bf16(kf, qf[k], sc, 0, 0, 0); }
                float pv[4];
#pragma unroll
                for (int r = 0; r < 4; ++r) { const int m = 16 * j + 4 * fq + r; pv[r] = (m <= n) ? sc[r] * __builtin_amdgcn_exp2f(l2g * (float)(n - m)) : 0.f; }
                u32x2 w; w.x = cvt_pk_bf16(pv[0], pv[1]); w.y = cvt_pk_bf16(pv[2], pv[3]);
                *(LAS u32x2*)(Pw + (16 * j + 4 * fq) * 2) = w;
            }
        }
        R3_BAR(); r3_issue(lds, g0 + 3, bid, wid, fr, fq, krot, rt, vt);
        f32x4 acc[16];
        const float xi = __builtin_amdgcn_exp2f(l2g * (float)(n + 1));
#pragma unroll
        for (int q = 0; q < 4; ++q) {
            R3_WAITV(8); R3_BAR();
            const LAS unsigned char* sb = lds + ((g0 + 1 + q) % 3) * 32768 + lane * 16;
#pragma unroll
            for (int jj = 0; jj < 4; ++jj) {
                f32x4 a = {0.f, 0.f, 0.f, 0.f};
#pragma unroll
                for (int k = 0; k < 4; ++k) { const bf16x8 rf = *(const LAS bf16x8*)(sb + (jj * 4 + k) * 1024); a = __builtin_amdgcn_mfma_f32_16x16x32_bf16(rf, qf[k], a, 0, 0, 0); }
                acc[4 * q + jj] = a * xi;
            }
            for (int k = 0; k < nK; ++k) {
                const bf16x8 pf = *(const LAS bf16x8*)(Pw + (32 * k + 8 * fq) * 2);
#pragma unroll
                for (int jj = 0; jj < 4; ++jj) { const bf16x8 vf = *(const LAS bf16x8*)(sb + (16 + jj * 4 + k) * 1024); acc[4 * q + jj] = __builtin_amdgcn_mfma_f32_16x16x32_bf16(vf, pf, acc[4 * q + jj], 0, 0, 0); }
            }
            R3_BAR(); r3_issue(lds, g0 + 4 + q, bid, wid, fr, fq, krot, rt, vt);
        }
        float s1 = 0.f;
#pragma unroll
        for (int j = 0; j < 16; ++j) s1 += (acc[j][0] + acc[j][1]) + (acc[j][2] + acc[j][3]);
        s1 += __shfl_xor(s1, 16); s1 += __shfl_xor(s1, 32);
        const float mean = s1 * (1.f / 256.f);
        float s2 = 0.f;
#pragma unroll
        for (int j = 0; j < 16; ++j) { acc[j] = acc[j] - mean; s2 += (acc[j][0] * acc[j][0] + acc[j][1] * acc[j][1]) + (acc[j][2] * acc[j][2] + acc[j][3] * acc[j][3]); }
        s2 += __shfl_xor(s2, 16); s2 += __shfl_xor(s2, 32);
        const float rstd = 1.0f / sqrtf(s2 * (1.f / 256.f) + LN_EPS);
        const u16* gp = gsilu + (size_t)(tok0 + n) * 1024 + head * 256 + 4 * fq;
        u16* op = yret + (size_t)(tok0 + n) * 1536 + head * 256 + 4 * fq;
#pragma unroll
        for (int j = 0; j < 16; ++j) {
            const f32x4 gv = ld_bf4(gp + 16 * j);
            const f32x4 o = acc[j] * rstd * gv;
            u32x2 w; w.x = cvt_pk_bf16(o[0], o[1]); w.y = cvt_pk_bf16(o[2], o[3]);
            *(u32x2*)(op + 16 * j) = w;
        }
    }
    R3_WAITV(0); R3_BAR();
}

#define XB_TMO      128
#define XB_XCNT(j)  (256  + 64 * (j))
#define XB_XSUB(j)  (1280 + 64 * (j))
#define XB_XGEN(j)  (2304 + 64 * (j))
#define XB_TOP      3328
#define XB_TOPGEN   3392
#define XCD_BAR_WORDS 3456
#define XB_SPIN_CAP (1u << 22)
__device__ __forceinline__ unsigned xb_ld(unsigned* p)              { return __hip_atomic_load(p, __ATOMIC_RELAXED, __HIP_MEMORY_SCOPE_AGENT); }
__device__ __forceinline__ unsigned xb_add(unsigned* p, unsigned v) { return __hip_atomic_fetch_add(p, v, __ATOMIC_RELAXED, __HIP_MEMORY_SCOPE_AGENT); }
__device__ __forceinline__ unsigned xb_xcc_id() { return (unsigned)__builtin_amdgcn_s_getreg((3 << 11) | 20) & 0xFu; }
#define XB_SPIN(cond, bar) do { unsigned _sp = 0; while (cond) { __builtin_amdgcn_s_sleep(1); \
    if ((++_sp & 255u) == 0u) { if (xb_ld(&(bar)[XB_TMO])) break; if (_sp > XB_SPIN_CAP) { atomicAdd(&(bar)[XB_TMO], 1u); break; } } } } while (0)
struct XcdBarrier { unsigned* bar; unsigned x; volatile LAS unsigned* st; };
__device__ __forceinline__ XcdBarrier xcd_barrier_post(unsigned* bar, volatile LAS unsigned* st) {
    XcdBarrier b; b.bar = bar; b.x = xb_xcc_id(); b.st = st;
    if (threadIdx.x == 0) (void)xb_add(&bar[XB_XCNT(b.x)], 1u);
    return b;
}
__device__ __forceinline__ void xcd_barrier_complete(unsigned* bar, unsigned x, unsigned& nloc, unsigned& nx) {
    const unsigned G = gridDim.x * gridDim.y * gridDim.z;
    unsigned sum, cnt, mine, sp = 0u;
    for (;;) {
        sum = 0u; cnt = 0u; mine = 0u;
#pragma unroll
        for (unsigned j = 0; j < 16; ++j) { const unsigned c = xb_ld(&bar[XB_XCNT(j)]); sum += c; cnt += (c > 0u) ? 1u : 0u; mine = (j == x) ? c : mine; }
        if (sum == G) break;
        __builtin_amdgcn_s_sleep(1);
        if ((++sp & 255u) == 0u) { if (xb_ld(&bar[XB_TMO])) break; if (sp > XB_SPIN_CAP) { atomicAdd(&bar[XB_TMO], 1u); break; } }
    }
    nloc = mine > 0u ? mine : 1u; nx = cnt > 0u ? cnt : 1u;
}
__device__ __forceinline__ void xcd_barrier(const XcdBarrier& b) {
    asm volatile("s_waitcnt vmcnt(0)" ::: "memory");
    __syncthreads();
    if (threadIdx.x == 0) {
        unsigned* bar = b.bar;
        __builtin_amdgcn_s_waitcnt(0);
        unsigned nloc = b.st[0], nx = b.st[1];
        if (nloc == 0u) { xcd_barrier_complete(bar, b.x, nloc, nx); b.st[0] = nloc; b.st[1] = nx; }
        const unsigned old = xb_add(&bar[XB_XSUB(b.x)], 1u);
        const unsigned gen = old / nloc;
        if (old + 1u == (gen + 1u) * nloc) {
            __builtin_amdgcn_fence(__ATOMIC_RELEASE, "agent");
            asm volatile("s_waitcnt vmcnt(0)" ::: "memory");
            const unsigned og = xb_add(&bar[XB_TOP], 1u);
            const unsigned tg = og / nx;
            if (og + 1u == (tg + 1u) * nx) xb_add(&bar[XB_TOPGEN], 1u);
            else XB_SPIN(xb_ld(&bar[XB_TOPGEN]) == tg, bar);
            __builtin_amdgcn_fence(__ATOMIC_ACQUIRE, "agent");
            xb_add(&bar[XB_XGEN(b.x)], 1u);
            asm volatile("s_waitcnt vmcnt(0)" ::: "memory");
        } else {
            XB_SPIN(xb_ld(&bar[XB_XGEN(b.x)]) == gen, bar);
            __builtin_amdgcn_fence(__ATOMIC_ACQUIRE, "agent");
            asm volatile("s_waitcnt vmcnt(0)" ::: "memory");
        }
    }
    __syncthreads();
}

#ifndef PHMASK
#define PHMASK 0xFFFFFF
#endif
#define PH_ON(p) ((PHMASK >> (p)) & 1)
#ifndef REPMASK
#define REPMASK 0
#endif
#define PH_BEGIN(p) _Pragma("nounroll") for (int rep_ = 0; rep_ < (int)PH_ON(p) * (1 + (int)((REPMASK >> (p)) & 1)); ++rep_) { int tid = threadIdx.x; asm volatile("" : "+v"(tid)); int bid = blockIdx.x; asm volatile("" : "+s"(bid)); \
        unsigned char* ws = P.ws; asm volatile("" : "+s"(ws)); float* dout = P.out; asm volatile("" : "+s"(dout)); \
        const int wid = tid >> 6, lane = tid & 63; const size_t gtid = (size_t)bid * 512 + tid, gth = (size_t)gridDim.x * 512; const int gw = bid * 8 + wid, ngw = gridDim.x * 8; \
        (void)wid; (void)lane; (void)gtid; (void)gth; (void)gw; (void)ngw; (void)ws; (void)dout;
#define PH_END xcd_barrier(xb); }

__device__ __forceinline__ void run_ffn_in(LAS unsigned char* lds, const u16* A, const u16* Wt, u16* hid, int bid) {
    pg8::Gemm g{A, Wt, DM, DM, DM}; pg8::StaticOrder S; S.init(MTOK, 2 * FF, gridDim.x, bid);
    EpiFfnIn E{hid}; pg8::gemm_phase(lds, g, S, E);
}
__device__ __forceinline__ void run_res(LAS unsigned char* lds, const u16* A, const u16* Wt, int K, u16* pre, const float* resf, const u16* resb, float scale, int bid) {
    pg8::Gemm g{A, Wt, K, K, K}; pg8::StaticOrder S; S.init(MTOK, DM, gridDim.x, bid);
    EpiRes E{pre, resf, resb, DN_ALPHA, scale}; pg8::gemm_phase(lds, g, S, E);
}
__device__ __forceinline__ void run_mix(LAS unsigned char* lds, unsigned char* ws, float* dout, int pn0, int npn, int bid) {
    pg8::Gemm g{(const u16*)(ws + O_H), (const u16*)(ws + O_WMT) + (size_t)pn0 * 256 * DM, DM, DM, DM};
    pg8::StaticOrder S; S.init(MTOK, npn * 256, gridDim.x, bid);
    EpiMix E{pn0, (u16*)dout, (u16*)(ws + O_QROT), (u16*)(ws + O_KROT), (u16*)(ws + O_KTZ), (u16*)(ws + O_VT), (u16*)(ws + O_GSILU), (u16*)dout, (const f32x2*)(ws + O_CS)};
    pg8::gemm_phase(lds, g, S, E);
}
__device__ __forceinline__ void run_fin(LAS unsigned char* lds, const u16* A, const u16* Wt, int K, int mode, float* out, u16* pproj, int bid) {
    pg8::Gemm g{A, Wt, K, K, K}; pg8::StaticOrder S; S.init(MTOK, DM, gridDim.x, bid);
    EpiFin E{mode, out, pproj}; pg8::gemm_phase(lds, g, S, E);
}

__global__ void __launch_bounds__(512, 2) mega(Params P) {
    extern __shared__ __attribute__((aligned(16))) unsigned char smem[];
    LAS unsigned char* lds = (LAS unsigned char*)smem;
    cg::grid_group grid = cg::this_grid();
    volatile LAS unsigned* xst = (volatile LAS unsigned*)(lds + pg8::STAGE_BYTES);
    if (threadIdx.x == 0) { xst[0] = 0u; xst[1] = 0u; }
    __syncthreads();
    const XcdBarrier xb = xcd_barrier_post((unsigned*)(P.ws + O_BAR), xst);
    if (P.ws == nullptr) grid.sync();

    PH_BEGIN(0) phase_convert(P, gtid, gth); PH_END
    PH_BEGIN(1) run_ffn_in(lds, (const u16*)(ws + O_XB), (const u16*)(ws + O_W1T), (u16*)(ws + O_HID), bid); PH_END
    PH_BEGIN(2) run_res(lds, (const u16*)(ws + O_HID), (const u16*)(ws + O_W2T), FF, (u16*)(ws + O_PRE), P.in[0], nullptr, 0.5f, bid); PH_END
    PH_BEGIN(3) phase_ln((const u16*)(ws + O_PRE), P.in[3], P.in[4], (u16*)(ws + O_H), nullptr, gw, ngw, lane); PH_END
    PH_BEGIN(4) run_mix(lds, ws, dout, 0, 7, bid); PH_END
    PH_BEGIN(5) phase_lora_prep((const u16*)dout, P.in[8], (u16*)(ws + O_ALORA), gtid, gth); PH_END
    PH_BEGIN(6) {
        pg8::Gemm g{(const u16*)(ws + O_ALORA), (const u16*)(ws + O_WLT), 256, 256, 256};
        pg8::StaticOrder S; S.init(MTOK, 1536, gridDim.x, bid);
        EpiLora E{(_Float16*)(ws + O_WBUF), (_Float16*)(ws + O_ABUF), (_Float16*)(ws + O_GBUF), P.in[9], P.in[11]};
        pg8::gemm_phase(lds, g, S, E);
    } PH_END
    PH_BEGIN(8) phase_scan(lds, (const u16*)dout, (const _Float16*)(ws + O_WBUF), (const _Float16*)(ws + O_ABUF), P.in[8], P.in[14], P.in[15], (float*)(ws + O_YRAW), tid, bid); PH_END
    PH_BEGIN(9) phase_rwkv_out((const float*)(ws + O_YRAW), (const u16*)dout, (const _Float16*)(ws + O_ABUF), (const _Float16*)(ws + O_GBUF), P.in[8], P.in[14], P.in[15], P.in[16], P.in[17], P.in[18], (u16*)(ws + O_Y), gtid, gth); PH_END
    PH_BEGIN(10) run_mix(lds, ws, dout, 7, 20, bid); PH_END
    PH_BEGIN(11) phase_r1(lds, (const u16*)(ws + O_VT), (const u16*)(ws + O_KTZ), (u16*)(ws + O_RT), wid, lane, bid); PH_END
    PH_BEGIN(12) phase_r2((u16*)(ws + O_RT), gtid, gth); PH_END
    PH_BEGIN(13) phase_r3(lds, (const u16*)(ws + O_QROT), (const u16*)(ws + O_KROT), (const u16*)(ws + O_VT), (const u16*)(ws + O_RT), (const u16*)(ws + O_GSILU), (u16*)(ws + O_Y) + 512, wid, lane, bid); PH_END
    PH_BEGIN(15) {
        pg8::Gemm g{(const u16*)(ws + O_Y), (const u16*)(ws + O_WBR), 1536, 1536, 1536};
        pg8::StaticOrder S; S.init(MTOK, DM, gridDim.x, bid);
        EpiBr E{(const u16*)dout, (u16*)(ws + O_MERGED)};
        pg8::gemm_phase<EpiBr, true>(lds, g, S, E, 512);
    } PH_END
    PH_BEGIN(17) run_res(lds, (const u16*)(ws + O_MERGED), (const u16*)(ws + O_WMO), DM, (u16*)(ws + O_PRE), nullptr, (const u16*)(ws + O_H), 1.0f, bid); PH_END
    PH_BEGIN(18) phase_ln((const u16*)(ws + O_PRE), P.in[22], P.in[23], (u16*)(ws + O_H), nullptr, gw, ngw, lane); PH_END
    PH_BEGIN(19) run_ffn_in(lds, (const u16*)(ws + O_H), (const u16*)(ws + O_W3T), (u16*)(ws + O_HID), bid); PH_END
    PH_BEGIN(20) run_res(lds, (const u16*)(ws + O_HID), (const u16*)(ws + O_W4T), FF, (u16*)(ws + O_PRE), nullptr, (const u16*)(ws + O_H), 0.5f, bid); PH_END
    PH_BEGIN(21) phase_ln((const u16*)(ws + O_PRE), P.in[26], P.in[27], (u16*)(ws + O_H), dout, gw, ngw, lane);
        run_fin(lds, (const u16*)(ws + O_PB), (const u16*)(ws + O_WPT), 256, 0, dout, (u16*)(ws + O_PPROJ), bid); PH_END
    PH_BEGIN(23) run_fin(lds, (const u16*)(ws + O_H), (const u16*)(ws + O_WGT), DM, 1, dout, (u16*)(ws + O_PPROJ), bid); PH_END
}

constexpr int LDS_BYTES = pg8::STAGE_BYTES + 16;

extern "C" void kernel_launch(void* const* d_in, const int* in_sizes, int n_in, void* d_out, int out_size, void* d_ws, size_t ws_size, hipStream_t stream) {
    static int grid = 0;
    if (grid == 0) {
        if (n_in != 30 || out_size != MTOK * DM || ws_size < WS_NEED) { fprintf(stderr, "kernel_launch: unexpected shapes (n_in %d out %d ws %zu)\n", n_in, out_size, ws_size); grid = -1; return; }
        int dev = 0, cus = 0, per_cu = 0;
        (void)hipGetDevice(&dev); (void)hipDeviceGetAttribute(&cus, hipDeviceAttributeMultiprocessorCount, dev);
        if (hipFuncSetAttribute((const void*)mega, hipFuncAttributeMaxDynamicSharedMemorySize, LDS_BYTES) != hipSuccess) { fprintf(stderr, "kernel_launch: hipFuncSetAttribute failed\n"); grid = -1; return; }
        (void)hipOccupancyMaxActiveBlocksPerMultiprocessor(&per_cu, (const void*)mega, 512, LDS_BYTES);
        (void)hipGetLastError();
        if (cus != 256 || per_cu < 1) { fprintf(stderr, "kernel_launch: needs 256 CUs with one resident workgroup each (cus %d per_cu %d)\n", cus, per_cu); grid = -1; return; }
        grid = 256;
    }
    if (grid < 0) return;
    if (hipMemsetAsync((char*)d_ws + O_BAR, 0, XCD_BAR_WORDS * 4, stream) != hipSuccess) { fprintf(stderr, "kernel_launch: memset of barrier words failed\n"); return; }
    Params p{};
    for (int i = 0; i < 30; ++i) p.in[i] = (const float*)d_in[i];
    p.out = (float*)d_out; p.ws = (unsigned char*)d_ws;
    void* args[] = {&p};
    hipError_t e = hipLaunchCooperativeKernel((const void*)mega, dim3(grid), dim3(512), args, LDS_BYTES, stream);
    if (e != hipSuccess) fprintf(stderr, "cooperative launch failed: %s\n", hipGetErrorString(e));
}
```

```cpp
#include <hip/hip_runtime.h>
#include <hip/hip_cooperative_groups.h>
#include <cstdio>
namespace cg = cooperative_groups;

#define LAS __attribute__((address_space(3)))
typedef unsigned short u16;
typedef short bf16x8 __attribute__((ext_vector_type(8)));
typedef float f32x4 __attribute__((ext_vector_type(4)));
typedef float f32x2 __attribute__((ext_vector_type(2)));
typedef unsigned u32x4 __attribute__((ext_vector_type(4)));
typedef unsigned u32x2 __attribute__((ext_vector_type(2)));
typedef _Float16 h16x4 __attribute__((ext_vector_type(4)));
typedef _Float16 h16x8 __attribute__((ext_vector_type(8)));

constexpr int MTOK = 65536, DM = 1024, FF = 2816, SEQ = 8192, MIXN = 6912;
constexpr float DN_ALPHA = 1.189207115f;
constexpr float LN_EPS = 1e-5f;
constexpr float DECAY_SCALE = 0.60653066f;

constexpr size_t MiB = 1ull << 20;
constexpr size_t O_W1T = 0;
constexpr size_t O_W2T = O_W1T + 5632ull * 1024 * 2;
constexpr size_t O_WMT = O_W2T + 1024ull * 2816 * 2;
constexpr size_t O_W3T = O_WMT + 6912ull * 1024 * 2;
constexpr size_t O_W4T = O_W3T + 5632ull * 1024 * 2;
constexpr size_t O_WLT = O_W4T + 1024ull * 2816 * 2;
constexpr size_t O_WBR = O_WLT + 1536ull * 256 * 2;
constexpr size_t O_WBT = O_WBR + 1024ull * 512 * 2;
constexpr size_t O_WMO = O_WBT + 1024ull * 1024 * 2;
constexpr size_t O_WGT = O_WMO + 1024ull * 1024 * 2;
constexpr size_t O_WPT = O_WGT + 1024ull * 1024 * 2;
static_assert(O_WPT + 1024ull * 256 * 2 <= 64 * MiB, "weights");
constexpr size_t O_BAR = 60 * MiB;
constexpr size_t O_CS = 64 * MiB;
constexpr size_t O_PB = 96 * MiB;
constexpr size_t O_H = 128 * MiB;
constexpr size_t O_XB = 256 * MiB;
constexpr size_t O_HID = 384 * MiB;
constexpr size_t O_ALORA = 256 * MiB;
constexpr size_t O_WBUF = 608 * MiB;
constexpr size_t O_ABUF = 672 * MiB;
constexpr size_t O_GBUF = 736 * MiB;
constexpr size_t O_YRAW = 288 * MiB;
constexpr size_t O_Y = 832 * MiB;
constexpr size_t O_QROT = 256 * MiB;
constexpr size_t O_KROT = 320 * MiB;
constexpr size_t O_KTZ = 384 * MiB;
constexpr size_t O_VT = 448 * MiB;
constexpr size_t O_GSILU = 576 * MiB;
constexpr size_t O_RT = 704 * MiB;
constexpr size_t O_TMP = 256 * MiB;
constexpr size_t O_MERGED = 512 * MiB;
constexpr size_t O_PPROJ = 384 * MiB;
constexpr size_t O_PRE = 256 * MiB;
constexpr size_t WS_NEED = 1024 * MiB;
static_assert(O_ABUF == O_WBUF + 64 * MiB && O_GBUF == O_ABUF + 64 * MiB, "EpiLora addresses W/A/G by stride");

struct Params { const float* in[30]; float* out; unsigned char* ws; };

__device__ __forceinline__ float bf2f(u16 v) { return __uint_as_float((unsigned)v << 16); }
__device__ __forceinline__ float bflo(unsigned v) { return __uint_as_float(v << 16); }
__device__ __forceinline__ float bfhi(unsigned v) { return __uint_as_float(v & 0xffff0000u); }
__device__ __forceinline__ f32x4 ld_bf4(const u16* p) { const u32x2 t = *(const u32x2*)p; return (f32x4){bflo(t.x), bfhi(t.x), bflo(t.y), bfhi(t.y)}; }
__device__ __forceinline__ unsigned cvt_pk_bf16(float lo, float hi) { unsigned r; asm volatile("v_cvt_pk_bf16_f32 %0, %1, %2" : "=v"(r) : "v"(lo), "v"(hi)); return r; }
__device__ __forceinline__ float sigm(float x) { return __builtin_amdgcn_rcpf(1.f + __builtin_amdgcn_exp2f(-1.44269504f * x)); }
__device__ __forceinline__ float siluf(float x) { return x * sigm(x); }
#define DPP_ADD(x, ctrl) ((x) + __builtin_bit_cast(float, __builtin_amdgcn_update_dpp(0, __builtin_bit_cast(int, (x)), (ctrl), 0xF, 0xF, true)))
__device__ __forceinline__ float red16(float x) {
    x = DPP_ADD(x, 0xB1); x = DPP_ADD(x, 0x4E); x = DPP_ADD(x, 0x141); x = DPP_ADD(x, 0x140); return x;
}
__device__ __forceinline__ float wave_sum(float v) {
#pragma unroll
    for (int o = 1; o < 64; o <<= 1) v += __shfl_xor(v, o);
    return v;
}

namespace pg8 {
constexpr int BM = 256, BK = 64, HALF = 128, HTB = HALF * BK * 2, STAGE_BYTES = 8 * HTB, NXCD = 8, WGM = 8;
__device__ __forceinline__ int lds_byte(int r, int c) { const int st = (r >> 4) * 2 + (c >> 5), rr = r & 15, cc = c & 31, ob = rr * 64 + cc * 2; return st * 1024 + (ob ^ (((ob >> 9) & 1) << 5)); }
__device__ __forceinline__ void stage_rc(int b, int& R, int& C) { const int st = b / 1024, sb = b % 1024, swz = sb ^ (((sb >> 9) & 1) << 5); R = (st >> 1) * 16 + swz / 64; C = (st & 1) * 32 + (swz % 64) / 2; }
__device__ __forceinline__ int perm32(int rho) { const int n = rho >> 4, i = rho & 15; return 8 * (i >> 2) + 4 * n + (i & 3); }
struct Unit { int pm, pn, part; };
struct Gemm { const u16* A; const u16* Bt; int lda, ldb, K; };
struct StaticOrder {
    int nM, nN, nwg, G, c;
    __device__ void init(int M, int N, int G_, int c_) { nM = M / BM; nN = N / BM; nwg = nM * nN; G = G_; c = c_; }
    __device__ bool next(int i, Unit& u) const {
        const long L = (long)i * G + c; if (L >= nwg) return false;
        int wgid = (int)L; { const int q = nwg / NXCD, r = nwg % NXCD, xcd = wgid % NXCD, off = wgid / NXCD; wgid = (xcd < r ? xcd * (q + 1) : r * (q + 1) + (xcd - r) * q) + off; }
        const int nig = WGM * nN, gid = wgid / nig, fm = gid * WGM, gsz = (nM - fm) < WGM ? (nM - fm) : WGM;
        u.pm = fm + ((wgid % nig) % gsz); u.pn = (wgid % nig) / gsz; return true;
    }
};

template <class Epi, bool SPLIT = false>
__device__ __forceinline__ void gemm_phase(LAS unsigned char* lds, const Gemm g, const StaticOrder& S, const Epi& E, int splitK = 0) {
    int tid_ = threadIdx.x; asm volatile("" : "+v"(tid_));
    const int tid = tid_, wid = __builtin_amdgcn_readfirstlane(tid >> 6), lane = tid & 63, wr = wid >> 2, wc = wid & 3, fr = lane & 15, fq = lane >> 4;
    int K_ = g.K, lda_ = g.lda, ldb_ = g.ldb; asm volatile("" : "+s"(K_), "+s"(lda_), "+s"(ldb_));
    const int K = K_;
    int nt = SPLIT ? splitK / BK : K / BK;
    unsigned voffA[2], voffB[2];
#pragma unroll
    for (int i = 0; i < 2; ++i) { int R, C; stage_rc(tid * 16 + i * 8192, R, C); const int Rb = Epi::PERM ? ((R & ~31) + perm32(R & 31)) : R;
        voffA[i] = (unsigned)(R * lda_ + C) * 2u; voffB[i] = (unsigned)(Rb * ldb_ + C) * 2u; }
    const size_t kstep = (size_t)(BK * 2);
    const size_t hstepA = (size_t)HALF * lda_ * 2, hstepB = (size_t)HALF * ldb_ * 2;
    const size_t tstepA = 2 * hstepA, tstepB = 2 * hstepB;
    const unsigned ldsw = (unsigned)wid * 1024u;
    const int aoff = lds_byte(wr * 64 + fr, fq * 8), boff = lds_byte(wc * 32 + fr, fq * 8);
#define PG8_SA(b, h) (((b) * 2 + (h)) * HTB)
#define PG8_SB(b, h) ((4 + (b) * 2 + (h)) * HTB)
#define PG8_STAGE(bufoff, gbase, voff) do { _Pragma("unroll") for (int _i = 0; _i < 2; ++_i) \
        __builtin_amdgcn_global_load_lds((const unsigned*)((const char*)(gbase) + (voff)[_i]), (LAS unsigned*)(lds + (bufoff) + ldsw + _i * 8192), 16, 0, 0); } while (0)
#define PG8_LDA(dst, b, h) do { _Pragma("unroll") for (int m = 0; m < 4; ++m) _Pragma("unroll") for (int k = 0; k < 2; ++k) dst[m][k] = *(const LAS bf16x8*)(lds + PG8_SA(b, h) + aoff + m * 2048 + k * 1024); } while (0)
#define PG8_LDB(dst, b, h) do { _Pragma("unroll") for (int n = 0; n < 2; ++n) _Pragma("unroll") for (int k = 0; k < 2; ++k) dst[n][k] = *(const LAS bf16x8*)(lds + PG8_SB(b, h) + boff + n * 2048 + k * 1024); } while (0)
#define PG8_MMA(ai, bj, At, Bt) do { __builtin_amdgcn_s_setprio(1); _Pragma("unroll") for (int m = 0; m < 4; ++m) _Pragma("unroll") for (int n = 0; n < 2; ++n) _Pragma("unroll") for (int k = 0; k < 2; ++k) \
        acc[ai][bj][m][n] = __builtin_amdgcn_mfma_f32_16x16x32_bf16(Bt[n][k], At[m][k], acc[ai][bj][m][n], 0, 0, 0); __builtin_amdgcn_s_setprio(0); } while (0)
#define PG8_WAIT_V(n) asm volatile("s_waitcnt vmcnt(" #n ")" ::: "memory")
#define PG8_WAIT_L(n) asm volatile("s_waitcnt lgkmcnt(" #n ")" ::: "memory")
#define PG8_BAR __builtin_amdgcn_s_barrier()
#define PG8_SCHED __builtin_amdgcn_sched_barrier(0)
    Unit cur, nxt; int ui = 0;
    cur.part = 0; nxt.part = 0;
    if (!S.next(0, cur)) return;
    f32x4 acc[2][2][4][2];
#pragma unroll
    for (int a = 0; a < 2; ++a)
#pragma unroll
        for (int b = 0; b < 2; ++b)
#pragma unroll
            for (int m = 0; m < 4; ++m)
#pragma unroll
                for (int n = 0; n < 2; ++n) acc[a][b][m][n] = (f32x4){0.f, 0.f, 0.f, 0.f};
    bf16x8 At[4][2], B0[2][2], B1[2][2];
    const char* cA = (const char*)g.A + (size_t)cur.pm * tstepA; const char* cB = (const char*)g.Bt + (size_t)cur.pn * tstepB;
    const size_t poff = (size_t)splitK * 2;
    PG8_STAGE(PG8_SB(0, 0), cB, voffB); PG8_STAGE(PG8_SA(0, 0), cA, voffA); PG8_STAGE(PG8_SB(0, 1), cB + hstepB, voffB); PG8_STAGE(PG8_SA(0, 1), cA + hstepA, voffA);
    if (wr == 1) PG8_BAR;
    PG8_WAIT_V(4); PG8_BAR;
    PG8_STAGE(PG8_SB(1, 0), cB + kstep, voffB); PG8_STAGE(PG8_SA(1, 0), cA + kstep, voffA); PG8_STAGE(PG8_SB(1, 1), cB + hstepB + kstep, voffB);
    PG8_WAIT_V(6); PG8_BAR;
    for (;;) {
        bool has_next;
        if constexpr (SPLIT) { has_next = S.next((ui + 1) >> 1, nxt); nxt.part = (ui + 1) & 1; } else has_next = S.next(ui + 1, nxt);
        const char* nA = has_next ? (const char*)g.A + (size_t)nxt.pm * tstepA + (SPLIT && nxt.part ? poff : 0) : cA;
        const char* nB = has_next ? (const char*)g.Bt + (size_t)nxt.pn * tstepB + (SPLIT && nxt.part ? poff : 0) : cB;
        for (int t = 0; t < nt; t += 2) {
            const bool last = (t == nt - 2);
            const char* a1 = cA + (size_t)(t + 1) * kstep;
            const char* a2 = last ? nA : cA + (size_t)(t + 2) * kstep; const char* b2 = last ? nB : cB + (size_t)(t + 2) * kstep;
            const char* a3 = a2 + kstep; const char* b3 = b2 + kstep;
            PG8_LDB(B0, 0, 0); PG8_SCHED; PG8_LDA(At, 0, 0); PG8_STAGE(PG8_SA(1, 1), a1 + hstepA, voffA);
            PG8_WAIT_L(8); PG8_BAR; PG8_WAIT_L(0); PG8_MMA(0, 0, At, B0); PG8_BAR; PG8_SCHED;
            PG8_LDB(B1, 0, 1); PG8_STAGE(PG8_SB(0, 0), b2, voffB);
            PG8_BAR; PG8_WAIT_L(0); PG8_MMA(0, 1, At, B1); PG8_BAR;
            PG8_LDA(At, 0, 1); PG8_STAGE(PG8_SA(0, 0), a2, voffA);
            PG8_BAR; PG8_WAIT_L(0); PG8_MMA(1, 0, At, B0); PG8_BAR; PG8_SCHED;
            PG8_STAGE(PG8_SB(0, 1), b2 + hstepB, voffB);
            PG8_WAIT_V(6); PG8_BAR; PG8_MMA(1, 1, At, B1); PG8_BAR;
            PG8_LDB(B0, 1, 0); PG8_SCHED; PG8_LDA(At, 1, 0); PG8_STAGE(PG8_SA(0, 1), a2 + hstepA, voffA);
            PG8_WAIT_L(8); PG8_BAR; PG8_WAIT_L(0); PG8_MMA(0, 0, At, B0); PG8_BAR; PG8_SCHED;
            PG8_LDB(B1, 1, 1); PG8_STAGE(PG8_SB(1, 0), b3, voffB);
            PG8_BAR; PG8_WAIT_L(0); PG8_MMA(0, 1, At, B1); PG8_BAR;
            PG8_LDA(At, 1, 1); PG8_STAGE(PG8_SA(1, 0), a3, voffA);
            PG8_BAR; PG8_WAIT_L(0); PG8_MMA(1, 0, At, B0); PG8_BAR; PG8_SCHED;
            PG8_STAGE(PG8_SB(1, 1), b3 + hstepB, voffB);
            PG8_WAIT_V(6); PG8_BAR; PG8_MMA(1, 1, At, B1); PG8_BAR;
        }
        E(acc, cur, wr, wc, fr, fq);
        if (!has_next) break;
        if (!SPLIT || cur.part == 1) {
#pragma unroll
            for (int a = 0; a < 2; ++a)
#pragma unroll
                for (int b = 0; b < 2; ++b)
#pragma unroll
                    for (int m = 0; m < 4; ++m)
#pragma unroll
                        for (int n = 0; n < 2; ++n) acc[a][b][m][n] = (f32x4){0.f, 0.f, 0.f, 0.f};
        }
        cur = nxt; cA = nA; cB = nB; ++ui;
        if constexpr (SPLIT) nt = cur.part ? (K - splitK) / BK : splitK / BK;
    }
    PG8_WAIT_V(0);
    if (wr == 0) PG8_BAR;
    PG8_BAR;
#undef PG8_SA
#undef PG8_SB
#undef PG8_STAGE
#undef PG8_LDA
#undef PG8_LDB
#undef PG8_MMA
#undef PG8_WAIT_V
#undef PG8_WAIT_L
#undef PG8_BAR
#undef PG8_SCHED
}
}
using pg8::Unit;
typedef f32x4 AccT[2][2][4][2];

struct EpiFfnIn {
    static constexpr bool PERM = true;
    u16* hid;
    __device__ __forceinline__ void operator()(const AccT& acc, const Unit& u, int wr, int wc, int fr, int fq) const {
        const int row0 = u.pm * 256 + wr * 64 + fr, col0 = u.pn * 128 + wc * 32 + 8 * fq;
#pragma unroll
        for (int ai = 0; ai < 2; ++ai)
#pragma unroll
            for (int m = 0; m < 4; ++m) {
                u16* rowp = hid + (size_t)(row0 + ai * 128 + m * 16) * FF + col0;
                const f32x4 g0 = acc[ai][0][m][0], g1 = acc[ai][0][m][1], u0 = acc[ai][1][m][0], u1 = acc[ai][1][m][1];
                u32x4 w;
                w.x = cvt_pk_bf16(siluf(g0[0]) * u0[0], siluf(g0[1]) * u0[1]); w.y = cvt_pk_bf16(siluf(g0[2]) * u0[2], siluf(g0[3]) * u0[3]);
                w.z = cvt_pk_bf16(siluf(g1[0]) * u1[0], siluf(g1[1]) * u1[1]); w.w = cvt_pk_bf16(siluf(g1[2]) * u1[2], siluf(g1[3]) * u1[3]);
                *(u32x4*)rowp = w;
            }
    }
};
struct EpiRes {
    static constexpr bool PERM = false;
    u16* pre; const float* resf; const u16* resb; float alpha, scale;
    __device__ __forceinline__ void operator()(const AccT& acc, const Unit& u, int wr, int wc, int fr, int fq) const {
        const int row0 = u.pm * 256 + wr * 64 + fr, col0 = u.pn * 256 + wc * 32 + 4 * fq;
#pragma unroll
        for (int ai = 0; ai < 2; ++ai)
#pragma unroll
            for (int m = 0; m < 4; ++m) {
                const size_t off = (size_t)(row0 + ai * 128 + m * 16) * DM + col0;
#pragma unroll
                for (int bj = 0; bj < 2; ++bj)
#pragma unroll
                    for (int n = 0; n < 2; ++n) {
                        f32x4 r;
                        if (resf) r = *(const f32x4*)(resf + off + bj * 128 + n * 16);
                        else r = ld_bf4(resb + off + bj * 128 + n * 16);
                        const f32x4 o = r * alpha + acc[ai][bj][m][n] * scale;
                        u32x2 w; w.x = cvt_pk_bf16(o[0], o[1]); w.y = cvt_pk_bf16(o[2], o[3]);
                        *(u32x2*)(pre + off + bj * 128 + n * 16) = w;
                    }
                asm volatile("" ::: "memory");
            }
    }
};
struct EpiMix {
    static constexpr bool PERM = true;
    int pn0; u16* zr; u16* qrot; u16* krot; u16* ktz; u16* vt; u16* gsilu; u16* gate; const f32x2* cs;
    __device__ __forceinline__ void operator()(const AccT& acc, const Unit& u, int wr, int wc, int fr, int fq) const {
        const int T = pn0 + u.pn;
        const int row0 = u.pm * 256 + wr * 64 + fr, c8 = wc * 32 + 8 * fq;
        if (T < 7 || T >= 15) {
            u16* base; int ld, colt, act;
            if (T < 7) { base = zr; ld = 1792; colt = T * 256; act = 0; }
            else if (T < 19) { base = gsilu; ld = 1024; colt = (T - 15) * 256; act = 1; }
            else { base = gate; ld = 2048; colt = (T - 19) * 256; act = 2; }
#pragma unroll
            for (int ai = 0; ai < 2; ++ai)
#pragma unroll
                for (int m = 0; m < 4; ++m) {
                    u16* rowp = base + (size_t)(row0 + ai * 128 + m * 16) * ld + colt + c8;
#pragma unroll
                    for (int bj = 0; bj < 2; ++bj) {
                        f32x4 v0 = acc[ai][bj][m][0], v1 = acc[ai][bj][m][1];
                        if (act == 1) {
#pragma unroll
                            for (int j = 0; j < 4; ++j) { v0[j] = siluf(v0[j]); v1[j] = siluf(v1[j]); }
                        } else if (act == 2) {
#pragma unroll
                            for (int j = 0; j < 4; ++j) { v0[j] = sigm(v0[j]); v1[j] = sigm(v1[j]); }
                        }
                        u32x4 w; w.x = cvt_pk_bf16(v0[0], v0[1]); w.y = cvt_pk_bf16(v0[2], v0[3]); w.z = cvt_pk_bf16(v1[0], v1[1]); w.w = cvt_pk_bf16(v1[2], v1[3]);
                        *(u32x4*)(rowp + bj * 128) = w;
                    }
                    asm volatile("" ::: "memory");
                }
        } else if (T < 11) {
            const bool isk = T >= 9; const int t = isk ? T - 9 : T - 7;
            const int head = 2 * t + (wc >> 1), idx0 = 32 * (wc & 1) + 8 * fq;
            const float sc = isk ? 0.08838834764831845f : 1.0f;
            const float l2g = __log2f(1.0f - __builtin_amdgcn_exp2f((float)(-5 - head)));
#pragma unroll
            for (int ai = 0; ai < 2; ++ai)
#pragma unroll
                for (int m = 0; m < 4; ++m) {
                    const int row = row0 + ai * 128 + m * 16;
                    const f32x4* cp = (const f32x4*)(cs + (size_t)row * 64 + idx0);
                    float o1[8], o2[8];
#pragma unroll
                    for (int q = 0; q < 4; ++q) {
                        const f32x4 c2 = cp[q];
                        const int n = q >> 1, j = (q & 1) * 2;
                        const float xa = acc[ai][0][m][n][j], xb = acc[ai][1][m][n][j], ya = acc[ai][0][m][n][j + 1], yb = acc[ai][1][m][n][j + 1];
                        o1[2 * q] = (xa * c2[0] - xb * c2[1]) * sc; o2[2 * q] = (xb * c2[0] + xa * c2[1]) * sc;
                        o1[2 * q + 1] = (ya * c2[2] - yb * c2[3]) * sc; o2[2 * q + 1] = (yb * c2[2] + ya * c2[3]) * sc;
                    }
                    u16* np = (isk ? krot : qrot) + (size_t)row * 512 + head * 128 + idx0;
                    u32x4 w; w.x = cvt_pk_bf16(o1[0], o1[1]); w.y = cvt_pk_bf16(o1[2], o1[3]); w.z = cvt_pk_bf16(o1[4], o1[5]); w.w = cvt_pk_bf16(o1[6], o1[7]);
                    *(u32x4*)np = w;
                    w.x = cvt_pk_bf16(o2[0], o2[1]); w.y = cvt_pk_bf16(o2[2], o2[3]); w.z = cvt_pk_bf16(o2[4], o2[5]); w.w = cvt_pk_bf16(o2[6], o2[7]);
                    *(u32x4*)(np + 64) = w;
                    if (isk) {
                        const int b = row >> 13, s = row & 8191, chunk = s >> 7, mm = s & 127;
                        const float zeta = __builtin_amdgcn_exp2f(l2g * (float)(127 - mm));
                        u16* tp = ktz + ((size_t)((b * 4 + head) * 64 + chunk) * 128 + idx0) * 128 + mm;
#pragma unroll
                        for (int i = 0; i < 8; ++i) {
                            tp[(size_t)i * 128] = (u16)(cvt_pk_bf16(o1[i] * zeta, 0.f) & 0xffffu);
                            tp[(size_t)(64 + i) * 128] = (u16)(cvt_pk_bf16(o2[i] * zeta, 0.f) & 0xffffu);
                        }
                    }
                    asm volatile("" ::: "memory");
                }
        } else {
            const int head = T - 11;
#pragma unroll
            for (int ai = 0; ai < 2; ++ai)
#pragma unroll
                for (int m = 0; m < 4; ++m) {
                    const int row = row0 + ai * 128 + m * 16;
                    const int b = row >> 13, s = row & 8191, chunk = s >> 7, mm = s & 127;
                    u16* tp = vt + ((size_t)((b * 4 + head) * 64 + chunk) * 256 + c8) * 128 + mm;
#pragma unroll
                    for (int bj = 0; bj < 2; ++bj)
#pragma unroll
                        for (int n = 0; n < 2; ++n)
#pragma unroll
                            for (int j = 0; j < 4; ++j)
                                tp[(size_t)(bj * 128 + 4 * n + j) * 128] = (u16)(cvt_pk_bf16(acc[ai][bj][m][n][j], 0.f) & 0xffffu);
                    asm volatile("" ::: "memory");
                }
        }
    }
};
struct EpiLora {
    static constexpr bool PERM = true;
    _Float16* wbuf; _Float16* abuf; _Float16* gbuf; const float* w0; const float* a0;
    __device__ __forceinline__ void operator()(const AccT& acc, const Unit& u, int wr, int wc, int fr, int fq) const {
        const int kind = u.pn >> 1;
        const int row0 = u.pm * 256 + wr * 64 + fr, ch0 = (u.pn & 1) * 256 + wc * 32 + 8 * fq;
        _Float16* dst = wbuf + (size_t)kind * (size_t)(32u << 20);
        const float* bias = kind == 0 ? w0 : a0;
#pragma unroll
        for (int bj = 0; bj < 2; ++bj) {
            const int ch = ch0 + bj * 128;
            f32x4 b0 = {0.f, 0.f, 0.f, 0.f}, b1 = b0;
            if (kind < 2) { b0 = *(const f32x4*)(bias + ch); b1 = *(const f32x4*)(bias + ch + 4); }
#pragma unroll
            for (int ai = 0; ai < 2; ++ai)
#pragma unroll
                for (int m = 0; m < 4; ++m) {
                    const int row = row0 + ai * 128 + m * 16;
                    f32x4 v0 = acc[ai][bj][m][0] + b0, v1 = acc[ai][bj][m][1] + b1;
                    if (kind < 2) {
#pragma unroll
                        for (int j = 0; j < 4; ++j) { v0[j] = sigm(v0[j]); v1[j] = sigm(v1[j]); }
                    }
                    if (kind == 0) {
#pragma unroll
                        for (int j = 0; j < 4; ++j) { v0[j] = __builtin_amdgcn_exp2f(-DECAY_SCALE * 1.44269504f * v0[j]); v1[j] = __builtin_amdgcn_exp2f(-DECAY_SCALE * 1.44269504f * v1[j]); }
                    }
                    *(h16x8*)(dst + (size_t)row * 512 + ch) = (h16x8){(_Float16)v0[0], (_Float16)v0[1], (_Float16)v0[2], (_Float16)v0[3], (_Float16)v1[0], (_Float16)v1[1], (_Float16)v1[2], (_Float16)v1[3]};
                    asm volatile("" ::: "memory"); __builtin_amdgcn_sched_barrier(0);
                }
        }
    }
};
struct EpiBr {
    static constexpr bool PERM = true;
    const u16* gate; u16* merged;
    __device__ __forceinline__ void operator()(AccT& acc, const Unit& u, int wr, int wc, int fr, int fq) const {
        if (u.part == 0) scale(acc, u, wr, wc, fr, fq); else store(acc, u, wr, wc, fr, fq);
    }
    __device__ __forceinline__ void scale(AccT& acc, const Unit& u, int wr, int wc, int fr, int fq) const {
        const int row0 = u.pm * 256 + wr * 64 + fr, col0 = u.pn * 256 + wc * 32 + 8 * fq;
#pragma unroll
        for (int ai = 0; ai < 2; ++ai)
#pragma unroll
            for (int m = 0; m < 4; ++m) {
                const int row = row0 + ai * 128 + m * 16;
#pragma unroll
                for (int bj = 0; bj < 2; ++bj) {
                    const int c = col0 + bj * 128;
                    const u32x4 g1 = *(const u32x4*)(gate + (size_t)row * 2048 + c), g2 = *(const u32x4*)(gate + (size_t)row * 2048 + 1024 + c);
                    f32x4 r0, r1;
                    r0[0] = bflo(g1.x) * __builtin_amdgcn_rcpf(bflo(g2.x)); r0[1] = bfhi(g1.x) * __builtin_amdgcn_rcpf(bfhi(g2.x));
                    r0[2] = bflo(g1.y) * __builtin_amdgcn_rcpf(bflo(g2.y)); r0[3] = bfhi(g1.y) * __builtin_amdgcn_rcpf(bfhi(g2.y));
                    r1[0] = bflo(g1.z) * __builtin_amdgcn_rcpf(bflo(g2.z)); r1[1] = bfhi(g1.z) * __builtin_amdgcn_rcpf(bfhi(g2.z));
                    r1[2] = bflo(g1.w) * __builtin_amdgcn_rcpf(bflo(g2.w)); r1[3] = bfhi(g1.w) * __builtin_amdgcn_rcpf(bfhi(g2.w));
                    acc[ai][bj][m][0] = acc[ai][bj][m][0] * r0; acc[ai][bj][m][1] = acc[ai][bj][m][1] * r1;
                    asm volatile("" ::: "memory"); __builtin_amdgcn_sched_barrier(0);
                }
            }
    }
    __device__ __forceinline__ void store(const AccT& acc, const Unit& u, int wr, int wc, int fr, int fq) const {
        const int row0 = u.pm * 256 + wr * 64 + fr, col0 = u.pn * 256 + wc * 32 + 8 * fq;
#pragma unroll
        for (int ai = 0; ai < 2; ++ai)
#pragma unroll
            for (int m = 0; m < 4; ++m) {
                const int row = row0 + ai * 128 + m * 16;
#pragma unroll
                for (int bj = 0; bj < 2; ++bj) {
                    const int c = col0 + bj * 128;
                    const u32x4 gv = *(const u32x4*)(gate + (size_t)row * 2048 + 1024 + c);
                    const f32x4 g0 = {bflo(gv.x), bfhi(gv.x), bflo(gv.y), bfhi(gv.y)}, g1 = {bflo(gv.z), bfhi(gv.z), bflo(gv.w), bfhi(gv.w)};
                    const f32x4 v0 = g0 * acc[ai][bj][m][0], v1 = g1 * acc[ai][bj][m][1];
                    u32x4 w; w.x = cvt_pk_bf16(v0[0], v0[1]); w.y = cvt_pk_bf16(v0[2], v0[3]); w.z = cvt_pk_bf16(v1[0], v1[1]); w.w = cvt_pk_bf16(v1[2], v1[3]);
                    *(u32x4*)(merged + (size_t)row * DM + c) = w;
                }
                asm volatile("" ::: "memory");
            }
    }
};
struct EpiFin {
    static constexpr bool PERM = false;
    int mode; float* out; u16* pproj;
    __device__ __forceinline__ void operator()(const AccT& acc, const Unit& u, int wr, int wc, int fr, int fq) const {
        const int row0 = u.pm * 256 + wr * 64 + fr, col0 = u.pn * 256 + wc * 32 + 4 * fq;
#pragma unroll
        for (int ai = 0; ai < 2; ++ai)
#pragma unroll
            for (int m = 0; m < 4; ++m) {
                const size_t off = (size_t)(row0 + ai * 128 + m * 16) * DM + col0;
#pragma unroll
                for (int bj = 0; bj < 2; ++bj)
#pragma unroll
                    for (int n = 0; n < 2; ++n) {
                        const size_t o = off + bj * 128 + n * 16;
                        const f32x4 a = acc[ai][bj][m][n];
                        if (mode == 0) { u32x2 w; w.x = cvt_pk_bf16(a[0], a[1]); w.y = cvt_pk_bf16(a[2], a[3]); *(u32x2*)(pproj + o) = w; }
                        else {
                            const f32x4 pp = ld_bf4(pproj + o), h = *(const f32x4*)(out + o);
                            f32x4 r; r[0] = h[0] + sigm(a[0]) * pp[0]; r[1] = h[1] + sigm(a[1]) * pp[1]; r[2] = h[2] + sigm(a[2]) * pp[2]; r[3] = h[3] + sigm(a[3]) * pp[3];
                            *(f32x4*)(out + o) = r;
                        }
                    }
                asm volatile("" ::: "memory");
            }
    }
};

__device__ __forceinline__ int map_row(int mode, int n) {
    if (mode == 1) { const int bj = n >= FF ? 1 : 0, cc = n - bj * FF; return (cc >> 7) * 256 + bj * 128 + (cc & 127); }
    if (mode == 2) {
        if (n < 1792 || n >= 2816) return n;
        const int base = n < 2304 ? 1792 : 2304, c = n - base, head = c >> 7, half = (c >> 6) & 1, idx = c & 63;
        return base + 256 * (head >> 1) + 128 * half + 64 * (head & 1) + idx;
    }
    return n;
}
__device__ __forceinline__ void conv_weight(const float* W, int K, int N, u16* dst, int mode, size_t gtid, size_t gth, int ldk = 0) {
    if (ldk == 0) ldk = K;
    const size_t total = (size_t)N * (K >> 3);
    for (size_t idx = gtid; idx < total; idx += gth) {
        const int n = (int)(idx % N), kc = (int)(idx / N);
        const float* s = W + (size_t)(kc * 8) * N + n;
        float v[8];
#pragma unroll
        for (int i = 0; i < 8; ++i) v[i] = s[(size_t)i * N];
        u32x4 w; w.x = cvt_pk_bf16(v[0], v[1]); w.y = cvt_pk_bf16(v[2], v[3]); w.z = cvt_pk_bf16(v[4], v[5]); w.w = cvt_pk_bf16(v[6], v[7]);
        *(u32x4*)(dst + (size_t)map_row(mode, n) * ldk + kc * 8) = w;
    }
}
__device__ __forceinline__ void conv_rows(const float* __restrict__ src, u16* __restrict__ dst, size_t n8, size_t gtid, size_t gth) {
    for (size_t i = gtid; i < n8; i += 4 * gth) {
        f32x4 a[4], b[4];
#pragma unroll
        for (int u = 0; u < 4; ++u) { const size_t j = i + u * gth; if (j < n8) { a[u] = *(const f32x4*)(src + j * 8); b[u] = *(const f32x4*)(src + j * 8 + 4); } }
#pragma unroll
        for (int u = 0; u < 4; ++u) { const size_t j = i + u * gth; if (j < n8) {
            u32x4 w; w.x = cvt_pk_bf16(a[u][0], a[u][1]); w.y = cvt_pk_bf16(a[u][2], a[u][3]); w.z = cvt_pk_bf16(b[u][0], b[u][1]); w.w = cvt_pk_bf16(b[u][2], b[u][3]);
            *(u32x4*)(dst + j * 8) = w; } }
    }
}
__device__ __forceinline__ void phase_convert(const Params& P, size_t gtid, size_t gth) {
    unsigned char* ws = P.ws;
    conv_rows(P.in[0], (u16*)(ws + O_XB), (size_t)MTOK * DM / 8, gtid, gth);
    conv_rows(P.in[1], (u16*)(ws + O_PB), (size_t)MTOK * 256 / 8, gtid, gth);
    conv_weight(P.in[5], DM, 2 * FF, (u16*)(ws + O_W1T), 1, gtid, gth);
    conv_weight(P.in[6], FF, DM, (u16*)(ws + O_W2T), 0, gtid, gth);
    conv_weight(P.in[7], DM, MIXN, (u16*)(ws + O_WMT), 2, gtid, gth);
    conv_weight(P.in[24], DM, 2 * FF, (u16*)(ws + O_W3T), 1, gtid, gth);
    conv_weight(P.in[25], FF, DM, (u16*)(ws + O_W4T), 0, gtid, gth);
    conv_weight(P.in[19], 512, DM, (u16*)(ws + O_WBR), 0, gtid, gth, 1536);
    conv_weight(P.in[20], DM, DM, (u16*)(ws + O_WBR) + 512, 0, gtid, gth, 1536);
    conv_weight(P.in[21], DM, DM, (u16*)(ws + O_WMO), 0, gtid, gth);
    conv_weight(P.in[29], DM, DM, (u16*)(ws + O_WGT), 0, gtid, gth);
    conv_weight(P.in[28], 256, DM, (u16*)(ws + O_WPT), 0, gtid, gth);
    {
        u16* dst = (u16*)(ws + O_WLT);
        for (size_t idx = gtid; idx < 1536 * 32; idx += gth) {
            const int n = (int)(idx % 1536), kc = (int)(idx / 1536), k0 = kc * 8;
            float v[8];
#pragma unroll
            for (int i = 0; i < 8; ++i) v[i] = 0.f;
            if (n < 512) { if (k0 < 64) {
#pragma unroll
                for (int i = 0; i < 8; ++i) v[i] = P.in[10][(size_t)(k0 + i) * 512 + n]; } }
            else if (n < 1024) { if (k0 >= 64 && k0 < 128) {
#pragma unroll
                for (int i = 0; i < 8; ++i) v[i] = P.in[12][(size_t)(k0 - 64 + i) * 512 + (n - 512)]; } }
            else { if (k0 >= 128) {
#pragma unroll
                for (int i = 0; i < 8; ++i) v[i] = P.in[13][(size_t)(k0 - 128 + i) * 512 + (n - 1024)]; } }
            u32x4 w; w.x = cvt_pk_bf16(v[0], v[1]); w.y = cvt_pk_bf16(v[2], v[3]); w.z = cvt_pk_bf16(v[4], v[5]); w.w = cvt_pk_bf16(v[6], v[7]);
            *(u32x4*)(dst + (size_t)n * 256 + k0) = w;
        }
    }
    {
        f32x2* cs = (f32x2*)(ws + O_CS); const int* pos = (const int*)P.in[2];
        for (size_t idx = gtid; idx < (size_t)MTOK * 64; idx += gth) {
            const int tok = (int)(idx >> 6), i = (int)(idx & 63);
            const float invf = exp2f(-(float)i * (13.287712379549449f / 64.0f));
            const float ang = (float)pos[tok] * invf;
            const double a = (double)ang; const double kq = rint(a * 0.6366197723675814); const float r = (float)(a - kq * 1.5707963267948966);
            const int q = (int)((long long)kq & 3);
            const float r2 = r * r;
            const float sn = r + r * r2 * (-1.6666667e-1f + r2 * (8.3333333e-3f + r2 * (-1.9841270e-4f + r2 * 2.7557319e-6f)));
            const float cn = 1.0f + r2 * (-0.5f + r2 * (4.1666668e-2f + r2 * (-1.3888889e-3f + r2 * (2.4801587e-5f - r2 * 2.7557319e-7f))));
            float c, s;
            if (q == 0) { c = cn; s = sn; } else if (q == 1) { c = -sn; s = cn; } else if (q == 2) { c = -cn; s = -sn; } else { c = sn; s = -cn; }
            cs[idx] = (f32x2){c, s};
        }
    }
}

__device__ __forceinline__ void phase_ln(const u16* pre, const float* g, const float* b, u16* hb, float* hf, int gw, int ngw, int lane) {
    f32x4 gv[4], bv[4];
#pragma unroll
    for (int j = 0; j < 4; ++j) { gv[j] = *(const f32x4*)(g + 4 * lane + 256 * j); bv[j] = *(const f32x4*)(b + 4 * lane + 256 * j); }
    for (int row = gw; row < MTOK; row += 2 * ngw) {
        const int row2 = row + ngw;
        const u16* xr = pre + (size_t)row * DM + 4 * lane; const u16* xr2 = pre + (size_t)row2 * DM + 4 * lane;
        f32x4 v[4], v2[4]; float s = 0.f, t = 0.f;
#pragma unroll
        for (int j = 0; j < 4; ++j) { v[j] = ld_bf4(xr + 256 * j); v2[j] = ld_bf4(xr2 + 256 * j); }
#pragma unroll
        for (int j = 0; j < 4; ++j) { s += (v[j][0] + v[j][1]) + (v[j][2] + v[j][3]); t += (v2[j][0] + v2[j][1]) + (v2[j][2] + v2[j][3]); }
        const float mean = wave_sum(s) * (1.f / DM), mean2 = wave_sum(t) * (1.f / DM); float s2 = 0.f, t2 = 0.f;
#pragma unroll
        for (int j = 0; j < 4; ++j) { v[j] = v[j] - mean; s2 += (v[j][0] * v[j][0] + v[j][1] * v[j][1]) + (v[j][2] * v[j][2] + v[j][3] * v[j][3]);
                                      v2[j] = v2[j] - mean2; t2 += (v2[j][0] * v2[j][0] + v2[j][1] * v2[j][1]) + (v2[j][2] * v2[j][2] + v2[j][3] * v2[j][3]); }
        const float rstd = 1.0f / sqrtf(wave_sum(s2) * (1.f / DM) + LN_EPS), rstd2 = 1.0f / sqrtf(wave_sum(t2) * (1.f / DM) + LN_EPS);
#pragma unroll
        for (int j = 0; j < 4; ++j) {
            const f32x4 o = v[j] * rstd * gv[j] + bv[j], o2 = v2[j] * rstd2 * gv[j] + bv[j];
            u32x2 w; w.x = cvt_pk_bf16(o[0], o[1]); w.y = cvt_pk_bf16(o[2], o[3]);
            *(u32x2*)(hb + (size_t)row * DM + 4 * lane + 256 * j) = w;
            w.x = cvt_pk_bf16(o2[0], o2[1]); w.y = cvt_pk_bf16(o2[2], o2[3]);
            *(u32x2*)(hb + (size_t)row2 * DM + 4 * lane + 256 * j) = w;
            if (hf) { *(f32x4*)(hf + (size_t)row * DM + 4 * lane + 256 * j) = o; *(f32x4*)(hf + (size_t)row2 * DM + 4 * lane + 256 * j) = o2; }
        }
    }
}

__device__ __forceinline__ void phase_lora_prep(const u16* __restrict__ zr, const float* __restrict__ mu, u16* __restrict__ alora, size_t gtid, size_t gth) {
    const int c = (int)(gtid & 31) * 8;
    const f32x4 m0 = *(const f32x4*)(mu + 1536 + c), m1 = *(const f32x4*)(mu + 1536 + c + 4);
    for (size_t idx = gtid; idx < (size_t)MTOK * 32; idx += 4 * gth) {
        u32x4 z[4], zp[4];
#pragma unroll
        for (int u = 0; u < 4; ++u) {
            const int tok = (int)((idx + u * gth) >> 5);
            z[u] = *(const u32x4*)(zr + (size_t)tok * 1792 + 1536 + c);
            zp[u] = ((tok & (SEQ - 1)) != 0) ? *(const u32x4*)(zr + (size_t)(tok - 1) * 1792 + 1536 + c) : (u32x4){0u, 0u, 0u, 0u};
        }
#pragma unroll
        for (int u = 0; u < 4; ++u) {
            const int tok = (int)((idx + u * gth) >> 5);
            const f32x4 a0 = {bflo(z[u].x), bfhi(z[u].x), bflo(z[u].y), bfhi(z[u].y)}, a1 = {bflo(z[u].z), bfhi(z[u].z), bflo(z[u].w), bfhi(z[u].w)};
            const f32x4 p0 = {bflo(zp[u].x), bfhi(zp[u].x), bflo(zp[u].y), bfhi(zp[u].y)}, p1 = {bflo(zp[u].z), bfhi(zp[u].z), bflo(zp[u].w), bfhi(zp[u].w)};
            f32x4 v0 = a0 + (p0 - a0) * m0, v1 = a1 + (p1 - a1) * m1;
            if (c < 64) {
#pragma unroll
                for (int j = 0; j < 4; ++j) { v0[j] = 2.f * sigm(2.f * v0[j]) - 1.f; v1[j] = 2.f * sigm(2.f * v1[j]) - 1.f; }
            } else if (c >= 128) {
#pragma unroll
                for (int j = 0; j < 4; ++j) { v0[j] = sigm(v0[j]); v1[j] = sigm(v1[j]); }
            }
            u32x4 w; w.x = cvt_pk_bf16(v0[0], v0[1]); w.y = cvt_pk_bf16(v0[2], v0[3]); w.z = cvt_pk_bf16(v1[0], v1[1]); w.w = cvt_pk_bf16(v1[2], v1[3]);
            *(u32x4*)(alora + (size_t)tok * 256 + c) = w;
        }
    }
}
struct RwkvConst { f32x4 mur, muk, muv, kk_, ka_; };
__device__ __forceinline__ RwkvConst rwkv_const(const float* mu, const float* k_k, const float* k_a, int ch) {
    RwkvConst c; c.mur = *(const f32x4*)(mu + ch); c.muk = *(const f32x4*)(mu + 512 + ch); c.muv = *(const f32x4*)(mu + 1024 + ch); c.kk_ = *(const f32x4*)(k_k + ch); c.ka_ = *(const f32x4*)(k_a + ch); return c;
}
struct RwkvRaw { u32x2 zr_, zk_, zv_, pr_, pk_, pv_; h16x4 ah; };
__device__ __forceinline__ f32x4 bf4(const u32x2 t) { return (f32x4){bflo(t.x), bfhi(t.x), bflo(t.y), bfhi(t.y)}; }
__device__ __forceinline__ RwkvRaw rwkv_load(const u16* zr, const _Float16* abuf, int tok, int ch) {
    const bool first = (tok & (SEQ - 1)) == 0;
    const u16* zt = zr + (size_t)tok * 1792 + ch; const u16* zq = first ? zt : zt - 1792;
    RwkvRaw w; w.zr_ = *(const u32x2*)zt; w.zk_ = *(const u32x2*)(zt + 512); w.zv_ = *(const u32x2*)(zt + 1024);
    w.pr_ = *(const u32x2*)zq; w.pk_ = *(const u32x2*)(zq + 512); w.pv_ = *(const u32x2*)(zq + 1024);
    w.ah = *(const h16x4*)(abuf + (size_t)tok * 512 + ch);
    return w;
}
__device__ __forceinline__ void rwkv_compute(const RwkvRaw& w, int tok, const RwkvConst& c, f32x4& r, f32x4& kh, f32x4& v, f32x4& kk, f32x4& bb) {
    const bool first = (tok & (SEQ - 1)) == 0;
    r = bf4(w.zr_); f32x4 k = bf4(w.zk_); v = bf4(w.zv_);
    f32x4 rp = bf4(w.pr_), kp = bf4(w.pk_), vp = bf4(w.pv_);
    if (first) { rp = (f32x4){0.f, 0.f, 0.f, 0.f}; kp = rp; vp = rp; }
    r = r + (rp - r) * c.mur; k = k + (kp - k) * c.muk; v = v + (vp - v) * c.muv;
    const f32x4 a = {(float)w.ah[0], (float)w.ah[1], (float)w.ah[2], (float)w.ah[3]};
    kk = k * c.kk_;
    const float ss = red16((kk[0] * kk[0] + kk[1] * kk[1]) + (kk[2] * kk[2] + kk[3] * kk[3]));
    kk = kk * __builtin_amdgcn_rsqf(fmaxf(ss, 1e-24f));
    kh = k * (1.0f + (a - 1.0f) * c.ka_); bb = kk * a;
}
__device__ __forceinline__ void rwkv_prep(const u16* zr, const _Float16* abuf, int tok, int ch, const RwkvConst& c, f32x4& r, f32x4& kh, f32x4& v, f32x4& kk, f32x4& bb) {
    const RwkvRaw w = rwkv_load(zr, abuf, tok, ch); rwkv_compute(w, tok, c, r, kh, v, kk, bb);
}
__device__ __forceinline__ void scan_load(const u16* zr, const _Float16* wbuf, const _Float16* abuf, int tok0, int pst, int pch, int c, RwkvRaw (&raw)[2], h16x4 (&wv)[2]) {
#pragma unroll
    for (int half = 0; half < 2; ++half) {
        const int tok = tok0 + c * 32 + pst + 16 * half;
        raw[half] = rwkv_load(zr, abuf, tok, pch);
        wv[half] = *(const h16x4*)(wbuf + (size_t)tok * 512 + pch);
    }
}
__device__ __forceinline__ void scan_write(LAS _Float16* lds, const RwkvConst& rc, int tok0, int pst, int pks, int c, int bufi, const RwkvRaw (&raw)[2], const h16x4 (&wv)[2]) {
    LAS _Float16* bp = lds + bufi * (32 * 384);
#pragma unroll
    for (int half = 0; half < 2; ++half) {
        const int st = pst + 16 * half, tok = tok0 + c * 32 + st;
        f32x4 r, kh, v, kk, bb; rwkv_compute(raw[half], tok, rc, r, kh, v, kk, bb);
        LAS _Float16* sp = bp + st * 384 + 4 * pks;
        *(LAS h16x4*)(sp) = wv[half];
        *(LAS h16x4*)(sp + 64) = (h16x4){(_Float16)kk[0], (_Float16)kk[1], (_Float16)kk[2], (_Float16)kk[3]};
        *(LAS h16x4*)(sp + 128) = (h16x4){(_Float16)bb[0], (_Float16)bb[1], (_Float16)bb[2], (_Float16)bb[3]};
        *(LAS h16x4*)(sp + 192) = (h16x4){(_Float16)kh[0], (_Float16)kh[1], (_Float16)kh[2], (_Float16)kh[3]};
        *(LAS h16x4*)(sp + 256) = (h16x4){(_Float16)r[0], (_Float16)r[1], (_Float16)r[2], (_Float16)r[3]};
        *(LAS h16x4*)(sp + 320) = (h16x4){(_Float16)v[0], (_Float16)v[1], (_Float16)v[2], (_Float16)v[3]};
    }
}
__device__ __forceinline__ float fmix_lo(float a, unsigned h, float c) { float d; asm("v_fma_mix_f32 %0, %1, %2, %3 op_sel_hi:[0,1,0]" : "=v"(d) : "v"(a), "v"(h), "v"(c)); return d; }
__device__ __forceinline__ float fmix_hi(float a, unsigned h, float c) { float d; asm("v_fma_mix_f32 %0, %1, %2, %3 op_sel:[0,1,0] op_sel_hi:[0,1,0]" : "=v"(d) : "v"(a), "v"(h), "v"(c)); return d; }
__device__ __forceinline__ float fmix2_lo(unsigned a, unsigned h, float c) { float d; asm("v_fma_mix_f32 %0, %1, %2, %3 op_sel_hi:[1,1,0]" : "=v"(d) : "v"(a), "v"(h), "v"(c)); return d; }
__device__ __forceinline__ float fmix2_hi(unsigned a, unsigned h, float c) { float d; asm("v_fma_mix_f32 %0, %1, %2, %3 op_sel:[0,1,0] op_sel_hi:[1,1,0]" : "=v"(d) : "v"(a), "v"(h), "v"(c)); return d; }
__device__ __forceinline__ void scan_step_asm(float& s0, float& s1, float& s2, float& s3, float& q0, float& q1,
                                              unsigned kkx, unsigned kky, unsigned wx, unsigned wy, unsigned khx, unsigned khy, unsigned bbx, unsigned bby, unsigned rx, unsigned ry, unsigned v) {
    float p0, p1, u0, u1, u2, u3;
    asm("v_fma_mix_f32 %[p0], %[s0], %[kkx], 0 op_sel_hi:[0,1,0]\n\t"
        "v_fma_mix_f32 %[p0], %[s1], %[kkx], %[p0] op_sel:[0,1,0] op_sel_hi:[0,1,0]\n\t"
        "v_fma_mix_f32 %[p0], %[s2], %[kky], %[p0] op_sel_hi:[0,1,0]\n\t"
        "v_fma_mix_f32 %[p0], %[s3], %[kky], %[p0] op_sel:[0,1,0] op_sel_hi:[0,1,0]\n\t"
        "v_fma_mix_f32 %[u0], %[s0], %[wx], 0 op_sel_hi:[0,1,0]\n\t"
        "v_fma_mix_f32 %[u1], %[s1], %[wx], 0 op_sel:[0,1,0] op_sel_hi:[0,1,0]\n\t"
        "v_add_f32_dpp %[p0], %[p0], %[p0] quad_perm:[1,0,3,2] row_mask:0xf bank_mask:0xf bound_ctrl:1\n\t"
        "v_fma_mix_f32 %[u2], %[s2], %[wy], 0 op_sel_hi:[0,1,0]\n\t"
        "v_fma_mix_f32 %[u3], %[s3], %[wy], 0 op_sel:[0,1,0] op_sel_hi:[0,1,0]\n\t"
        "v_add_f32_dpp %[p0], %[p0], %[p0] quad_perm:[2,3,0,1] row_mask:0xf bank_mask:0xf bound_ctrl:1\n\t"
        "v_fma_mix_f32 %[u0], %[v], %[khx], %[u0] op_sel_hi:[1,1,0]\n\t"
        "v_fma_mix_f32 %[u1], %[v], %[khx], %[u1] op_sel:[0,1,0] op_sel_hi:[1,1,0]\n\t"
        "v_add_f32_dpp %[p0], %[p0], %[p0] row_half_mirror row_mask:0xf bank_mask:0xf bound_ctrl:1\n\t"
        "v_fma_mix_f32 %[u2], %[v], %[khy], %[u2] op_sel_hi:[1,1,0]\n\t"
        "v_fma_mix_f32 %[u3], %[v], %[khy], %[u3] op_sel:[0,1,0] op_sel_hi:[1,1,0]\n\t"
        "v_add_f32_dpp %[p0], %[p0], %[p0] row_mirror row_mask:0xf bank_mask:0xf bound_ctrl:1\n\t"
        "v_xor_b32 %[p1], 0x80000000, %[p0]\n\t"
        "v_fma_mix_f32 %[s0], %[p1], %[bbx], %[u0] op_sel_hi:[0,1,0]\n\t"
        "v_fma_mix_f32 %[s1], %[p1], %[bbx], %[u1] op_sel:[0,1,0] op_sel_hi:[0,1,0]\n\t"
        "v_fma_mix_f32 %[s2], %[p1], %[bby], %[u2] op_sel_hi:[0,1,0]\n\t"
        "v_fma_mix_f32 %[s3], %[p1], %[bby], %[u3] op_sel:[0,1,0] op_sel_hi:[0,1,0]\n\t"
        "v_fma_mix_f32 %[q0], %[s0], %[rx], 0 op_sel_hi:[0,1,0]\n\t"
        "v_fma_mix_f32 %[q0], %[s1], %[rx], %[q0] op_sel:[0,1,0] op_sel_hi:[0,1,0]\n\t"
        "v_fma_mix_f32 %[q0], %[s2], %[ry], %[q0] op_sel_hi:[0,1,0]\n\t"
        "v_fma_mix_f32 %[q0], %[s3], %[ry], %[q0] op_sel:[0,1,0] op_sel_hi:[0,1,0]"
        : [s0] "+v"(s0), [s1] "+v"(s1), [s2] "+v"(s2), [s3] "+v"(s3), [q0] "=&v"(q0),
          [p0] "=&v"(p0), [p1] "=&v"(p1), [u0] "=&v"(u0), [u1] "=&v"(u1), [u2] "=&v"(u2), [u3] "=&v"(u3)
        : [kkx] "v"(kkx), [kky] "v"(kky), [wx] "v"(wx), [wy] "v"(wy), [khx] "v"(khx), [khy] "v"(khy), [bbx] "v"(bbx), [bby] "v"(bby), [rx] "v"(rx), [ry] "v"(ry), [v] "v"(v));
    q1 = 0.f;
}
constexpr int TCH = 32;
constexpr int SCH = 6 * 64;
__device__ __forceinline__ void phase_scan(LAS unsigned char* ldsb, const u16* zr, const _Float16* wbuf, const _Float16* abuf, const float* mu, const float* k_k, const float* k_a,
                                           float* yraw, int tid, int bid) {
    LAS _Float16* lds = (LAS _Float16*)ldsb;
    LAS float* ypart = (LAS float*)(ldsb + 2 * TCH * SCH * 2);
    const int wid = tid >> 6, lane = tid & 63;
    const int blk = bid, xcd = blk & 7, slot = blk >> 3, bh = xcd * 8 + (slot >> 2), quarter = slot & 3;
    const int b = bh >> 3, h = bh & 7, tok0 = b * SEQ;
    const bool comp = wid < 4;
    const int rowl = quarter * 16 + (wid & 3) * 4 + (lane >> 4), ks = lane & 15;
    constexpr int NCH = SEQ / TCH;
    const int p = tid & 255, pst = p >> 4, pks = p & 15, pch = h * 64 + 4 * pks;
    RwkvConst rc = rwkv_const(mu, k_k, k_a, pch);
    RwkvRaw raw[2]; h16x4 wv[2];
    if (!comp) { scan_load(zr, wbuf, abuf, tok0, pst, pch, 0, raw, wv); scan_write(lds, rc, tok0, pst, pks, 0, 0, raw, wv); scan_load(zr, wbuf, abuf, tok0, pst, pch, 1, raw, wv); }
    __syncthreads();
    float s0 = 0.f, s1 = 0.f, s2 = 0.f, s3 = 0.f;
    LAS float* ypw = ypart + (wid & 3) * (TCH * 64);
#define SCAN_LD(W, KK, BB, KH, R, V, st) do { const LAS _Float16* sp_ = bp + (st) * SCH; W = *(const LAS u32x2*)(sp_ + 4 * ks); KK = *(const LAS u32x2*)(sp_ + 64 + 4 * ks); \
        BB = *(const LAS u32x2*)(sp_ + 128 + 4 * ks); KH = *(const LAS u32x2*)(sp_ + 192 + 4 * ks); R = *(const LAS u32x2*)(sp_ + 256 + 4 * ks); V = *(const LAS unsigned short*)(sp_ + 320 + rowl); } while (0)
#pragma nounroll
    for (int c = 0; c < NCH; ++c) {
        if (!comp) {
            if (c + 1 < NCH) scan_write(lds, rc, tok0, pst, pks, c + 1, (c + 1) & 1, raw, wv);
            if (c + 2 < NCH) scan_load(zr, wbuf, abuf, tok0, pst, pch, c + 2, raw, wv);
        }
        else {
            const LAS _Float16* bp = lds + (c & 1) * (TCH * SCH);
            u32x2 w, kk, bb, kh, r; unsigned v;
            SCAN_LD(w, kk, bb, kh, r, v, 0);
#pragma unroll
            for (int st = 0; st < TCH; ++st) {
                u32x2 nw, nkk, nbb, nkh, nr; unsigned nv;
                if (st + 1 < TCH) SCAN_LD(nw, nkk, nbb, nkh, nr, nv, st + 1);
                float q0, q1;
                scan_step_asm(s0, s1, s2, s3, q0, q1, kk.x, kk.y, w.x, w.y, kh.x, kh.y, bb.x, bb.y, r.x, r.y, v);
                ypw[st * 64 + lane] = q0;
                if (st + 1 < TCH) { w = nw; kk = nkk; bb = nbb; kh = nkh; r = nr; v = nv; }
            }
#pragma unroll
            for (int i = 0; i < 2; ++i) {
                const int pp = lane + 64 * i, st = pp >> 2, rw = pp & 3;
                const LAS f32x4* q = (const LAS f32x4*)(ypw + st * 64 + rw * 16);
                const f32x4 a0 = q[0], a1 = q[1], a2 = q[2], a3 = q[3];
                const f32x4 sm = (a0 + a1) + (a2 + a3);
                yraw[(size_t)(tok0 + c * TCH + st) * 512 + h * 64 + quarter * 16 + (wid & 3) * 4 + rw] = (sm[0] + sm[1]) + (sm[2] + sm[3]);
            }
        }
        asm volatile("s_waitcnt lgkmcnt(0)" ::: "memory"); __builtin_amdgcn_s_barrier(); asm volatile("" ::: "memory");
    }
#undef SCAN_LD
}
__device__ __forceinline__ void phase_rwkv_out(const float* __restrict__ yraw, const u16* __restrict__ zr, const _Float16* __restrict__ abuf, const _Float16* __restrict__ gbuf,
                                               const float* __restrict__ mu, const float* __restrict__ k_k, const float* __restrict__ k_a, const float* __restrict__ r_k,
                                               const float* __restrict__ gn_g, const float* __restrict__ gn_b, u16* __restrict__ yout, size_t gtid, size_t gth) {
    const int hk = (int)(gtid & 127), head = hk >> 4, ks = hk & 15, ch = head * 64 + ks * 4;
    const RwkvConst rc = rwkv_const(mu, k_k, k_a, ch);
    const f32x4 rk = *(const f32x4*)(r_k + ch), gg = *(const f32x4*)(gn_g + ch), gb = *(const f32x4*)(gn_b + ch);
#pragma unroll 2
    for (size_t idx = gtid; idx < (size_t)MTOK * 128; idx += gth) {
        const int tok = (int)(idx >> 7);
        const f32x4 y = *(const f32x4*)(yraw + (size_t)tok * 512 + ch);
        const h16x4 gh = *(const h16x4*)(gbuf + (size_t)tok * 512 + ch);
        f32x4 r, kh, v, kk, bb; rwkv_prep(zr, abuf, tok, ch, rc, r, kh, v, kk, bb);
        const float mean = red16((y[0] + y[1]) + (y[2] + y[3])) * (1.f / 64.f);
        const f32x4 d = y - mean;
        const float var = red16((d[0] * d[0] + d[1] * d[1]) + (d[2] * d[2] + d[3] * d[3])) * (1.f / 64.f);
        const float rstd = 1.0f / sqrtf(var + 64e-5f);
        const float bs = red16((r[0] * kh[0] * rk[0] + r[1] * kh[1] * rk[1]) + (r[2] * kh[2] * rk[2] + r[3] * kh[3] * rk[3]));
        float o[4];
#pragma unroll
        for (int j = 0; j < 4; ++j) o[j] = (d[j] * rstd * gg[j] + gb[j] + bs * v[j]) * (float)gh[j];
        u32x2 w; w.x = cvt_pk_bf16(o[0], o[1]); w.y = cvt_pk_bf16(o[2], o[3]);
        *(u32x2*)(yout + (size_t)tok * 1536 + ch) = w;
    }
}

__device__ __forceinline__ bf16x8 ldfrag(const u16* p) { return *(const bf16x8*)p; }
__device__ __forceinline__ void r1_issue(LAS unsigned char* lds, int it, int bid, int wid, int fr, int fq, const u16* ktz) {
    const int itc = it > 7 ? 7 : it, item = itc * 256 + bid;
    const u16* src = ktz + (size_t)item * 16384 + (size_t)(16 * wid + fr) * 128 + 8 * fq;
    LAS unsigned char* dst = lds + (it % 3) * 32768 + wid * 4096;
#pragma unroll
    for (int k = 0; k < 4; ++k) __builtin_amdgcn_global_load_lds((const unsigned*)(src + 32 * k), (LAS unsigned*)(dst + k * 1024), 16, 0, 0);
}
__device__ __forceinline__ void phase_r1(LAS unsigned char* lds, const u16* vt, const u16* ktz, u16* ut, int wid_, int lane, int bid) {
    const int wid = __builtin_amdgcn_readfirstlane(wid_), fr = lane & 15, fq = lane >> 4;
    r1_issue(lds, 0, bid, wid, fr, fq, ktz); r1_issue(lds, 1, bid, wid, fr, fq, ktz); r1_issue(lds, 2, bid, wid, fr, fq, ktz);
    bf16x8 xf[2][4];
    {
        const u16* V = vt + (size_t)bid * 32768 + (size_t)(wid * 32) * 128;
#pragma unroll
        for (int i = 0; i < 2; ++i)
#pragma unroll
            for (int k = 0; k < 4; ++k) xf[i][k] = ldfrag(V + (size_t)(16 * i + fr) * 128 + 32 * k + 8 * fq);
    }
#pragma unroll 1
    for (int it = 0; it < 8; ++it) {
        const int item = it * 256 + bid;
        asm volatile("s_waitcnt vmcnt(8)" ::: "memory");
        asm volatile("s_waitcnt lgkmcnt(0)" ::: "memory"); __builtin_amdgcn_s_barrier(); asm volatile("" ::: "memory");
        const LAS unsigned char* kb = lds + (it % 3) * 32768 + lane * 16;
        f32x4 acc[2][8];
#pragma unroll
        for (int i = 0; i < 2; ++i)
#pragma unroll
            for (int j = 0; j < 8; ++j) acc[i][j] = (f32x4){0.f, 0.f, 0.f, 0.f};
#pragma unroll
        for (int k = 0; k < 4; ++k)
#pragma unroll
            for (int j = 0; j < 8; ++j) {
                const bf16x8 yf = *(const LAS bf16x8*)(kb + (j * 4 + k) * 1024);
#pragma unroll
                for (int i = 0; i < 2; ++i) acc[i][j] = __builtin_amdgcn_mfma_f32_16x16x32_bf16(yf, xf[i][k], acc[i][j], 0, 0, 0);
            }
        u16* U = ut + (size_t)item * 256 * 128 + (size_t)(wid * 32) * 128;
#pragma unroll
        for (int i = 0; i < 2; ++i)
#pragma unroll
            for (int j = 0; j < 8; ++j) { u32x2 w; w.x = cvt_pk_bf16(acc[i][j][0], acc[i][j][1]); w.y = cvt_pk_bf16(acc[i][j][2], acc[i][j][3]);
                *(u32x2*)(U + (size_t)(16 * i + fr) * 128 + 16 * j + 4 * fq) = w; }
        {
            const int itn = it < 7 ? it + 1 : 7;
            const u16* V = vt + (size_t)(itn * 256 + bid) * 32768 + (size_t)(wid * 32) * 128;
#pragma unroll
            for (int i = 0; i < 2; ++i)
#pragma unroll
                for (int k = 0; k < 4; ++k) xf[i][k] = ldfrag(V + (size_t)(16 * i + fr) * 128 + 32 * k + 8 * fq);
        }
        asm volatile("s_waitcnt lgkmcnt(0)" ::: "memory"); __builtin_amdgcn_s_barrier(); asm volatile("" ::: "memory");
        r1_issue(lds, it + 3, bid, wid, fr, fq, ktz);
    }
    asm volatile("s_waitcnt vmcnt(0)" ::: "memory");
    asm volatile("s_waitcnt lgkmcnt(0)" ::: "memory"); __builtin_amdgcn_s_barrier(); asm volatile("" ::: "memory");
}
__device__ __forceinline__ void phase_r2(u16* rt, size_t gtid, size_t gth) {
    for (size_t idx = gtid; idx < (size_t)32 * 8192; idx += gth) {
        const int bh = (int)(idx >> 13), off = (int)(idx & 8191) * 4, head = bh & 3;
        const float cd = __builtin_amdgcn_exp2f(128.f * __log2f(1.0f - __builtin_amdgcn_exp2f((float)(-5 - head))));
        f32x4 R = {0.f, 0.f, 0.f, 0.f};
        u16* rp = rt + (size_t)bh * 64 * 32768 + off;
#pragma unroll 8
        for (int c = 0; c < 64; ++c) {
            const f32x4 uv = ld_bf4(rp + (size_t)c * 32768);
            u32x2 w; w.x = cvt_pk_bf16(R[0], R[1]); w.y = cvt_pk_bf16(R[2], R[3]);
            *(u32x2*)(rp + (size_t)c * 32768) = w;
            R = R * cd + uv;
        }
    }
}
#define R3_WAITV(n) asm volatile("s_waitcnt vmcnt(" #n ")" ::: "memory")
#define R3_BAR() do { asm volatile("s_waitcnt lgkmcnt(0)" ::: "memory"); __builtin_amdgcn_s_barrier(); asm volatile("" ::: "memory"); } while (0)
__device__ __forceinline__ void r3_issue(LAS unsigned char* lds, int g, int bid, int wid, int fr, int fq, const u16* krot, const u16* rt, const u16* vt) {
    int it = g / 5; const int st = g - it * 5; it = it > 7 ? 7 : it;
    const int item = it * 256 + bid, bh = item >> 6, chunk = item & 63, b = bh >> 2, head = bh & 3, tok0 = b * SEQ + chunk * 128;
    const u16* src;
    if (st == 0) src = krot + (size_t)(tok0 + 16 * wid + fr) * 512 + head * 128 + 8 * fq;
    else src = (wid < 4 ? rt : vt) + (size_t)item * 32768 + (size_t)(16 * (4 * (st - 1) + (wid & 3)) + fr) * 128 + 8 * fq;
    LAS unsigned char* dst = lds + (g % 3) * 32768 + wid * 4096;
#pragma unroll
    for (int k = 0; k < 4; ++k) __builtin_amdgcn_global_load_lds((const unsigned*)(src + 32 * k), (LAS unsigned*)(dst + k * 1024), 16, 0, 0);
}
__device__ __forceinline__ void phase_r3(LAS unsigned char* lds, const u16* qrot, const u16* krot, const u16* vt, const u16* rt, const u16* gsilu, u16* yret, int wid_, int lane, int bid) {
    const int wid = __builtin_amdgcn_readfirstlane(wid_), fr = lane & 15, fq = lane >> 4;
    LAS unsigned char* Pw = lds + 98304 + (16 * wid + fr) * 256;
    const int nK = (wid >> 1) + 1;
    const int n = 16 * wid + fr;
    r3_issue(lds, 0, bid, wid, fr, fq, krot, rt, vt); r3_issue(lds, 1, bid, wid, fr, fq, krot, rt, vt); r3_issue(lds, 2, bid, wid, fr, fq, krot, rt, vt);
#pragma unroll 1
    for (int it = 0; it < 8; ++it) {
        const int item = it * 256 + bid, bh = item >> 6, chunk = item & 63, b = bh >> 2, head = bh & 3, tok0 = b * SEQ + chunk * 128, g0 = it * 5;
        const float l2g = __log2f(1.0f - __builtin_amdgcn_exp2f((float)(-5 - head)));
        bf16x8 qf[4];
#pragma unroll
        for (int k = 0; k < 4; ++k) qf[k] = ldfrag(qrot + (size_t)(tok0 + n) * 512 + head * 128 + 32 * k + 8 * fq);
        R3_WAITV(8); R3_BAR();
        {
            const LAS unsigned char* kb = lds + (g0 % 3) * 32768 + lane * 16;
            for (int j = 0; j < 2 * nK; ++j) {
                f32x4 sc = {0.f, 0.f, 0.f, 0.f};
#pragma unroll
                for (int k = 0; k < 4; ++k) { const bf16x8 kf = *(const LAS bf16x8*)(kb + (j * 4 + k) * 1024); sc = __builtin_amdgcn_mfma_f32_16x16x32_bf16(kf, qf[k], sc, 0, 0, 0); }
                float pv[4];
#pragma unroll
                for (int r = 0; r < 4; ++r) { const int m = 16 * j + 4 * fq + r; pv[r] = (m <= n) ? sc[r] * __builtin_amdgcn_exp2f(l2g * (float)(n - m)) : 0.f; }
                u32x2 w; w.x = cvt_pk_bf16(pv[0], pv[1]); w.y = cvt_pk_bf16(pv[2], pv[3]);
                *(LAS u32x2*)(Pw + (16 * j + 4 * fq) * 2) = w;
            }
        }
        R3_BAR(); r3_issue(lds, g0 + 3, bid, wid, fr, fq, krot, rt, vt);
        f32x4 acc[16];
        const float xi = __builtin_amdgcn_exp2f(l2g * (float)(n + 1));
#pragma unroll
        for (int q = 0; q < 4; ++q) {
            R3_WAITV(8); R3_BAR();
            const LAS unsigned char* sb = lds + ((g0 + 1 + q) % 3) * 32768 + lane * 16;
#pragma unroll
            for (int jj = 0; jj < 4; ++jj) {
                f32x4 a = {0.f, 0.f, 0.f, 0.f};
#pragma unroll
                for (int k = 0; k < 4; ++k) { const bf16x8 rf = *(const LAS bf16x8*)(sb + (jj * 4 + k) * 1024); a = __builtin_amdgcn_mfma_f32_16x16x32_bf16(rf, qf[k], a, 0, 0, 0); }
                acc[4 * q + jj] = a * xi;
            }
            for (int k = 0; k < nK; ++k) {
                const bf16x8 pf = *(const LAS bf16x8*)(Pw + (32 * k + 8 * fq) * 2);
#pragma unroll
                for (int jj = 0; jj < 4; ++jj) { const bf16x8 vf = *(const LAS bf16x8*)(sb + (16 + jj * 4 + k) * 1024); acc[4 * q + jj] = __builtin_amdgcn_mfma_f32_16x16x32_bf16(vf, pf, acc[4 * q + jj], 0, 0, 0); }
            }
            R3_BAR(); r3_issue(lds, g0 + 4 + q, bid, wid, fr, fq, krot, rt, vt);
        }
        float s1 = 0.f;
#pragma unroll
        for (int j = 0; j < 16; ++j) s1 += (acc[j][0] + acc[j][1]) + (acc[j][2] + acc[j][3]);
        s1 += __shfl_xor(s1, 16); s1 += __shfl_xor(s1, 32);
        const float mean = s1 * (1.f / 256.f);
        float s2 = 0.f;
#pragma unroll
        for (int j = 0; j < 16; ++j) { acc[j] = acc[j] - mean; s2 += (acc[j][0] * acc[j][0] + acc[j][1] * acc[j][1]) + (acc[j][2] * acc[j][2] + acc[j][3] * acc[j][3]); }
        s2 += __shfl_xor(s2, 16); s2 += __shfl_xor(s2, 32);
        const float rstd = 1.0f / sqrtf(s2 * (1.f / 256.f) + LN_EPS);
        const u16* gp = gsilu + (size_t)(tok0 + n) * 1024 + head * 256 + 4 * fq;
        u16* op = yret + (size_t)(tok0 + n) * 1536 + head * 256 + 4 * fq;
#pragma unroll
        for (int j = 0; j < 16; ++j) {
            const f32x4 gv = ld_bf4(gp + 16 * j);
            const f32x4 o = acc[j] * rstd * gv;
            u32x2 w; w.x = cvt_pk_bf16(o[0], o[1]); w.y = cvt_pk_bf16(o[2], o[3]);
            *(u32x2*)(op + 16 * j) = w;
        }
    }
    R3_WAITV(0); R3_BAR();
}

#define XB_TMO      128
#define XB_XCNT(j)  (256  + 64 * (j))
#define XB_XSUB(j)  (1280 + 64 * (j))
#define XB_XGEN(j)  (2304 + 64 * (j))
#define XB_TOP      3328
#define XB_TOPGEN   3392
#define XCD_BAR_WORDS 3456
#define XB_SPIN_CAP (1u << 22)
__device__ __forceinline__ unsigned xb_ld(unsigned* p)              { return __hip_atomic_load(p, __ATOMIC_RELAXED, __HIP_MEMORY_SCOPE_AGENT); }
__device__ __forceinline__ unsigned xb_add(unsigned* p, unsigned v) { return __hip_atomic_fetch_add(p, v, __ATOMIC_RELAXED, __HIP_MEMORY_SCOPE_AGENT); }
__device__ __forceinline__ unsigned xb_xcc_id() { return (unsigned)__builtin_amdgcn_s_getreg((3 << 11) | 20) & 0xFu; }
#define XB_SPIN(cond, bar) do { unsigned _sp = 0; while (cond) { __builtin_amdgcn_s_sleep(1); \
    if ((++_sp & 255u) == 0u) { if (xb_ld(&(bar)[XB_TMO])) break; if (_sp > XB_SPIN_CAP) { atomicAdd(&(bar)[XB_TMO], 1u); break; } } } } while (0)
struct XcdBarrier { unsigned* bar; unsigned x; volatile LAS unsigned* st; };
__device__ __forceinline__ XcdBarrier xcd_barrier_post(unsigned* bar, volatile LAS unsigned* st) {
    XcdBarrier b; b.bar = bar; b.x = xb_xcc_id(); b.st = st;
    if (threadIdx.x == 0) (void)xb_add(&bar[XB_XCNT(b.x)], 1u);
    return b;
}
__device__ __forceinline__ void xcd_barrier_complete(unsigned* bar, unsigned x, unsigned& nloc, unsigned& nx) {
    const unsigned G = gridDim.x * gridDim.y * gridDim.z;
    unsigned sum, cnt, mine, sp = 0u;
    for (;;) {
        sum = 0u; cnt = 0u; mine = 0u;
#pragma unroll
        for (unsigned j = 0; j < 16; ++j) { const unsigned c = xb_ld(&bar[XB_XCNT(j)]); sum += c; cnt += (c > 0u) ? 1u : 0u; mine = (j == x) ? c : mine; }
        if (sum == G) break;
        __builtin_amdgcn_s_sleep(1);
        if ((++sp & 255u) == 0u) { if (xb_ld(&bar[XB_TMO])) break; if (sp > XB_SPIN_CAP) { atomicAdd(&bar[XB_TMO], 1u); break; } }
    }
    nloc = mine > 0u ? mine : 1u; nx = cnt > 0u ? cnt : 1u;
}
__device__ __forceinline__ void xcd_barrier(const XcdBarrier& b) {
    asm volatile("s_waitcnt vmcnt(0)" ::: "memory");
    __syncthreads();
    if (threadIdx.x == 0) {
        unsigned* bar = b.bar;
        __builtin_amdgcn_s_waitcnt(0);
        unsigned nloc = b.st[0], nx = b.st[1];
        if (nloc == 0u) { xcd_barrier_complete(bar, b.x, nloc, nx); b.st[0] = nloc; b.st[1] = nx; }
        const unsigned old = xb_add(&bar[XB_XSUB(b.x)], 1u);
        const unsigned gen = old / nloc;
        if (old + 1u == (gen + 1u) * nloc) {
            __builtin_amdgcn_fence(__ATOMIC_RELEASE, "agent");
            asm volatile("s_waitcnt vmcnt(0)" ::: "memory");
            const unsigned og = xb_add(&bar[XB_TOP], 1u);
            const unsigned tg = og / nx;
            if (og + 1u == (tg + 1u) * nx) xb_add(&bar[XB_TOPGEN], 1u);
            else XB_SPIN(xb_ld(&bar[XB_TOPGEN]) == tg, bar);
            __builtin_amdgcn_fence(__ATOMIC_ACQUIRE, "agent");
            xb_add(&bar[XB_XGEN(b.x)], 1u);
            asm volatile("s_waitcnt vmcnt(0)" ::: "memory");
        } else {
            XB_SPIN(xb_ld(&bar[XB_XGEN(b.x)]) == gen, bar);
            __builtin_amdgcn_fence(__ATOMIC_ACQUIRE, "agent");
            asm volatile("s_waitcnt vmcnt(0)" ::: "memory");
        }
    }
    __syncthreads();
}

#ifndef PHMASK
#define PHMASK 0xFFFFFF
#endif
#define PH_ON(p) ((PHMASK >> (p)) & 1)
#ifndef REPMASK
#define REPMASK 0
#endif
#define PH_BEGIN(p) _Pragma("nounroll") for (int rep_ = 0; rep_ < (int)PH_ON(p) * (1 + (int)((REPMASK >> (p)) & 1)); ++rep_) { int tid = threadIdx.x; asm volatile("" : "+v"(tid)); int bid = blockIdx.x; asm volatile("" : "+s"(bid)); \
        size_t zoff_ = 0; asm volatile("" : "+s"(zoff_)); unsigned char* ws = P.ws + zoff_; float* dout = (float*)((unsigned char*)P.out + zoff_);     \
        const int wid = tid >> 6, lane = tid & 63; const size_t gtid = (size_t)bid * 512 + tid, gth = (size_t)gridDim.x * 512; const int gw = bid * 8 + wid, ngw = gridDim.x * 8; \
        (void)wid; (void)lane; (void)gtid; (void)gth; (void)gw; (void)ngw; (void)ws; (void)dout;
#define PH_END xcd_barrier(xb); }

__device__ __forceinline__ void run_ffn_in(LAS unsigned char* lds, const u16* A, const u16* Wt, u16* hid, int bid) {
    pg8::Gemm g{A, Wt, DM, DM, DM}; pg8::StaticOrder S; S.init(MTOK, 2 * FF, gridDim.x, bid);
    EpiFfnIn E{hid}; pg8::gemm_phase(lds, g, S, E);
}
__device__ __forceinline__ void run_res(LAS unsigned char* lds, const u16* A, const u16* Wt, int K, u16* pre, const float* resf, const u16* resb, float scale, int bid) {
    pg8::Gemm g{A, Wt, K, K, K}; pg8::StaticOrder S; S.init(MTOK, DM, gridDim.x, bid);
    EpiRes E{pre, resf, resb, DN_ALPHA, scale}; pg8::gemm_phase(lds, g, S, E);
}
__device__ __forceinline__ void run_mix(LAS unsigned char* lds, unsigned char* ws, float* dout, int pn0, int npn, int bid) {
    pg8::Gemm g{(const u16*)(ws + O_H), (const u16*)(ws + O_WMT) + (size_t)pn0 * 256 * DM, DM, DM, DM};
    pg8::StaticOrder S; S.init(MTOK, npn * 256, gridDim.x, bid);
    EpiMix E{pn0, (u16*)dout, (u16*)(ws + O_QROT), (u16*)(ws + O_KROT), (u16*)(ws + O_KTZ), (u16*)(ws + O_VT), (u16*)(ws + O_GSILU), (u16*)dout, (const f32x2*)(ws + O_CS)};
    pg8::gemm_phase(lds, g, S, E);
}
__device__ __forceinline__ void run_fin(LAS unsigned char* lds, const u16* A, const u16* Wt, int K, int mode, float* out, u16* pproj, int bid) {
    pg8::Gemm g{A, Wt, K, K, K}; pg8::StaticOrder S; S.init(MTOK, DM, gridDim.x, bid);
    EpiFin E{mode, out, pproj}; pg8::gemm_phase(lds, g, S, E);
}

__global__ void __launch_bounds__(512, 2) mega(Params P) {
    extern __shared__ __attribute__((aligned(16))) unsigned char smem[];
    LAS unsigned char* lds = (LAS unsigned char*)smem;
    cg::grid_group grid = cg::this_grid();
    volatile LAS unsigned* xst = (volatile LAS unsigned*)(lds + pg8::STAGE_BYTES);
    if (threadIdx.x == 0) { xst[0] = 0u; xst[1] = 0u; }
    __syncthreads();
    const XcdBarrier xb = xcd_barrier_post((unsigned*)(P.ws + O_BAR), xst);
    if (P.ws == nullptr) grid.sync();

    PH_BEGIN(0) phase_convert(P, gtid, gth); PH_END
    PH_BEGIN(1) run_ffn_in(lds, (const u16*)(ws + O_XB), (const u16*)(ws + O_W1T), (u16*)(ws + O_HID), bid); PH_END
    PH_BEGIN(2) run_res(lds, (const u16*)(ws + O_HID), (const u16*)(ws + O_W2T), FF, (u16*)(ws + O_PRE), P.in[0], nullptr, 0.5f, bid); PH_END
    PH_BEGIN(3) phase_ln((const u16*)(ws + O_PRE), P.in[3], P.in[4], (u16*)(ws + O_H), nullptr, gw, ngw, lane); PH_END
    PH_BEGIN(4) run_mix(lds, ws, dout, 0, 7, bid); PH_END
    PH_BEGIN(5) phase_lora_prep((const u16*)dout, P.in[8], (u16*)(ws + O_ALORA), gtid, gth); PH_END
    PH_BEGIN(6) {
        pg8::Gemm g{(const u16*)(ws + O_ALORA), (const u16*)(ws + O_WLT), 256, 256, 256};
        pg8::StaticOrder S; S.init(MTOK, 1536, gridDim.x, bid);
        EpiLora E{(_Float16*)(ws + O_WBUF), (_Float16*)(ws + O_ABUF), (_Float16*)(ws + O_GBUF), P.in[9], P.in[11]};
        pg8::gemm_phase(lds, g, S, E);
    } PH_END
    PH_BEGIN(8) phase_scan(lds, (const u16*)dout, (const _Float16*)(ws + O_WBUF), (const _Float16*)(ws + O_ABUF), P.in[8], P.in[14], P.in[15], (float*)(ws + O_YRAW), tid, bid); PH_END
    PH_BEGIN(9) phase_rwkv_out((const float*)(ws + O_YRAW), (const u16*)dout, (const _Float16*)(ws + O_ABUF), (const _Float16*)(ws + O_GBUF), P.in[8], P.in[14], P.in[15], P.in[16], P.in[17], P.in[18], (u16*)(ws + O_Y), gtid, gth); PH_END
    PH_BEGIN(10) run_mix(lds, ws, dout, 7, 20, bid); PH_END
    PH_BEGIN(11) phase_r1(lds, (const u16*)(ws + O_VT), (const u16*)(ws + O_KTZ), (u16*)(ws + O_RT), wid, lane, bid); PH_END
    PH_BEGIN(12) phase_r2((u16*)(ws + O_RT), gtid, gth); PH_END
    PH_BEGIN(13) phase_r3(lds, (const u16*)(ws + O_QROT), (const u16*)(ws + O_KROT), (const u16*)(ws + O_VT), (const u16*)(ws + O_RT), (const u16*)(ws + O_GSILU), (u16*)(ws + O_Y) + 512, wid, lane, bid); PH_END
    PH_BEGIN(15) {
        pg8::Gemm g{(const u16*)(ws + O_Y), (const u16*)(ws + O_WBR), 1536, 1536, 1536};
        pg8::StaticOrder S; S.init(MTOK, DM, gridDim.x, bid);
        EpiBr E{(const u16*)dout, (u16*)(ws + O_MERGED)};
        pg8::gemm_phase<EpiBr, true>(lds, g, S, E, 512);
    } PH_END
    PH_BEGIN(17) run_res(lds, (const u16*)(ws + O_MERGED), (const u16*)(ws + O_WMO), DM, (u16*)(ws + O_PRE), nullptr, (const u16*)(ws + O_H), 1.0f, bid); PH_END
    PH_BEGIN(18) phase_ln((const u16*)(ws + O_PRE), P.in[22], P.in[23], (u16*)(ws + O_H), nullptr, gw, ngw, lane); PH_END
    PH_BEGIN(19) run_ffn_in(lds, (const u16*)(ws + O_H), (const u16*)(ws + O_W3T), (u16*)(ws + O_HID), bid); PH_END
    PH_BEGIN(20) run_res(lds, (const u16*)(ws + O_HID), (const u16*)(ws + O_W4T), FF, (u16*)(ws + O_PRE), nullptr, (const u16*)(ws + O_H), 0.5f, bid); PH_END
    PH_BEGIN(21) phase_ln((const u16*)(ws + O_PRE), P.in[26], P.in[27], (u16*)(ws + O_H), dout, gw, ngw, lane);
        run_fin(lds, (const u16*)(ws + O_PB), (const u16*)(ws + O_WPT), 256, 0, dout, (u16*)(ws + O_PPROJ), bid); PH_END
    PH_BEGIN(23) run_fin(lds, (const u16*)(ws + O_H), (const u16*)(ws + O_WGT), DM, 1, dout, (u16*)(ws + O_PPROJ), bid); PH_END
}

constexpr int LDS_BYTES = pg8::STAGE_BYTES + 16;

extern "C" void kernel_launch(void* const* d_in, const int* in_sizes, int n_in, void* d_out, int out_size, void* d_ws, size_t ws_size, hipStream_t stream) {
    static int grid = 0;
    if (grid == 0) {
        if (n_in != 30 || out_size != MTOK * DM || ws_size < WS_NEED) { fprintf(stderr, "kernel_launch: unexpected shapes (n_in %d out %d ws %zu)\n", n_in, out_size, ws_size); grid = -1; return; }
        int dev = 0, cus = 0, per_cu = 0;
        (void)hipGetDevice(&dev); (void)hipDeviceGetAttribute(&cus, hipDeviceAttributeMultiprocessorCount, dev);
        if (hipFuncSetAttribute((const void*)mega, hipFuncAttributeMaxDynamicSharedMemorySize, LDS_BYTES) != hipSuccess) { fprintf(stderr, "kernel_launch: hipFuncSetAttribute failed\n"); grid = -1; return; }
        (void)hipOccupancyMaxActiveBlocksPerMultiprocessor(&per_cu, (const void*)mega, 512, LDS_BYTES);
        (void)hipGetLastError();
        if (cus != 256 || per_cu < 1) { fprintf(stderr, "kernel_launch: needs 256 CUs with one resident workgroup each (cus %d per_cu %d)\n", cus, per_cu); grid = -1; return; }
        grid = 256;
    }
    if (grid < 0) return;
    if (hipMemsetAsync((char*)d_ws + O_BAR, 0, XCD_BAR_WORDS * 4, stream) != hipSuccess) { fprintf(stderr, "kernel_launch: memset of barrier words failed\n"); return; }
    Params p{};
    for (int i = 0; i < 30; ++i) p.in[i] = (const float*)d_in[i];
    p.out = (float*)d_out; p.ws = (unsigned char*)d_ws;
    void* args[] = {&p};
    hipError_t e = hipLaunchCooperativeKernel((const void*)mega, dim3(grid), dim3(512), args, LDS_BYTES, stream);
    if (e != hipSuccess) fprintf(stderr, "cooperative launch failed: %s\n", hipGetErrorString(e));
}
```

```cpp
#include <hip/hip_runtime.h>
#include <hip/hip_cooperative_groups.h>
#include <cstdio>
namespace cg = cooperative_groups;

#define LAS __attribute__((address_space(3)))
typedef unsigned short u16;
typedef short bf16x8 __attribute__((ext_vector_type(8)));
typedef float f32x4 __attribute__((ext_vector_type(4)));
typedef float f32x2 __attribute__((ext_vector_type(2)));
typedef unsigned u32x4 __attribute__((ext_vector_type(4)));
typedef unsigned u32x2 __attribute__((ext_vector_type(2)));
typedef _Float16 h16x4 __attribute__((ext_vector_type(4)));
typedef _Float16 h16x8 __attribute__((ext_vector_type(8)));

constexpr int MTOK = 65536, DM = 1024, FF = 2816, SEQ = 8192, MIXN = 6912;
constexpr float DN_ALPHA = 1.189207115f;
constexpr float LN_EPS = 1e-5f;
constexpr float DECAY_SCALE = 0.60653066f;

constexpr size_t MiB = 1ull << 20;
constexpr size_t O_W1T = 0;
constexpr size_t O_W2T = O_W1T + 5632ull * 1024 * 2;
constexpr size_t O_WMT = O_W2T + 1024ull * 2816 * 2;
constexpr size_t O_W3T = O_WMT + 6912ull * 1024 * 2;
constexpr size_t O_W4T = O_W3T + 5632ull * 1024 * 2;
constexpr size_t O_WLT = O_W4T + 1024ull * 2816 * 2;
constexpr size_t O_WBR = O_WLT + 1536ull * 256 * 2;
constexpr size_t O_WBT = O_WBR + 1024ull * 512 * 2;
constexpr size_t O_WMO = O_WBT + 1024ull * 1024 * 2;
constexpr size_t O_WGT = O_WMO + 1024ull * 1024 * 2;
constexpr size_t O_WPT = O_WGT + 1024ull * 1024 * 2;
static_assert(O_WPT + 1024ull * 256 * 2 <= 64 * MiB, "weights");
constexpr size_t O_BAR = 60 * MiB;
constexpr size_t O_CS = 64 * MiB;
constexpr size_t O_PB = 96 * MiB;
constexpr size_t O_H = 128 * MiB;
constexpr size_t O_XB = 256 * MiB;
constexpr size_t O_HID = 384 * MiB;
constexpr size_t O_ALORA = 256 * MiB;
constexpr size_t O_WBUF = 608 * MiB;
constexpr size_t O_ABUF = 672 * MiB;
constexpr size_t O_GBUF = 736 * MiB;
constexpr size_t O_YRAW = 288 * MiB;
constexpr size_t O_Y = 832 * MiB;
constexpr size_t O_QROT = 256 * MiB;
constexpr size_t O_KROT = 320 * MiB;
constexpr size_t O_KTZ = 384 * MiB;
constexpr size_t O_VT = 448 * MiB;
constexpr size_t O_GSILU = 576 * MiB;
constexpr size_t O_RT = 704 * MiB;
constexpr size_t O_TMP = 256 * MiB;
constexpr size_t O_MERGED = 512 * MiB;
constexpr size_t O_PPROJ = 384 * MiB;
constexpr size_t O_PRE = 256 * MiB;
constexpr size_t WS_NEED = 1024 * MiB;
static_assert(O_ABUF == O_WBUF + 64 * MiB && O_GBUF == O_ABUF + 64 * MiB, "EpiLora addresses W/A/G by stride");

struct Params { const float* in[30]; float* out; unsigned char* ws; };

__device__ __forceinline__ float bf2f(u16 v) { return __uint_as_float((unsigned)v << 16); }
__device__ __forceinline__ float bflo(unsigned v) { return __uint_as_float(v << 16); }
__device__ __forceinline__ float bfhi(unsigned v) { return __uint_as_float(v & 0xffff0000u); }
__device__ __forceinline__ f32x4 ld_bf4(const u16* p) { const u32x2 t = *(const u32x2*)p; return (f32x4){bflo(t.x), bfhi(t.x), bflo(t.y), bfhi(t.y)}; }
__device__ __forceinline__ unsigned cvt_pk_bf16(float lo, float hi) { unsigned r; asm volatile("v_cvt_pk_bf16_f32 %0, %1, %2" : "=v"(r) : "v"(lo), "v"(hi)); return r; }
__device__ __forceinline__ float sigm(float x) { return __builtin_amdgcn_rcpf(1.f + __builtin_amdgcn_exp2f(-1.44269504f * x)); }
__device__ __forceinline__ float siluf(float x) { return x * sigm(x); }
#define DPP_ADD(x, ctrl) ((x) + __builtin_bit_cast(float, __builtin_amdgcn_update_dpp(0, __builtin_bit_cast(int, (x)), (ctrl), 0xF, 0xF, true)))
__device__ __forceinline__ float red16(float x) {
    x = DPP_ADD(x, 0xB1); x = DPP_ADD(x, 0x4E); x = DPP_ADD(x, 0x141); x = DPP_ADD(x, 0x140); return x;
}
__device__ __forceinline__ float wave_sum(float v) {
#pragma unroll
    for (int o = 1; o < 64; o <<= 1) v += __shfl_xor(v, o);
    return v;
}

namespace pg8 {
constexpr int BM = 256, BK = 64, HALF = 128, HTB = HALF * BK * 2, STAGE_BYTES = 8 * HTB, NXCD = 8, WGM = 8;
__device__ __forceinline__ int lds_byte(int r, int c) { const int st = (r >> 4) * 2 + (c >> 5), rr = r & 15, cc = c & 31, ob = rr * 64 + cc * 2; return st * 1024 + (ob ^ (((ob >> 9) & 1) << 5)); }
__device__ __forceinline__ void stage_rc(int b, int& R, int& C) { const int st = b / 1024, sb = b % 1024, swz = sb ^ (((sb >> 9) & 1) << 5); R = (st >> 1) * 16 + swz / 64; C = (st & 1) * 32 + (swz % 64) / 2; }
__device__ __forceinline__ int perm32(int rho) { const int n = rho >> 4, i = rho & 15; return 8 * (i >> 2) + 4 * n + (i & 3); }
struct Unit { int pm, pn, part; };
struct Gemm { const u16* A; const u16* Bt; int lda, ldb, K; };
struct StaticOrder {
    int nM, nN, nwg, G, c, rev;
    __device__ void init(int M, int N, int G_, int c_, int rev_ = 0) { nM = M / BM; nN = N / BM; nwg = nM * nN; G = G_; c = c_; rev = rev_; }
    __device__ bool next(int i, Unit& u) const {
        const long L = (long)i * G + c; if (L >= nwg) return false;
        int wgid = (int)L; { const int q = nwg / NXCD, r = nwg % NXCD, xcd = wgid % NXCD, off = wgid / NXCD; wgid = (xcd < r ? xcd * (q + 1) : r * (q + 1) + (xcd - r) * q) + off; }
        const int nig = WGM * nN, gid = wgid / nig, fm = gid * WGM, gsz = (nM - fm) < WGM ? (nM - fm) : WGM;
        u.pm = fm + ((wgid % nig) % gsz); u.pn = (wgid % nig) / gsz; if (rev) u.pm = nM - 1 - u.pm; return true;
    }
};

template <class Epi, bool SPLIT = false>
__device__ __forceinline__ void gemm_phase(LAS unsigned char* lds, const Gemm g, const StaticOrder& S, const Epi& E, int splitK = 0) {
    int tid_ = threadIdx.x; asm volatile("" : "+v"(tid_));
    const int tid = tid_, wid = __builtin_amdgcn_readfirstlane(tid >> 6), lane = tid & 63, wr = wid >> 2, wc = wid & 3, fr = lane & 15, fq = lane >> 4;
    int K_ = g.K, lda_ = g.lda, ldb_ = g.ldb; asm volatile("" : "+s"(K_), "+s"(lda_), "+s"(ldb_));
    const int K = K_;
    int nt = SPLIT ? splitK / BK : K / BK;
    unsigned voffA[2], voffB[2];
#pragma unroll
    for (int i = 0; i < 2; ++i) { int R, C; stage_rc(tid * 16 + i * 8192, R, C); const int Rb = Epi::PERM ? ((R & ~31) + perm32(R & 31)) : R;
        voffA[i] = (unsigned)(R * lda_ + C) * 2u; voffB[i] = (unsigned)(Rb * ldb_ + C) * 2u; }
    const size_t kstep = (size_t)(BK * 2);
    const size_t hstepA = (size_t)HALF * lda_ * 2, hstepB = (size_t)HALF * ldb_ * 2;
    const size_t tstepA = 2 * hstepA, tstepB = 2 * hstepB;
    const unsigned ldsw = (unsigned)wid * 1024u;
    const int aoff = lds_byte(wr * 64 + fr, fq * 8), boff = lds_byte(wc * 32 + fr, fq * 8);
#define PG8_SA(b, h) (((b) * 2 + (h)) * HTB)
#define PG8_SB(b, h) ((4 + (b) * 2 + (h)) * HTB)
#define PG8_STAGE(bufoff, gbase, voff) do { _Pragma("unroll") for (int _i = 0; _i < 2; ++_i) \
        __builtin_amdgcn_global_load_lds((const unsigned*)((const char*)(gbase) + (voff)[_i]), (LAS unsigned*)(lds + (bufoff) + ldsw + _i * 8192), 16, 0, 0); } while (0)
#define PG8_LDA(dst, b, h) do { _Pragma("unroll") for (int m = 0; m < 4; ++m) _Pragma("unroll") for (int k = 0; k < 2; ++k) dst[m][k] = *(const LAS bf16x8*)(lds + PG8_SA(b, h) + aoff + m * 2048 + k * 1024); } while (0)
#define PG8_LDB(dst, b, h) do { _Pragma("unroll") for (int n = 0; n < 2; ++n) _Pragma("unroll") for (int k = 0; k < 2; ++k) dst[n][k] = *(const LAS bf16x8*)(lds + PG8_SB(b, h) + boff + n * 2048 + k * 1024); } while (0)
#define PG8_MMA(ai, bj, At, Bt) do { __builtin_amdgcn_s_setprio(1); _Pragma("unroll") for (int m = 0; m < 4; ++m) _Pragma("unroll") for (int n = 0; n < 2; ++n) _Pragma("unroll") for (int k = 0; k < 2; ++k) \
        acc[ai][bj][m][n] = __builtin_amdgcn_mfma_f32_16x16x32_bf16(Bt[n][k], At[m][k], acc[ai][bj][m][n], 0, 0, 0); __builtin_amdgcn_s_setprio(0); } while (0)
#define PG8_WAIT_V(n) asm volatile("s_waitcnt vmcnt(" #n ")" ::: "memory")
#define PG8_WAIT_L(n) asm volatile("s_waitcnt lgkmcnt(" #n ")" ::: "memory")
#define PG8_BAR __builtin_amdgcn_s_barrier()
#define PG8_SCHED __builtin_amdgcn_sched_barrier(0)
    Unit cur, nxt; int ui = 0;
    cur.part = 0; nxt.part = 0;
    if (!S.next(0, cur)) return;
    f32x4 acc[2][2][4][2];
#pragma unroll
    for (int a = 0; a < 2; ++a)
#pragma unroll
        for (int b = 0; b < 2; ++b)
#pragma unroll
            for (int m = 0; m < 4; ++m)
#pragma unroll
                for (int n = 0; n < 2; ++n) acc[a][b][m][n] = (f32x4){0.f, 0.f, 0.f, 0.f};
    bf16x8 At[4][2], B0[2][2], B1[2][2];
    const char* cA = (const char*)g.A + (size_t)cur.pm * tstepA; const char* cB = (const char*)g.Bt + (size_t)cur.pn * tstepB;
    const size_t poff = (size_t)splitK * 2;
    PG8_STAGE(PG8_SB(0, 0), cB, voffB); PG8_STAGE(PG8_SA(0, 0), cA, voffA); PG8_STAGE(PG8_SB(0, 1), cB + hstepB, voffB); PG8_STAGE(PG8_SA(0, 1), cA + hstepA, voffA);
    if (wr == 1) PG8_BAR;
    PG8_WAIT_V(4); PG8_BAR;
    PG8_STAGE(PG8_SB(1, 0), cB + kstep, voffB); PG8_STAGE(PG8_SA(1, 0), cA + kstep, voffA); PG8_STAGE(PG8_SB(1, 1), cB + hstepB + kstep, voffB);
    PG8_WAIT_V(6); PG8_BAR;
    for (;;) {
        bool has_next;
        if constexpr (SPLIT) { has_next = S.next((ui + 1) >> 1, nxt); nxt.part = (ui + 1) & 1; } else has_next = S.next(ui + 1, nxt);
        const char* nA = has_next ? (const char*)g.A + (size_t)nxt.pm * tstepA + (SPLIT && nxt.part ? poff : 0) : cA;
        const char* nB = has_next ? (const char*)g.Bt + (size_t)nxt.pn * tstepB + (SPLIT && nxt.part ? poff : 0) : cB;
        for (int t = 0; t < nt; t += 2) {
            const bool last = (t == nt - 2);
            const char* a1 = cA + (size_t)(t + 1) * kstep;
            const char* a2 = last ? nA : cA + (size_t)(t + 2) * kstep; const char* b2 = last ? nB : cB + (size_t)(t + 2) * kstep;
            const char* a3 = a2 + kstep; const char* b3 = b2 + kstep;
            PG8_LDB(B0, 0, 0); PG8_SCHED; PG8_LDA(At, 0, 0); PG8_STAGE(PG8_SA(1, 1), a1 + hstepA, voffA);
            PG8_WAIT_L(8); PG8_BAR; PG8_WAIT_L(0); PG8_MMA(0, 0, At, B0); PG8_BAR; PG8_SCHED;
            PG8_LDB(B1, 0, 1); PG8_STAGE(PG8_SB(0, 0), b2, voffB);
            PG8_BAR; PG8_WAIT_L(0); PG8_MMA(0, 1, At, B1); PG8_BAR;
            PG8_LDA(At, 0, 1); PG8_STAGE(PG8_SA(0, 0), a2, voffA);
            PG8_BAR; PG8_WAIT_L(0); PG8_MMA(1, 0, At, B0); PG8_BAR; PG8_SCHED;
            PG8_STAGE(PG8_SB(0, 1), b2 + hstepB, voffB);
            PG8_WAIT_V(6); PG8_BAR; PG8_MMA(1, 1, At, B1); PG8_BAR;
            PG8_LDB(B0, 1, 0); PG8_SCHED; PG8_LDA(At, 1, 0); PG8_STAGE(PG8_SA(0, 1), a2 + hstepA, voffA);
            PG8_WAIT_L(8); PG8_BAR; PG8_WAIT_L(0); PG8_MMA(0, 0, At, B0); PG8_BAR; PG8_SCHED;
            PG8_LDB(B1, 1, 1); PG8_STAGE(PG8_SB(1, 0), b3, voffB);
            PG8_BAR; PG8_WAIT_L(0); PG8_MMA(0, 1, At, B1); PG8_BAR;
            PG8_LDA(At, 1, 1); PG8_STAGE(PG8_SA(1, 0), a3, voffA);
            PG8_BAR; PG8_WAIT_L(0); PG8_MMA(1, 0, At, B0); PG8_BAR; PG8_SCHED;
            PG8_STAGE(PG8_SB(1, 1), b3 + hstepB, voffB);
            PG8_WAIT_V(6); PG8_BAR; PG8_MMA(1, 1, At, B1); PG8_BAR;
        }
        E(acc, cur, wr, wc, fr, fq);
        if (!has_next) break;
        if (!SPLIT || cur.part == 1) {
#pragma unroll
            for (int a = 0; a < 2; ++a)
#pragma unroll
                for (int b = 0; b < 2; ++b)
#pragma unroll
                    for (int m = 0; m < 4; ++m)
#pragma unroll
                        for (int n = 0; n < 2; ++n) acc[a][b][m][n] = (f32x4){0.f, 0.f, 0.f, 0.f};
        }
        cur = nxt; cA = nA; cB = nB; ++ui;
        if constexpr (SPLIT) nt = cur.part ? (K - splitK) / BK : splitK / BK;
    }
    PG8_WAIT_V(0);
    if (wr == 0) PG8_BAR;
    PG8_BAR;
#undef PG8_SA
#undef PG8_SB
#undef PG8_STAGE
#undef PG8_LDA
#undef PG8_LDB
#undef PG8_MMA
#undef PG8_WAIT_V
#undef PG8_WAIT_L
#undef PG8_BAR
#undef PG8_SCHED
}
}
using pg8::Unit;
typedef f32x4 AccT[2][2][4][2];

struct EpiFfnIn {
    static constexpr bool PERM = true;
    u16* hid;
    __device__ __forceinline__ void operator()(const AccT& acc, const Unit& u, int wr, int wc, int fr, int fq) const {
        const int row0 = u.pm * 256 + wr * 64 + fr, col0 = u.pn * 128 + wc * 32 + 8 * fq;
#pragma unroll
        for (int ai = 0; ai < 2; ++ai)
#pragma unroll
            for (int m = 0; m < 4; ++m) {
                u16* rowp = hid + (size_t)(row0 + ai * 128 + m * 16) * FF + col0;
                const f32x4 g0 = acc[ai][0][m][0], g1 = acc[ai][0][m][1], u0 = acc[ai][1][m][0], u1 = acc[ai][1][m][1];
                u32x4 w;
                w.x = cvt_pk_bf16(siluf(g0[0]) * u0[0], siluf(g0[1]) * u0[1]); w.y = cvt_pk_bf16(siluf(g0[2]) * u0[2], siluf(g0[3]) * u0[3]);
                w.z = cvt_pk_bf16(siluf(g1[0]) * u1[0], siluf(g1[1]) * u1[1]); w.w = cvt_pk_bf16(siluf(g1[2]) * u1[2], siluf(g1[3]) * u1[3]);
                *(u32x4*)rowp = w;
            }
    }
};
struct EpiRes {
    static constexpr bool PERM = false;
    u16* pre; const float* resf; const u16* resb; float alpha, scale;
    __device__ __forceinline__ void operator()(const AccT& acc, const Unit& u, int wr, int wc, int fr, int fq) const {
        const int row0 = u.pm * 256 + wr * 64 + fr, col0 = u.pn * 256 + wc * 32 + 4 * fq;
#pragma unroll
        for (int ai = 0; ai < 2; ++ai)
#pragma unroll
            for (int m = 0; m < 4; ++m) {
                const size_t off = (size_t)(row0 + ai * 128 + m * 16) * DM + col0;
#pragma unroll
                for (int bj = 0; bj < 2; ++bj)
#pragma unroll
                    for (int n = 0; n < 2; ++n) {
                        f32x4 r;
                        if (resf) r = *(const f32x4*)(resf + off + bj * 128 + n * 16);
                        else r = ld_bf4(resb + off + bj * 128 + n * 16);
                        const f32x4 o = r * alpha + acc[ai][bj][m][n] * scale;
                        u32x2 w; w.x = cvt_pk_bf16(o[0], o[1]); w.y = cvt_pk_bf16(o[2], o[3]);
                        *(u32x2*)(pre + off + bj * 128 + n * 16) = w;
                    }
                asm volatile("" ::: "memory");
            }
    }
};
struct EpiMix {
    static constexpr bool PERM = true;
    int pn0; u16* zr; u16* qrot; u16* krot; u16* ktz; u16* vt; u16* gsilu; u16* gate; const f32x2* cs;
    __device__ __forceinline__ void operator()(const AccT& acc, const Unit& u, int wr, int wc, int fr, int fq) const {
        const int T = pn0 + u.pn;
        const int row0 = u.pm * 256 + wr * 64 + fr, c8 = wc * 32 + 8 * fq;
        if (T < 7 || T >= 15) {
            u16* base; int ld, colt, act;
            if (T < 7) { base = zr; ld = 1792; colt = T * 256; act = 0; }
            else if (T < 19) { base = gsilu; ld = 1024; colt = (T - 15) * 256; act = 1; }
            else { base = gate; ld = 2048; colt = (T - 19) * 256; act = 2; }
#pragma unroll
            for (int ai = 0; ai < 2; ++ai)
#pragma unroll
                for (int m = 0; m < 4; ++m) {
                    u16* rowp = base + (size_t)(row0 + ai * 128 + m * 16) * ld + colt + c8;
#pragma unroll
                    for (int bj = 0; bj < 2; ++bj) {
                        f32x4 v0 = acc[ai][bj][m][0], v1 = acc[ai][bj][m][1];
                        if (act == 1) {
#pragma unroll
                            for (int j = 0; j < 4; ++j) { v0[j] = siluf(v0[j]); v1[j] = siluf(v1[j]); }
                        } else if (act == 2) {
#pragma unroll
                            for (int j = 0; j < 4; ++j) { v0[j] = sigm(v0[j]); v1[j] = sigm(v1[j]); }
                        }
                        u32x4 w; w.x = cvt_pk_bf16(v0[0], v0[1]); w.y = cvt_pk_bf16(v0[2], v0[3]); w.z = cvt_pk_bf16(v1[0], v1[1]); w.w = cvt_pk_bf16(v1[2], v1[3]);
                        *(u32x4*)(rowp + bj * 128) = w;
                    }
                    asm volatile("" ::: "memory");
                }
        } else if (T < 11) {
            const bool isk = T >= 9; const int t = isk ? T - 9 : T - 7;
            const int head = 2 * t + (wc >> 1), idx0 = 32 * (wc & 1) + 8 * fq;
            const float sc = isk ? 0.08838834764831845f : 1.0f;
            const float l2g = __log2f(1.0f - __builtin_amdgcn_exp2f((float)(-5 - head)));
#pragma unroll
            for (int ai = 0; ai < 2; ++ai)
#pragma unroll
                for (int m = 0; m < 4; ++m) {
                    const int row = row0 + ai * 128 + m * 16;
                    const f32x4* cp = (const f32x4*)(cs + (size_t)row * 64 + idx0);
                    float o1[8], o2[8];
#pragma unroll
                    for (int q = 0; q < 4; ++q) {
                        const f32x4 c2 = cp[q];
                        const int n = q >> 1, j = (q & 1) * 2;
                        const float xa = acc[ai][0][m][n][j], xb = acc[ai][1][m][n][j], ya = acc[ai][0][m][n][j + 1], yb = acc[ai][1][m][n][j + 1];
                        o1[2 * q] = (xa * c2[0] - xb * c2[1]) * sc; o2[2 * q] = (xb * c2[0] + xa * c2[1]) * sc;
                        o1[2 * q + 1] = (ya * c2[2] - yb * c2[3]) * sc; o2[2 * q + 1] = (yb * c2[2] + ya * c2[3]) * sc;
                    }
                    u16* np = (isk ? krot : qrot) + (size_t)row * 512 + head * 128 + idx0;
                    u32x4 w; w.x = cvt_pk_bf16(o1[0], o1[1]); w.y = cvt_pk_bf16(o1[2], o1[3]); w.z = cvt_pk_bf16(o1[4], o1[5]); w.w = cvt_pk_bf16(o1[6], o1[7]);
                    *(u32x4*)np = w;
                    w.x = cvt_pk_bf16(o2[0], o2[1]); w.y = cvt_pk_bf16(o2[2], o2[3]); w.z = cvt_pk_bf16(o2[4], o2[5]); w.w = cvt_pk_bf16(o2[6], o2[7]);
                    *(u32x4*)(np + 64) = w;
                    if (isk) {
                        const int b = row >> 13, s = row & 8191, chunk = s >> 7, mm = s & 127;
                        const float zeta = __builtin_amdgcn_exp2f(l2g * (float)(127 - mm));
                        u16* tp = ktz + ((size_t)((b * 4 + head) * 64 + chunk) * 128 + idx0) * 128 + mm;
#pragma unroll
                        for (int i = 0; i < 8; ++i) {
                            tp[(size_t)i * 128] = (u16)(cvt_pk_bf16(o1[i] * zeta, 0.f) & 0xffffu);
                            tp[(size_t)(64 + i) * 128] = (u16)(cvt_pk_bf16(o2[i] * zeta, 0.f) & 0xffffu);
                        }
                    }
                    asm volatile("" ::: "memory");
                }
        } else {
            const int head = T - 11;
#pragma unroll
            for (int ai = 0; ai < 2; ++ai)
#pragma unroll
                for (int m = 0; m < 4; ++m) {
                    const int row = row0 + ai * 128 + m * 16;
                    const int b = row >> 13, s = row & 8191, chunk = s >> 7, mm = s & 127;
                    u16* tp = vt + ((size_t)((b * 4 + head) * 64 + chunk) * 256 + c8) * 128 + mm;
#pragma unroll
                    for (int bj = 0; bj < 2; ++bj)
#pragma unroll
                        for (int n = 0; n < 2; ++n)
#pragma unroll
                            for (int j = 0; j < 4; ++j)
                                tp[(size_t)(bj * 128 + 4 * n + j) * 128] = (u16)(cvt_pk_bf16(acc[ai][bj][m][n][j], 0.f) & 0xffffu);
                    asm volatile("" ::: "memory");
                }
        }
    }
};
struct EpiLora {
    static constexpr bool PERM = true;
    _Float16* wbuf; _Float16* abuf; _Float16* gbuf; const float* w0; const float* a0;
    __device__ __forceinline__ void operator()(const AccT& acc, const Unit& u, int wr, int wc, int fr, int fq) const {
        const int kind = u.pn >> 1;
        const int row0 = u.pm * 256 + wr * 64 + fr, ch0 = (u.pn & 1) * 256 + wc * 32 + 8 * fq;
        _Float16* dst = wbuf + (size_t)kind * (size_t)(32u << 20);
        const float* bias = kind == 0 ? w0 : a0;
#pragma unroll
        for (int bj = 0; bj < 2; ++bj) {
            const int ch = ch0 + bj * 128;
            f32x4 b0 = {0.f, 0.f, 0.f, 0.f}, b1 = b0;
            if (kind < 2) { b0 = *(const f32x4*)(bias + ch); b1 = *(const f32x4*)(bias + ch + 4); }
#pragma unroll
            for (int ai = 0; ai < 2; ++ai)
#pragma unroll
                for (int m = 0; m < 4; ++m) {
                    const int row = row0 + ai * 128 + m * 16;
                    f32x4 v0 = acc[ai][bj][m][0] + b0, v1 = acc[ai][bj][m][1] + b1;
                    if (kind < 2) {
#pragma unroll
                        for (int j = 0; j < 4; ++j) { v0[j] = sigm(v0[j]); v1[j] = sigm(v1[j]); }
                    }
                    if (kind == 0) {
#pragma unroll
                        for (int j = 0; j < 4; ++j) { v0[j] = __builtin_amdgcn_exp2f(-DECAY_SCALE * 1.44269504f * v0[j]); v1[j] = __builtin_amdgcn_exp2f(-DECAY_SCALE * 1.44269504f * v1[j]); }
                    }
                    *(h16x8*)(dst + (size_t)row * 512 + ch) = (h16x8){(_Float16)v0[0], (_Float16)v0[1], (_Float16)v0[2], (_Float16)v0[3], (_Float16)v1[0], (_Float16)v1[1], (_Float16)v1[2], (_Float16)v1[3]};
                    asm volatile("" ::: "memory"); __builtin_amdgcn_sched_barrier(0);
                }
        }
    }
};
struct EpiBr {
    static constexpr bool PERM = true;
    const u16* gate; u16* merged;
    __device__ __forceinline__ void operator()(AccT& acc, const Unit& u, int wr, int wc, int fr, int fq) const {
        if (u.part == 0) scale(acc, u, wr, wc, fr, fq); else store(acc, u, wr, wc, fr, fq);
    }
    __device__ __forceinline__ void scale(AccT& acc, const Unit& u, int wr, int wc, int fr, int fq) const {
        const int row0 = u.pm * 256 + wr * 64 + fr, col0 = u.pn * 256 + wc * 32 + 8 * fq;
#pragma unroll
        for (int ai = 0; ai < 2; ++ai)
#pragma unroll
            for (int m = 0; m < 4; ++m) {
                const int row = row0 + ai * 128 + m * 16;
#pragma unroll
                for (int bj = 0; bj < 2; ++bj) {
                    const int c = col0 + bj * 128;
                    const u32x4 g1 = *(const u32x4*)(gate + (size_t)row * 2048 + c), g2 = *(const u32x4*)(gate + (size_t)row * 2048 + 1024 + c);
                    f32x4 r0, r1;
                    r0[0] = bflo(g1.x) * __builtin_amdgcn_rcpf(bflo(g2.x)); r0[1] = bfhi(g1.x) * __builtin_amdgcn_rcpf(bfhi(g2.x));
                    r0[2] = bflo(g1.y) * __builtin_amdgcn_rcpf(bflo(g2.y)); r0[3] = bfhi(g1.y) * __builtin_amdgcn_rcpf(bfhi(g2.y));
                    r1[0] = bflo(g1.z) * __builtin_amdgcn_rcpf(bflo(g2.z)); r1[1] = bfhi(g1.z) * __builtin_amdgcn_rcpf(bfhi(g2.z));
                    r1[2] = bflo(g1.w) * __builtin_amdgcn_rcpf(bflo(g2.w)); r1[3] = bfhi(g1.w) * __builtin_amdgcn_rcpf(bfhi(g2.w));
                    acc[ai][bj][m][0] = acc[ai][bj][m][0] * r0; acc[ai][bj][m][1] = acc[ai][bj][m][1] * r1;
                    asm volatile("" ::: "memory"); __builtin_amdgcn_sched_barrier(0);
                }
            }
    }
    __device__ __forceinline__ void store(const AccT& acc, const Unit& u, int wr, int wc, int fr, int fq) const {
        const int row0 = u.pm * 256 + wr * 64 + fr, col0 = u.pn * 256 + wc * 32 + 8 * fq;
#pragma unroll
        for (int ai = 0; ai < 2; ++ai)
#pragma unroll
            for (int m = 0; m < 4; ++m) {
                const int row = row0 + ai * 128 + m * 16;
#pragma unroll
                for (int bj = 0; bj < 2; ++bj) {
                    const int c = col0 + bj * 128;
                    const u32x4 gv = *(const u32x4*)(gate + (size_t)row * 2048 + 1024 + c);
                    const f32x4 g0 = {bflo(gv.x), bfhi(gv.x), bflo(gv.y), bfhi(gv.y)}, g1 = {bflo(gv.z), bfhi(gv.z), bflo(gv.w), bfhi(gv.w)};
                    const f32x4 v0 = g0 * acc[ai][bj][m][0], v1 = g1 * acc[ai][bj][m][1];
                    u32x4 w; w.x = cvt_pk_bf16(v0[0], v0[1]); w.y = cvt_pk_bf16(v0[2], v0[3]); w.z = cvt_pk_bf16(v1[0], v1[1]); w.w = cvt_pk_bf16(v1[2], v1[3]);
                    *(u32x4*)(merged + (size_t)row * DM + c) = w;
                }
                asm volatile("" ::: "memory");
            }
    }
};
struct EpiFin {
    static constexpr bool PERM = false;
    int mode; float* out; u16* pproj;
    __device__ __forceinline__ void operator()(const AccT& acc, const Unit& u, int wr, int wc, int fr, int fq) const {
        const int row0 = u.pm * 256 + wr * 64 + fr, col0 = u.pn * 256 + wc * 32 + 4 * fq;
#pragma unroll
        for (int ai = 0; ai < 2; ++ai)
#pragma unroll
            for (int m = 0; m < 4; ++m) {
                const size_t off = (size_t)(row0 + ai * 128 + m * 16) * DM + col0;
#pragma unroll
                for (int bj = 0; bj < 2; ++bj)
#pragma unroll
                    for (int n = 0; n < 2; ++n) {
                        const size_t o = off + bj * 128 + n * 16;
                        const f32x4 a = acc[ai][bj][m][n];
                        if (mode == 0) { u32x2 w; w.x = cvt_pk_bf16(a[0], a[1]); w.y = cvt_pk_bf16(a[2], a[3]); *(u32x2*)(pproj + o) = w; }
                        else {
                            const f32x4 pp = ld_bf4(pproj + o), h = *(const f32x4*)(out + o);
                            f32x4 r; r[0] = h[0] + sigm(a[0]) * pp[0]; r[1] = h[1] + sigm(a[1]) * pp[1]; r[2] = h[2] + sigm(a[2]) * pp[2]; r[3] = h[3] + sigm(a[3]) * pp[3];
                            *(f32x4*)(out + o) = r;
                        }
                    }
                asm volatile("" ::: "memory");
            }
    }
};

__device__ __forceinline__ int map_row(int mode, int n) {
    if (mode == 1) { const int bj = n >= FF ? 1 : 0, cc = n - bj * FF; return (cc >> 7) * 256 + bj * 128 + (cc & 127); }
    if (mode == 2) {
        if (n < 1792 || n >= 2816) return n;
        const int base = n < 2304 ? 1792 : 2304, c = n - base, head = c >> 7, half = (c >> 6) & 1, idx = c & 63;
        return base + 256 * (head >> 1) + 128 * half + 64 * (head & 1) + idx;
    }
    return n;
}
__device__ __forceinline__ void conv_weight(const float* W, int K, int N, u16* dst, int mode, size_t gtid, size_t gth, int ldk = 0) {
    if (ldk == 0) ldk = K;
    const size_t total = (size_t)N * (K >> 3);
    for (size_t idx = gtid; idx < total; idx += gth) {
        const int n = (int)(idx % N), kc = (int)(idx / N);
        const float* s = W + (size_t)(kc * 8) * N + n;
        float v[8];
#pragma unroll
        for (int i = 0; i < 8; ++i) v[i] = s[(size_t)i * N];
        u32x4 w; w.x = cvt_pk_bf16(v[0], v[1]); w.y = cvt_pk_bf16(v[2], v[3]); w.z = cvt_pk_bf16(v[4], v[5]); w.w = cvt_pk_bf16(v[6], v[7]);
        *(u32x4*)(dst + (size_t)map_row(mode, n) * ldk + kc * 8) = w;
    }
}
__device__ __forceinline__ void conv_rows(const float* __restrict__ src, u16* __restrict__ dst, size_t n8, size_t gtid, size_t gth) {
    for (size_t i = gtid; i < n8; i += 4 * gth) {
        f32x4 a[4], b[4];
#pragma unroll
        for (int u = 0; u < 4; ++u) { const size_t j = i + u * gth; if (j < n8) { a[u] = *(const f32x4*)(src + j * 8); b[u] = *(const f32x4*)(src + j * 8 + 4); } }
#pragma unroll
        for (int u = 0; u < 4; ++u) { const size_t j = i + u * gth; if (j < n8) {
            u32x4 w; w.x = cvt_pk_bf16(a[u][0], a[u][1]); w.y = cvt_pk_bf16(a[u][2], a[u][3]); w.z = cvt_pk_bf16(b[u][0], b[u][1]); w.w = cvt_pk_bf16(b[u][2], b[u][3]);
            *(u32x4*)(dst + j * 8) = w; } }
    }
}
__device__ __forceinline__ void phase_convert(const Params& P, size_t gtid, size_t gth) {
    unsigned char* ws = P.ws;
    conv_rows(P.in[1], (u16*)(ws + O_PB), (size_t)MTOK * 256 / 8, gtid, gth);
    conv_weight(P.in[5], DM, 2 * FF, (u16*)(ws + O_W1T), 1, gtid, gth);
    conv_weight(P.in[6], FF, DM, (u16*)(ws + O_W2T), 0, gtid, gth);
    conv_weight(P.in[7], DM, MIXN, (u16*)(ws + O_WMT), 2, gtid, gth);
    conv_weight(P.in[24], DM, 2 * FF, (u16*)(ws + O_W3T), 1, gtid, gth);
    conv_weight(P.in[25], FF, DM, (u16*)(ws + O_W4T), 0, gtid, gth);
    conv_weight(P.in[19], 512, DM, (u16*)(ws + O_WBR), 0, gtid, gth, 1536);
    conv_weight(P.in[20], DM, DM, (u16*)(ws + O_WBR) + 512, 0, gtid, gth, 1536);
    conv_weight(P.in[21], DM, DM, (u16*)(ws + O_WMO), 0, gtid, gth);
    conv_weight(P.in[29], DM, DM, (u16*)(ws + O_WGT), 0, gtid, gth);
    conv_weight(P.in[28], 256, DM, (u16*)(ws + O_WPT), 0, gtid, gth);
    {
        u16* dst = (u16*)(ws + O_WLT);
        for (size_t idx = gtid; idx < 1536 * 32; idx += gth) {
            const int n = (int)(idx % 1536), kc = (int)(idx / 1536), k0 = kc * 8;
            float v[8];
#pragma unroll
            for (int i = 0; i < 8; ++i) v[i] = 0.f;
            if (n < 512) { if (k0 < 64) {
#pragma unroll
                for (int i = 0; i < 8; ++i) v[i] = P.in[10][(size_t)(k0 + i) * 512 + n]; } }
            else if (n < 1024) { if (k0 >= 64 && k0 < 128) {
#pragma unroll
                for (int i = 0; i < 8; ++i) v[i] = P.in[12][(size_t)(k0 - 64 + i) * 512 + (n - 512)]; } }
            else { if (k0 >= 128) {
#pragma unroll
                for (int i = 0; i < 8; ++i) v[i] = P.in[13][(size_t)(k0 - 128 + i) * 512 + (n - 1024)]; } }
            u32x4 w; w.x = cvt_pk_bf16(v[0], v[1]); w.y = cvt_pk_bf16(v[2], v[3]); w.z = cvt_pk_bf16(v[4], v[5]); w.w = cvt_pk_bf16(v[6], v[7]);
            *(u32x4*)(dst + (size_t)n * 256 + k0) = w;
        }
    }
    {
        f32x2* cs = (f32x2*)(ws + O_CS); const int* pos = (const int*)P.in[2];
        for (size_t idx = gtid; idx < (size_t)MTOK * 64; idx += gth) {
            const int tok = (int)(idx >> 6), i = (int)(idx & 63);
            const float invf = exp2f(-(float)i * (13.287712379549449f / 64.0f));
            const float ang = (float)pos[tok] * invf;
            const double a = (double)ang; const double kq = rint(a * 0.6366197723675814); const float r = (float)(a - kq * 1.5707963267948966);
            const int q = (int)((long long)kq & 3);
            const float r2 = r * r;
            const float sn = r + r * r2 * (-1.6666667e-1f + r2 * (8.3333333e-3f + r2 * (-1.9841270e-4f + r2 * 2.7557319e-6f)));
            const float cn = 1.0f + r2 * (-0.5f + r2 * (4.1666668e-2f + r2 * (-1.3888889e-3f + r2 * (2.4801587e-5f - r2 * 2.7557319e-7f))));
            float c, s;
            if (q == 0) { c = cn; s = sn; } else if (q == 1) { c = -sn; s = cn; } else if (q == 2) { c = -cn; s = -sn; } else { c = sn; s = -cn; }
            cs[idx] = (f32x2){c, s};
        }
    }
    conv_rows(P.in[0], (u16*)(ws + O_XB), (size_t)MTOK * DM / 8, gtid, gth);
}

__device__ __forceinline__ void phase_ln(const u16* pre, const float* g, const float* b, u16* hb, float* hf, int gw, int ngw, int lane) {
    f32x4 gv[4], bv[4];
#pragma unroll
    for (int j = 0; j < 4; ++j) { gv[j] = *(const f32x4*)(g + 4 * lane + 256 * j); bv[j] = *(const f32x4*)(b + 4 * lane + 256 * j); }
    for (int row = gw; row < MTOK; row += 2 * ngw) {
        const int row2 = row + ngw;
        const u16* xr = pre + (size_t)row * DM + 4 * lane; const u16* xr2 = pre + (size_t)row2 * DM + 4 * lane;
        f32x4 v[4], v2[4]; float s = 0.f, t = 0.f;
#pragma unroll
        for (int j = 0; j < 4; ++j) { v[j] = ld_bf4(xr + 256 * j); v2[j] = ld_bf4(xr2 + 256 * j); }
#pragma unroll
        for (int j = 0; j < 4; ++j) { s += (v[j][0] + v[j][1]) + (v[j][2] + v[j][3]); t += (v2[j][0] + v2[j][1]) + (v2[j][2] + v2[j][3]); }
        const float mean = wave_sum(s) * (1.f / DM), mean2 = wave_sum(t) * (1.f / DM); float s2 = 0.f, t2 = 0.f;
#pragma unroll
        for (int j = 0; j < 4; ++j) { v[j] = v[j] - mean; s2 += (v[j][0] * v[j][0] + v[j][1] * v[j][1]) + (v[j][2] * v[j][2] + v[j][3] * v[j][3]);
                                      v2[j] = v2[j] - mean2; t2 += (v2[j][0] * v2[j][0] + v2[j][1] * v2[j][1]) + (v2[j][2] * v2[j][2] + v2[j][3] * v2[j][3]); }
        const float rstd = 1.0f / sqrtf(wave_sum(s2) * (1.f / DM) + LN_EPS), rstd2 = 1.0f / sqrtf(wave_sum(t2) * (1.f / DM) + LN_EPS);
#pragma unroll
        for (int j = 0; j < 4; ++j) {
            const f32x4 o = v[j] * rstd * gv[j] + bv[j], o2 = v2[j] * rstd2 * gv[j] + bv[j];
            u32x2 w; w.x = cvt_pk_bf16(o[0], o[1]); w.y = cvt_pk_bf16(o[2], o[3]);
            *(u32x2*)(hb + (size_t)row * DM + 4 * lane + 256 * j) = w;
            w.x = cvt_pk_bf16(o2[0], o2[1]); w.y = cvt_pk_bf16(o2[2], o2[3]);
            *(u32x2*)(hb + (size_t)row2 * DM + 4 * lane + 256 * j) = w;
            if (hf) { *(f32x4*)(hf + (size_t)row * DM + 4 * lane + 256 * j) = o; *(f32x4*)(hf + (size_t)row2 * DM + 4 * lane + 256 * j) = o2; }
        }
    }
}

__device__ __forceinline__ void phase_lora_prep(const u16* __restrict__ zr, const float* __restrict__ mu, u16* __restrict__ alora, size_t gtid, size_t gth) {
    const int c = (int)(gtid & 31) * 8;
    const f32x4 m0 = *(const f32x4*)(mu + 1536 + c), m1 = *(const f32x4*)(mu + 1536 + c + 4);
    for (size_t idx = gtid; idx < (size_t)MTOK * 32; idx += 4 * gth) {
        u32x4 z[4], zp[4];
#pragma unroll
        for (int u = 0; u < 4; ++u) {
            const int tok = (int)((idx + u * gth) >> 5);
            z[u] = *(const u32x4*)(zr + (size_t)tok * 1792 + 1536 + c);
            zp[u] = ((tok & (SEQ - 1)) != 0) ? *(const u32x4*)(zr + (size_t)(tok - 1) * 1792 + 1536 + c) : (u32x4){0u, 0u, 0u, 0u};
        }
#pragma unroll
        for (int u = 0; u < 4; ++u) {
            const int tok = (int)((idx + u * gth) >> 5);
            const f32x4 a0 = {bflo(z[u].x), bfhi(z[u].x), bflo(z[u].y), bfhi(z[u].y)}, a1 = {bflo(z[u].z), bfhi(z[u].z), bflo(z[u].w), bfhi(z[u].w)};
            const f32x4 p0 = {bflo(zp[u].x), bfhi(zp[u].x), bflo(zp[u].y), bfhi(zp[u].y)}, p1 = {bflo(zp[u].z), bfhi(zp[u].z), bflo(zp[u].w), bfhi(zp[u].w)};
            f32x4 v0 = a0 + (p0 - a0) * m0, v1 = a1 + (p1 - a1) * m1;
            if (c < 64) {
#pragma unroll
                for (int j = 0; j < 4; ++j) { v0[j] = 2.f * sigm(2.f * v0[j]) - 1.f; v1[j] = 2.f * sigm(2.f * v1[j]) - 1.f; }
            } else if (c >= 128) {
#pragma unroll
                for (int j = 0; j < 4; ++j) { v0[j] = sigm(v0[j]); v1[j] = sigm(v1[j]); }
            }
            u32x4 w; w.x = cvt_pk_bf16(v0[0], v0[1]); w.y = cvt_pk_bf16(v0[2], v0[3]); w.z = cvt_pk_bf16(v1[0], v1[1]); w.w = cvt_pk_bf16(v1[2], v1[3]);
            *(u32x4*)(alora + (size_t)tok * 256 + c) = w;
        }
    }
}
struct RwkvConst { f32x4 mur, muk, muv, kk_, ka_; };
__device__ __forceinline__ RwkvConst rwkv_const(const float* mu, const float* k_k, const float* k_a, int ch) {
    RwkvConst c; c.mur = *(const f32x4*)(mu + ch); c.muk = *(const f32x4*)(mu + 512 + ch); c.muv = *(const f32x4*)(mu + 1024 + ch); c.kk_ = *(const f32x4*)(k_k + ch); c.ka_ = *(const f32x4*)(k_a + ch); return c;
}
struct RwkvRaw { u32x2 zr_, zk_, zv_, pr_, pk_, pv_; h16x4 ah; };
__device__ __forceinline__ f32x4 bf4(const u32x2 t) { return (f32x4){bflo(t.x), bfhi(t.x), bflo(t.y), bfhi(t.y)}; }
__device__ __forceinline__ RwkvRaw rwkv_load(const u16* zr, const _Float16* abuf, int tok, int ch) {
    const bool first = (tok & (SEQ - 1)) == 0;
    const u16* zt = zr + (size_t)tok * 1792 + ch; const u16* zq = first ? zt : zt - 1792;
    RwkvRaw w; w.zr_ = *(const u32x2*)zt; w.zk_ = *(const u32x2*)(zt + 512); w.zv_ = *(const u32x2*)(zt + 1024);
    w.pr_ = *(const u32x2*)zq; w.pk_ = *(const u32x2*)(zq + 512); w.pv_ = *(const u32x2*)(zq + 1024);
    w.ah = *(const h16x4*)(abuf + (size_t)tok * 512 + ch);
    return w;
}
__device__ __forceinline__ void rwkv_compute(const RwkvRaw& w, int tok, const RwkvConst& c, f32x4& r, f32x4& kh, f32x4& v, f32x4& kk, f32x4& bb) {
    const bool first = (tok & (SEQ - 1)) == 0;
    r = bf4(w.zr_); f32x4 k = bf4(w.zk_); v = bf4(w.zv_);
    f32x4 rp = bf4(w.pr_), kp = bf4(w.pk_), vp = bf4(w.pv_);
    if (first) { rp = (f32x4){0.f, 0.f, 0.f, 0.f}; kp = rp; vp = rp; }
    r = r + (rp - r) * c.mur; k = k + (kp - k) * c.muk; v = v + (vp - v) * c.muv;
    const f32x4 a = {(float)w.ah[0], (float)w.ah[1], (float)w.ah[2], (float)w.ah[3]};
    kk = k * c.kk_;
    const float ss = red16((kk[0] * kk[0] + kk[1] * kk[1]) + (kk[2] * kk[2] + kk[3] * kk[3]));
    kk = kk * __builtin_amdgcn_rsqf(fmaxf(ss, 1e-24f));
    kh = k * (1.0f + (a - 1.0f) * c.ka_); bb = kk * a;
}
__device__ __forceinline__ void rwkv_prep(const u16* zr, const _Float16* abuf, int tok, int ch, const RwkvConst& c, f32x4& r, f32x4& kh, f32x4& v, f32x4& kk, f32x4& bb) {
    const RwkvRaw w = rwkv_load(zr, abuf, tok, ch); rwkv_compute(w, tok, c, r, kh, v, kk, bb);
}
__device__ __forceinline__ void scan_load(const u16* zr, const _Float16* wbuf, const _Float16* abuf, int tok0, int pst, int pch, int c, RwkvRaw (&raw)[2], h16x4 (&wv)[2]) {
#pragma unroll
    for (int half = 0; half < 2; ++half) {
        const int tok = tok0 + c * 32 + pst + 16 * half;
        raw[half] = rwkv_load(zr, abuf, tok, pch);
        wv[half] = *(const h16x4*)(wbuf + (size_t)tok * 512 + pch);
    }
}
__device__ __forceinline__ void scan_write(LAS _Float16* lds, const RwkvConst& rc, int tok0, int pst, int pks, int c, int bufi, const RwkvRaw (&raw)[2], const h16x4 (&wv)[2]) {
    LAS _Float16* bp = lds + bufi * (32 * 384);
#pragma unroll
    for (int half = 0; half < 2; ++half) {
        const int st = pst + 16 * half, tok = tok0 + c * 32 + st;
        f32x4 r, kh, v, kk, bb; rwkv_compute(raw[half], tok, rc, r, kh, v, kk, bb);
        LAS _Float16* sp = bp + st * 384 + 4 * pks;
        *(LAS h16x4*)(sp) = wv[half];
        *(LAS h16x4*)(sp + 64) = (h16x4){(_Float16)kk[0], (_Float16)kk[1], (_Float16)kk[2], (_Float16)kk[3]};
        *(LAS h16x4*)(sp + 128) = (h16x4){(_Float16)bb[0], (_Float16)bb[1], (_Float16)bb[2], (_Float16)bb[3]};
        *(LAS h16x4*)(sp + 192) = (h16x4){(_Float16)kh[0], (_Float16)kh[1], (_Float16)kh[2], (_Float16)kh[3]};
        *(LAS h16x4*)(sp + 256) = (h16x4){(_Float16)r[0], (_Float16)r[1], (_Float16)r[2], (_Float16)r[3]};
        *(LAS h16x4*)(sp + 320) = (h16x4){(_Float16)v[0], (_Float16)v[1], (_Float16)v[2], (_Float16)v[3]};
    }
}
__device__ __forceinline__ float fmix_lo(float a, unsigned h, float c) { float d; asm("v_fma_mix_f32 %0, %1, %2, %3 op_sel_hi:[0,1,0]" : "=v"(d) : "v"(a), "v"(h), "v"(c)); return d; }
__device__ __forceinline__ float fmix_hi(float a, unsigned h, float c) { float d; asm("v_fma_mix_f32 %0, %1, %2, %3 op_sel:[0,1,0] op_sel_hi:[0,1,0]" : "=v"(d) : "v"(a), "v"(h), "v"(c)); return d; }
__device__ __forceinline__ float fmix2_lo(unsigned a, unsigned h, float c) { float d; asm("v_fma_mix_f32 %0, %1, %2, %3 op_sel_hi:[1,1,0]" : "=v"(d) : "v"(a), "v"(h), "v"(c)); return d; }
__device__ __forceinline__ float fmix2_hi(unsigned a, unsigned h, float c) { float d; asm("v_fma_mix_f32 %0, %1, %2, %3 op_sel:[0,1,0] op_sel_hi:[1,1,0]" : "=v"(d) : "v"(a), "v"(h), "v"(c)); return d; }
__device__ __forceinline__ void scan_step_asm(float& s0, float& s1, float& s2, float& s3, float& q0, float& q1,
                                              unsigned kkx, unsigned kky, unsigned wx, unsigned wy, unsigned khx, unsigned khy, unsigned bbx, unsigned bby, unsigned rx, unsigned ry, unsigned v) {
    float p0, p1, u0, u1, u2, u3;
    asm("v_fma_mix_f32 %[p0], %[s0], %[kkx], 0 op_sel_hi:[0,1,0]\n\t"
        "v_fma_mix_f32 %[p0], %[s1], %[kkx], %[p0] op_sel:[0,1,0] op_sel_hi:[0,1,0]\n\t"
        "v_fma_mix_f32 %[p0], %[s2], %[kky], %[p0] op_sel_hi:[0,1,0]\n\t"
        "v_fma_mix_f32 %[p0], %[s3], %[kky], %[p0] op_sel:[0,1,0] op_sel_hi:[0,1,0]\n\t"
        "v_fma_mix_f32 %[u0], %[s0], %[wx], 0 op_sel_hi:[0,1,0]\n\t"
        "v_fma_mix_f32 %[u1], %[s1], %[wx], 0 op_sel:[0,1,0] op_sel_hi:[0,1,0]\n\t"
        "v_add_f32_dpp %[p0], %[p0], %[p0] quad_perm:[1,0,3,2] row_mask:0xf bank_mask:0xf bound_ctrl:1\n\t"
        "v_fma_mix_f32 %[u2], %[s2], %[wy], 0 op_sel_hi:[0,1,0]\n\t"
        "v_fma_mix_f32 %[u3], %[s3], %[wy], 0 op_sel:[0,1,0] op_sel_hi:[0,1,0]\n\t"
        "v_add_f32_dpp %[p0], %[p0], %[p0] quad_perm:[2,3,0,1] row_mask:0xf bank_mask:0xf bound_ctrl:1\n\t"
        "v_fma_mix_f32 %[u0], %[v], %[khx], %[u0] op_sel_hi:[1,1,0]\n\t"
        "v_fma_mix_f32 %[u1], %[v], %[khx], %[u1] op_sel:[0,1,0] op_sel_hi:[1,1,0]\n\t"
        "v_add_f32_dpp %[p0], %[p0], %[p0] row_half_mirror row_mask:0xf bank_mask:0xf bound_ctrl:1\n\t"
        "v_fma_mix_f32 %[u2], %[v], %[khy], %[u2] op_sel_hi:[1,1,0]\n\t"
        "v_fma_mix_f32 %[u3], %[v], %[khy], %[u3] op_sel:[0,1,0] op_sel_hi:[1,1,0]\n\t"
        "v_add_f32_dpp %[p0], %[p0], %[p0] row_mirror row_mask:0xf bank_mask:0xf bound_ctrl:1\n\t"
        "v_xor_b32 %[p1], 0x80000000, %[p0]\n\t"
        "v_fma_mix_f32 %[s0], %[p1], %[bbx], %[u0] op_sel_hi:[0,1,0]\n\t"
        "v_fma_mix_f32 %[s1], %[p1], %[bbx], %[u1] op_sel:[0,1,0] op_sel_hi:[0,1,0]\n\t"
        "v_fma_mix_f32 %[s2], %[p1], %[bby], %[u2] op_sel_hi:[0,1,0]\n\t"
        "v_fma_mix_f32 %[s3], %[p1], %[bby], %[u3] op_sel:[0,1,0] op_sel_hi:[0,1,0]\n\t"
        "v_fma_mix_f32 %[q0], %[s0], %[rx], 0 op_sel_hi:[0,1,0]\n\t"
        "v_fma_mix_f32 %[q0], %[s1], %[rx], %[q0] op_sel:[0,1,0] op_sel_hi:[0,1,0]\n\t"
        "v_fma_mix_f32 %[q0], %[s2], %[ry], %[q0] op_sel_hi:[0,1,0]\n\t"
        "v_fma_mix_f32 %[q0], %[s3], %[ry], %[q0] op_sel:[0,1,0] op_sel_hi:[0,1,0]"
        : [s0] "+v"(s0), [s1] "+v"(s1), [s2] "+v"(s2), [s3] "+v"(s3), [q0] "=&v"(q0),
          [p0] "=&v"(p0), [p1] "=&v"(p1), [u0] "=&v"(u0), [u1] "=&v"(u1), [u2] "=&v"(u2), [u3] "=&v"(u3)
        : [kkx] "v"(kkx), [kky] "v"(kky), [wx] "v"(wx), [wy] "v"(wy), [khx] "v"(khx), [khy] "v"(khy), [bbx] "v"(bbx), [bby] "v"(bby), [rx] "v"(rx), [ry] "v"(ry), [v] "v"(v));
    q1 = 0.f;
}
constexpr int TCH = 32;
constexpr int SCH = 6 * 64;
__device__ __forceinline__ void phase_scan(LAS unsigned char* ldsb, const u16* zr, const _Float16* wbuf, const _Float16* abuf, const float* mu, const float* k_k, const float* k_a,
                                           float* yraw, int tid, int bid) {
    LAS _Float16* lds = (LAS _Float16*)ldsb;
    LAS float* ypart = (LAS float*)(ldsb + 2 * TCH * SCH * 2);
    const int wid = tid >> 6, lane = tid & 63;
    const int blk = bid, xcd = blk & 7, slot = blk >> 3, bh = xcd * 8 + (slot >> 2), quarter = slot & 3;
    const int b = bh >> 3, h = bh & 7, tok0 = b * SEQ;
    const bool comp = wid < 4;
    const int rowl = quarter * 16 + (wid & 3) * 4 + (lane >> 4), ks = lane & 15;
    constexpr int NCH = SEQ / TCH;
    const int p = tid & 255, pst = p >> 4, pks = p & 15, pch = h * 64 + 4 * pks;
    RwkvConst rc = rwkv_const(mu, k_k, k_a, pch);
    RwkvRaw raw[2]; h16x4 wv[2];
    if (!comp) { scan_load(zr, wbuf, abuf, tok0, pst, pch, 0, raw, wv); scan_write(lds, rc, tok0, pst, pks, 0, 0, raw, wv); scan_load(zr, wbuf, abuf, tok0, pst, pch, 1, raw, wv); }
    __syncthreads();
    float s0 = 0.f, s1 = 0.f, s2 = 0.f, s3 = 0.f;
    LAS float* ypw = ypart + (wid & 3) * (TCH * 64);
#define SCAN_LD(W, KK, BB, KH, R, V, st) do { const LAS _Float16* sp_ = bp + (st) * SCH; W = *(const LAS u32x2*)(sp_ + 4 * ks); KK = *(const LAS u32x2*)(sp_ + 64 + 4 * ks); \
        BB = *(const LAS u32x2*)(sp_ + 128 + 4 * ks); KH = *(const LAS u32x2*)(sp_ + 192 + 4 * ks); R = *(const LAS u32x2*)(sp_ + 256 + 4 * ks); V = *(const LAS unsigned short*)(sp_ + 320 + rowl); } while (0)
#pragma nounroll
    for (int c = 0; c < NCH; ++c) {
        if (!comp) {
            if (c + 1 < NCH) scan_write(lds, rc, tok0, pst, pks, c + 1, (c + 1) & 1, raw, wv);
            if (c + 2 < NCH) scan_load(zr, wbuf, abuf, tok0, pst, pch, c + 2, raw, wv);
        }
        else {
            const LAS _Float16* bp = lds + (c & 1) * (TCH * SCH);
            u32x2 w, kk, bb, kh, r; unsigned v;
            SCAN_LD(w, kk, bb, kh, r, v, 0);
#pragma unroll
            for (int st = 0; st < TCH; ++st) {
                u32x2 nw, nkk, nbb, nkh, nr; unsigned nv;
                if (st + 1 < TCH) SCAN_LD(nw, nkk, nbb, nkh, nr, nv, st + 1);
                float q0, q1;
                scan_step_asm(s0, s1, s2, s3, q0, q1, kk.x, kk.y, w.x, w.y, kh.x, kh.y, bb.x, bb.y, r.x, r.y, v);
                ypw[st * 64 + lane] = q0;
                if (st + 1 < TCH) { w = nw; kk = nkk; bb = nbb; kh = nkh; r = nr; v = nv; }
            }
#pragma unroll
            for (int i = 0; i < 2; ++i) {
                const int pp = lane + 64 * i, st = pp >> 2, rw = pp & 3;
                const LAS f32x4* q = (const LAS f32x4*)(ypw + st * 64 + rw * 16);
                const f32x4 a0 = q[0], a1 = q[1], a2 = q[2], a3 = q[3];
                const f32x4 sm = (a0 + a1) + (a2 + a3);
                yraw[(size_t)(tok0 + c * TCH + st) * 512 + h * 64 + quarter * 16 + (wid & 3) * 4 + rw] = (sm[0] + sm[1]) + (sm[2] + sm[3]);
            }
        }
        asm volatile("s_waitcnt lgkmcnt(0)" ::: "memory"); __builtin_amdgcn_s_barrier(); asm volatile("" ::: "memory");
    }
#undef SCAN_LD
}
__device__ __forceinline__ void phase_rwkv_out(const float* __restrict__ yraw, const u16* __restrict__ zr, const _Float16* __restrict__ abuf, const _Float16* __restrict__ gbuf,
                                               const float* __restrict__ mu, const float* __restrict__ k_k, const float* __restrict__ k_a, const float* __restrict__ r_k,
                                               const float* __restrict__ gn_g, const float* __restrict__ gn_b, u16* __restrict__ yout, size_t gtid, size_t gth) {
    const int hk = (int)(gtid & 127), head = hk >> 4, ks = hk & 15, ch = head * 64 + ks * 4;
    const RwkvConst rc = rwkv_const(mu, k_k, k_a, ch);
    const f32x4 rk = *(const f32x4*)(r_k + ch), gg = *(const f32x4*)(gn_g + ch), gb = *(const f32x4*)(gn_b + ch);
#pragma unroll 2
    for (size_t idx = gtid; idx < (size_t)MTOK * 128; idx += gth) {
        const int tok = (int)(idx >> 7);
        const f32x4 y = *(const f32x4*)(yraw + (size_t)tok * 512 + ch);
        const h16x4 gh = *(const h16x4*)(gbuf + (size_t)tok * 512 + ch);
        f32x4 r, kh, v, kk, bb; rwkv_prep(zr, abuf, tok, ch, rc, r, kh, v, kk, bb);
        const float mean = red16((y[0] + y[1]) + (y[2] + y[3])) * (1.f / 64.f);
        const f32x4 d = y - mean;
        const float var = red16((d[0] * d[0] + d[1] * d[1]) + (d[2] * d[2] + d[3] * d[3])) * (1.f / 64.f);
        const float rstd = 1.0f / sqrtf(var + 64e-5f);
        const float bs = red16((r[0] * kh[0] * rk[0] + r[1] * kh[1] * rk[1]) + (r[2] * kh[2] * rk[2] + r[3] * kh[3] * rk[3]));
        float o[4];
#pragma unroll
        for (int j = 0; j < 4; ++j) o[j] = (d[j] * rstd * gg[j] + gb[j] + bs * v[j]) * (float)gh[j];
        u32x2 w; w.x = cvt_pk_bf16(o[0], o[1]); w.y = cvt_pk_bf16(o[2], o[3]);
        *(u32x2*)(yout + (size_t)tok * 1536 + ch) = w;
    }
}

__device__ __forceinline__ bf16x8 ldfrag(const u16* p) { return *(const bf16x8*)p; }
__device__ __forceinline__ void r1_issue(LAS unsigned char* lds, int it, int bid, int wid, int fr, int fq, const u16* ktz) {
    const int itc = it > 7 ? 7 : it, item = itc * 256 + bid;
    const u16* src = ktz + (size_t)item * 16384 + (size_t)(16 * wid + fr) * 128 + 8 * fq;
    LAS unsigned char* dst = lds + (it % 3) * 32768 + wid * 4096;
#pragma unroll
    for (int k = 0; k < 4; ++k) __builtin_amdgcn_global_load_lds((const unsigned*)(src + 32 * k), (LAS unsigned*)(dst + k * 1024), 16, 0, 0);
}
__device__ __forceinline__ void phase_r1(LAS unsigned char* lds, const u16* vt, const u16* ktz, u16* ut, int wid_, int lane, int bid) {
    const int wid = __builtin_amdgcn_readfirstlane(wid_), fr = lane & 15, fq = lane >> 4;
    r1_issue(lds, 0, bid, wid, fr, fq, ktz); r1_issue(lds, 1, bid, wid, fr, fq, ktz); r1_issue(lds, 2, bid, wid, fr, fq, ktz);
    bf16x8 xf[2][4];
    {
        const u16* V = vt + (size_t)bid * 32768 + (size_t)(wid * 32) * 128;
#pragma unroll
        for (int i = 0; i < 2; ++i)
#pragma unroll
            for (int k = 0; k < 4; ++k) xf[i][k] = ldfrag(V + (size_t)(16 * i + fr) * 128 + 32 * k + 8 * fq);
    }
#pragma unroll 1
    for (int it = 0; it < 8; ++it) {
        const int item = it * 256 + bid;
        asm volatile("s_waitcnt vmcnt(8)" ::: "memory");
        asm volatile("s_waitcnt lgkmcnt(0)" ::: "memory"); __builtin_amdgcn_s_barrier(); asm volatile("" ::: "memory");
        const LAS unsigned char* kb = lds + (it % 3) * 32768 + lane * 16;
        f32x4 acc[2][8];
#pragma unroll
        for (int i = 0; i < 2; ++i)
#pragma unroll
            for (int j = 0; j < 8; ++j) acc[i][j] = (f32x4){0.f, 0.f, 0.f, 0.f};
#pragma unroll
        for (int k = 0; k < 4; ++k)
#pragma unroll
            for (int j = 0; j < 8; ++j) {
                const bf16x8 yf = *(const LAS bf16x8*)(kb + (j * 4 + k) * 1024);
#pragma unroll
                for (int i = 0; i < 2; ++i) acc[i][j] = __builtin_amdgcn_mfma_f32_16x16x32_bf16(yf, xf[i][k], acc[i][j], 0, 0, 0);
            }
        u16* U = ut + (size_t)item * 256 * 128 + (size_t)(wid * 32) * 128;
#pragma unroll
        for (int i = 0; i < 2; ++i)
#pragma unroll
            for (int j = 0; j < 8; ++j) { u32x2 w; w.x = cvt_pk_bf16(acc[i][j][0], acc[i][j][1]); w.y = cvt_pk_bf16(acc[i][j][2], acc[i][j][3]);
                *(u32x2*)(U + (size_t)(16 * i + fr) * 128 + 16 * j + 4 * fq) = w; }
        {
            const int itn = it < 7 ? it + 1 : 7;
            const u16* V = vt + (size_t)(itn * 256 + bid) * 32768 + (size_t)(wid * 32) * 128;
#pragma unroll
            for (int i = 0; i < 2; ++i)
#pragma unroll
                for (int k = 0; k < 4; ++k) xf[i][k] = ldfrag(V + (size_t)(16 * i + fr) * 128 + 32 * k + 8 * fq);
        }
        asm volatile("s_waitcnt lgkmcnt(0)" ::: "memory"); __builtin_amdgcn_s_barrier(); asm volatile("" ::: "memory");
        r1_issue(lds, it + 3, bid, wid, fr, fq, ktz);
    }
    asm volatile("s_waitcnt vmcnt(0)" ::: "memory");
    asm volatile("s_waitcnt lgkmcnt(0)" ::: "memory"); __builtin_amdgcn_s_barrier(); asm volatile("" ::: "memory");
}
__device__ __forceinline__ void phase_r2(u16* rt, size_t gtid, size_t gth) {
    for (size_t idx = gtid; idx < (size_t)32 * 8192; idx += gth) {
        const int bh = (int)(idx >> 13), off = (int)(idx & 8191) * 4, head = bh & 3;
        const float cd = __builtin_amdgcn_exp2f(128.f * __log2f(1.0f - __builtin_amdgcn_exp2f((float)(-5 - head))));
        f32x4 R = {0.f, 0.f, 0.f, 0.f};
        u16* rp = rt + (size_t)bh * 64 * 32768 + off;
#pragma unroll 8
        for (int c = 0; c < 64; ++c) {
            const f32x4 uv = ld_bf4(rp + (size_t)c * 32768);
            u32x2 w; w.x = cvt_pk_bf16(R[0], R[1]); w.y = cvt_pk_bf16(R[2], R[3]);
            *(u32x2*)(rp + (size_t)c * 32768) = w;
            R = R * cd + uv;
        }
    }
}
#define R3_WAITV(n) asm volatile("s_waitcnt vmcnt(" #n ")" ::: "memory")
#define R3_BAR() do { asm volatile("s_waitcnt lgkmcnt(0)" ::: "memory"); __builtin_amdgcn_s_barrier(); asm volatile("" ::: "memory"); } while (0)
__device__ __forceinline__ void r3_issue(LAS unsigned char* lds, int g, int bid, int wid, int fr, int fq, const u16* krot, const u16* rt, const u16* vt) {
    int it = g / 5; const int st = g - it * 5; it = it > 7 ? 7 : it;
    const int item = it * 256 + bid, bh = item >> 6, chunk = item & 63, b = bh >> 2, head = bh & 3, tok0 = b * SEQ + chunk * 128;
    const u16* src;
    if (st == 0) src = krot + (size_t)(tok0 + 16 * wid + fr) * 512 + head * 128 + 8 * fq;
    else src = (wid < 4 ? rt : vt) + (size_t)item * 32768 + (size_t)(16 * (4 * (st - 1) + (wid & 3)) + fr) * 128 + 8 * fq;
    LAS unsigned char* dst = lds + (g % 3) * 32768 + wid * 4096;
#pragma unroll
    for (int k = 0; k < 4; ++k) __builtin_amdgcn_global_load_lds((const unsigned*)(src + 32 * k), (LAS unsigned*)(dst + k * 1024), 16, 0, 0);
}
__device__ __forceinline__ void phase_r3(LAS unsigned char* lds, const u16* qrot, const u16* krot, const u16* vt, const u16* rt, const u16* gsilu, u16* yret, int wid_, int lane, int bid) {
    const int wid = __builtin_amdgcn_readfirstlane(wid_), fr = lane & 15, fq = lane >> 4;
    LAS unsigned char* Pw = lds + 98304 + (16 * wid + fr) * 256;
    const int nK = (wid >> 1) + 1;
    const int n = 16 * wid + fr;
    r3_issue(lds, 0, bid, wid, fr, fq, krot, rt, vt); r3_issue(lds, 1, bid, wid, fr, fq, krot, rt, vt); r3_issue(lds, 2, bid, wid, fr, fq, krot, rt, vt);
#pragma unroll 1
    for (int it = 0; it < 8; ++it) {
        const int item = it * 256 + bid, bh = item >> 6, chunk = item & 63, b = bh >> 2, head = bh & 3, tok0 = b * SEQ + chunk * 128, g0 = it * 5;
        const float l2g = __log2f(1.0f - __builtin_amdgcn_exp2f((float)(-5 - head)));
        bf16x8 qf[4];
#pragma unroll
        for (int k = 0; k < 4; ++k) qf[k] = ldfrag(qrot + (size_t)(tok0 + n) * 512 + head * 128 + 32 * k + 8 * fq);
        R3_WAITV(8); R3_BAR();
        {
            const LAS unsigned char* kb = lds + (g0 % 3) * 32768 + lane * 16;
            for (int j = 0; j < 2 * nK; ++j) {
                f32x4 sc = {0.f, 0.f, 0.f, 0.f};
#pragma unroll
                for (int k = 0; k < 4; ++k) { const bf16x8 kf = *(const LAS bf16x8*)(kb + (j * 4 + k) * 1024); sc = __builtin_amdgcn_mfma_f32_16x16x32_bf16(kf, qf[k], sc, 0, 0, 0); }
                float pv[4];
#pragma unroll
                for (int r = 0; r < 4; ++r) { const int m = 16 * j + 4 * fq + r; pv[r] = (m <= n) ? sc[r] * __builtin_amdgcn_exp2f(l2g * (float)(n - m)) : 0.f; }
                u32x2 w; w.x = cvt_pk_bf16(pv[0], pv[1]); w.y = cvt_pk_bf16(pv[2], pv[3]);
                *(LAS u32x2*)(Pw + (16 * j + 4 * fq) * 2) = w;
            }
        }
        R3_BAR(); r3_issue(lds, g0 + 3, bid, wid, fr, fq, krot, rt, vt);
        f32x4 acc[16];
        const float xi = __builtin_amdgcn_exp2f(l2g * (float)(n + 1));
#pragma unroll
        for (int q = 0; q < 4; ++q) {
            R3_WAITV(8); R3_BAR();
            const LAS unsigned char* sb = lds + ((g0 + 1 + q) % 3) * 32768 + lane * 16;
#pragma unroll
            for (int jj = 0; jj < 4; ++jj) {
                f32x4 a = {0.f, 0.f, 0.f, 0.f};
#pragma unroll
                for (int k = 0; k < 4; ++k) { const bf16x8 rf = *(const LAS bf16x8*)(sb + (jj * 4 + k) * 1024); a = __builtin_amdgcn_mfma_f32_16x16x32_bf16(rf, qf[k], a, 0, 0, 0); }
                acc[4 * q + jj] = a * xi;
            }
            for (int k = 0; k < nK; ++k) {
                const bf16x8 pf = *(const LAS bf16x8*)(Pw + (32 * k + 8 * fq) * 2);
#pragma unroll
                for (int jj = 0; jj < 4; ++jj) { const bf16x8 vf = *(const LAS bf16x8*)(sb + (16 + jj * 4 + k) * 1024); acc[4 * q + jj] = __builtin_amdgcn_mfma_f32_16x16x32_bf16(vf, pf, acc[4 * q + jj], 0, 0, 0); }
            }
            R3_BAR(); r3_issue(lds, g0 + 4 + q, bid, wid, fr, fq, krot, rt, vt);
        }
        float s1 = 0.f;
#pragma unroll
        for (int j = 0; j < 16; ++j) s1 += (acc[j][0] + acc[j][1]) + (acc[j][2] + acc[j][3]);
        s1 += __shfl_xor(s1, 16); s1 += __shfl_xor(s1, 32);
        const float mean = s1 * (1.f / 256.f);
        float s2 = 0.f;
#pragma unroll
        for (int j = 0; j < 16; ++j) { acc[j] = acc[j] - mean; s2 += (acc[j][0] * acc[j][0] + acc[j][1] * acc[j][1]) + (acc[j][2] * acc[j][2] + acc[j][3] * acc[j][3]); }
        s2 += __shfl_xor(s2, 16); s2 += __shfl_xor(s2, 32);
        const float rstd = 1.0f / sqrtf(s2 * (1.f / 256.f) + LN_EPS);
        const u16* gp = gsilu + (size_t)(tok0 + n) * 1024 + head * 256 + 4 * fq;
        u16* op = yret + (size_t)(tok0 + n) * 1536 + head * 256 + 4 * fq;
#pragma unroll
        for (int j = 0; j < 16; ++j) {
            const f32x4 gv = ld_bf4(gp + 16 * j);
            const f32x4 o = acc[j] * rstd * gv;
            u32x2 w; w.x = cvt_pk_bf16(o[0], o[1]); w.y = cvt_pk_bf16(o[2], o[3]);
            *(u32x2*)(op + 16 * j) = w;
        }
    }
    R3_WAITV(0); R3_BAR();
}

#define XB_TMO      128
#define XB_XCNT(j)  (256  + 64 * (j))
#define XB_XSUB(j)  (1280 + 64 * (j))
#define XB_XGEN(j)  (2304 + 64 * (j))
#define XB_TOP      3328
#define XB_TOPGEN   3392
#define XCD_BAR_WORDS 3456
#define XB_SPIN_CAP (1u << 22)
__device__ __forceinline__ unsigned xb_ld(unsigned* p)              { return __hip_atomic_load(p, __ATOMIC_RELAXED, __HIP_MEMORY_SCOPE_AGENT); }
__device__ __forceinline__ unsigned xb_add(unsigned* p, unsigned v) { return __hip_atomic_fetch_add(p, v, __ATOMIC_RELAXED, __HIP_MEMORY_SCOPE_AGENT); }
__device__ __forceinline__ unsigned xb_xcc_id() { return (unsigned)__builtin_amdgcn_s_getreg((3 << 11) | 20) & 0xFu; }
#define XB_SPIN(cond, bar) do { unsigned _sp = 0; while (cond) { __builtin_amdgcn_s_sleep(1); \
    if ((++_sp & 255u) == 0u) { if (xb_ld(&(bar)[XB_TMO])) break; if (_sp > XB_SPIN_CAP) { atomicAdd(&(bar)[XB_TMO], 1u); break; } } } } while (0)
struct XcdBarrier { unsigned* bar; unsigned x; volatile LAS unsigned* st; };
__device__ __forceinline__ XcdBarrier xcd_barrier_post(unsigned* bar, volatile LAS unsigned* st) {
    XcdBarrier b; b.bar = bar; b.x = xb_xcc_id(); b.st = st;
    if (threadIdx.x == 0) (void)xb_add(&bar[XB_XCNT(b.x)], 1u);
    return b;
}
__device__ __forceinline__ void xcd_barrier_complete(unsigned* bar, unsigned x, unsigned& nloc, unsigned& nx) {
    const unsigned G = gridDim.x * gridDim.y * gridDim.z;
    unsigned sum, cnt, mine, sp = 0u;
    for (;;) {
        sum = 0u; cnt = 0u; mine = 0u;
#pragma unroll
        for (unsigned j = 0; j < 16; ++j) { const unsigned c = xb_ld(&bar[XB_XCNT(j)]); sum += c; cnt += (c > 0u) ? 1u : 0u; mine = (j == x) ? c : mine; }
        if (sum == G) break;
        __builtin_amdgcn_s_sleep(1);
        if ((++sp & 255u) == 0u) { if (xb_ld(&bar[XB_TMO])) break; if (sp > XB_SPIN_CAP) { atomicAdd(&bar[XB_TMO], 1u); break; } }
    }
    nloc = mine > 0u ? mine : 1u; nx = cnt > 0u ? cnt : 1u;
}
__device__ __forceinline__ void xcd_barrier(const XcdBarrier& b) {
    asm volatile("s_waitcnt vmcnt(0)" ::: "memory");
    __syncthreads();
    if (threadIdx.x == 0) {
        unsigned* bar = b.bar;
        __builtin_amdgcn_s_waitcnt(0);
        unsigned nloc = b.st[0], nx = b.st[1];
        if (nloc == 0u) { xcd_barrier_complete(bar, b.x, nloc, nx); b.st[0] = nloc; b.st[1] = nx; }
        const unsigned old = xb_add(&bar[XB_XSUB(b.x)], 1u);
        const unsigned gen = old / nloc;
        if (old + 1u == (gen + 1u) * nloc) {
            __builtin_amdgcn_fence(__ATOMIC_RELEASE, "agent");
            asm volatile("s_waitcnt vmcnt(0)" ::: "memory");
            const unsigned og = xb_add(&bar[XB_TOP], 1u);
            const unsigned tg = og / nx;
            if (og + 1u == (tg + 1u) * nx) xb_add(&bar[XB_TOPGEN], 1u);
            else XB_SPIN(xb_ld(&bar[XB_TOPGEN]) == tg, bar);
            __builtin_amdgcn_fence(__ATOMIC_ACQUIRE, "agent");
            xb_add(&bar[XB_XGEN(b.x)], 1u);
            asm volatile("s_waitcnt vmcnt(0)" ::: "memory");
        } else {
            XB_SPIN(xb_ld(&bar[XB_XGEN(b.x)]) == gen, bar);
            __builtin_amdgcn_fence(__ATOMIC_ACQUIRE, "agent");
            asm volatile("s_waitcnt vmcnt(0)" ::: "memory");
        }
    }
    __syncthreads();
}

#ifndef PHMASK
#define PHMASK 0xFFFFFF
#endif
#define PH_ON(p) ((PHMASK >> (p)) & 1)
#ifndef REPMASK
#define REPMASK 0
#endif
#define PH_BEGIN(p) _Pragma("nounroll") for (int rep_ = 0; rep_ < (int)PH_ON(p) * (1 + (int)((REPMASK >> (p)) & 1)); ++rep_) { int tid = threadIdx.x; asm volatile("" : "+v"(tid)); int bid = blockIdx.x; asm volatile("" : "+s"(bid)); \
        size_t zoff_ = 0; asm volatile("" : "+s"(zoff_)); unsigned char* ws = P.ws + zoff_; float* dout = (float*)((unsigned char*)P.out + zoff_);     \
        const int wid = tid >> 6, lane = tid & 63; const size_t gtid = (size_t)bid * 512 + tid, gth = (size_t)gridDim.x * 512; const int gw = bid * 8 + wid, ngw = gridDim.x * 8; \
        (void)wid; (void)lane; (void)gtid; (void)gth; (void)gw; (void)ngw; (void)ws; (void)dout;
#define PH_END xcd_barrier(xb); }

__device__ __forceinline__ void run_ffn_in(LAS unsigned char* lds, const u16* A, const u16* Wt, u16* hid, int bid) {
    pg8::Gemm g{A, Wt, DM, DM, DM}; pg8::StaticOrder S; S.init(MTOK, 2 * FF, gridDim.x, bid);
    EpiFfnIn E{hid}; pg8::gemm_phase(lds, g, S, E);
}
__device__ __forceinline__ void run_res(LAS unsigned char* lds, const u16* A, const u16* Wt, int K, u16* pre, const float* resf, const u16* resb, float scale, int bid, int rev = 0) {
    pg8::Gemm g{A, Wt, K, K, K}; pg8::StaticOrder S; S.init(MTOK, DM, gridDim.x, bid, rev);
    EpiRes E{pre, resf, resb, DN_ALPHA, scale}; pg8::gemm_phase(lds, g, S, E);
}
__device__ __forceinline__ void run_mix(LAS unsigned char* lds, unsigned char* ws, float* dout, int pn0, int npn, int bid) {
    pg8::Gemm g{(const u16*)(ws + O_H), (const u16*)(ws + O_WMT) + (size_t)pn0 * 256 * DM, DM, DM, DM};
    pg8::StaticOrder S; S.init(MTOK, npn * 256, gridDim.x, bid);
    EpiMix E{pn0, (u16*)dout, (u16*)(ws + O_QROT), (u16*)(ws + O_KROT), (u16*)(ws + O_KTZ), (u16*)(ws + O_VT), (u16*)(ws + O_GSILU), (u16*)dout, (const f32x2*)(ws + O_CS)};
    pg8::gemm_phase(lds, g, S, E);
}
__device__ __forceinline__ void run_fin(LAS unsigned char* lds, const u16* A, const u16* Wt, int K, int mode, float* out, u16* pproj, int bid) {
    pg8::Gemm g{A, Wt, K, K, K}; pg8::StaticOrder S; S.init(MTOK, DM, gridDim.x, bid);
    EpiFin E{mode, out, pproj}; pg8::gemm_phase(lds, g, S, E);
}

__global__ void __launch_bounds__(512, 2) mega(Params P) {
    extern __shared__ __attribute__((aligned(16))) unsigned char smem[];
    LAS unsigned char* lds = (LAS unsigned char*)smem;
    cg::grid_group grid = cg::this_grid();
    volatile LAS unsigned* xst = (volatile LAS unsigned*)(lds + pg8::STAGE_BYTES);
    if (threadIdx.x == 0) { xst[0] = 0u; xst[1] = 0u; }
    __syncthreads();
    const XcdBarrier xb = xcd_barrier_post((unsigned*)(P.ws + O_BAR), xst);
    if (P.ws == nullptr) grid.sync();

    PH_BEGIN(0) phase_convert(P, gtid, gth); PH_END
    PH_BEGIN(1) run_ffn_in(lds, (const u16*)(ws + O_XB), (const u16*)(ws + O_W1T), (u16*)(ws + O_HID), bid); PH_END
    PH_BEGIN(2) run_res(lds, (const u16*)(ws + O_HID), (const u16*)(ws + O_W2T), FF, (u16*)(ws + O_PRE), P.in[0], nullptr, 0.5f, bid, 1); PH_END
    PH_BEGIN(3) phase_ln((const u16*)(ws + O_PRE), P.in[3], P.in[4], (u16*)(ws + O_H), nullptr, gw, ngw, lane); PH_END
    PH_BEGIN(4) run_mix(lds, ws, dout, 0, 7, bid); PH_END
    PH_BEGIN(5) phase_lora_prep((const u16*)dout, P.in[8], (u16*)(ws + O_ALORA), gtid, gth); PH_END
    PH_BEGIN(6) {
        pg8::Gemm g{(const u16*)(ws + O_ALORA), (const u16*)(ws + O_WLT), 256, 256, 256};
        pg8::StaticOrder S; S.init(MTOK, 1536, gridDim.x, bid);
        EpiLora E{(_Float16*)(ws + O_WBUF), (_Float16*)(ws + O_ABUF), (_Float16*)(ws + O_GBUF), P.in[9], P.in[11]};
        pg8::gemm_phase(lds, g, S, E);
    } PH_END
    PH_BEGIN(8) phase_scan(lds, (const u16*)dout, (const _Float16*)(ws + O_WBUF), (const _Float16*)(ws + O_ABUF), P.in[8], P.in[14], P.in[15], (float*)(ws + O_YRAW), tid, bid); PH_END
    PH_BEGIN(9) phase_rwkv_out((const float*)(ws + O_YRAW), (const u16*)dout, (const _Float16*)(ws + O_ABUF), (const _Float16*)(ws + O_GBUF), P.in[8], P.in[14], P.in[15], P.in[16], P.in[17], P.in[18], (u16*)(ws + O_Y), gtid, gth); PH_END
    PH_BEGIN(10) run_mix(lds, ws, dout, 7, 20, bid); PH_END
    PH_BEGIN(11) phase_r1(lds, (const u16*)(ws + O_VT), (const u16*)(ws + O_KTZ), (u16*)(ws + O_RT), wid, lane, bid); PH_END
    PH_BEGIN(12) phase_r2((u16*)(ws + O_RT), gtid, gth); PH_END
    PH_BEGIN(13) phase_r3(lds, (const u16*)(ws + O_QROT), (const u16*)(ws + O_KROT), (const u16*)(ws + O_VT), (const u16*)(ws + O_RT), (const u16*)(ws + O_GSILU), (u16*)(ws + O_Y) + 512, wid, lane, bid); PH_END
    PH_BEGIN(15) {
        pg8::Gemm g{(const u16*)(ws + O_Y), (const u16*)(ws + O_WBR), 1536, 1536, 1536};
        pg8::StaticOrder S; S.init(MTOK, DM, gridDim.x, bid);
        EpiBr E{(const u16*)dout, (u16*)(ws + O_MERGED)};
        pg8::gemm_phase<EpiBr, true>(lds, g, S, E, 512);
    } PH_END
    PH_BEGIN(17) run_res(lds, (const u16*)(ws + O_MERGED), (const u16*)(ws + O_WMO), DM, (u16*)(ws + O_PRE), nullptr, (const u16*)(ws + O_H), 1.0f, bid); PH_END
    PH_BEGIN(18) phase_ln((const u16*)(ws + O_PRE), P.in[22], P.in[23], (u16*)(ws + O_H), nullptr, gw, ngw, lane); PH_END
    PH_BEGIN(19) run_ffn_in(lds, (const u16*)(ws + O_H), (const u16*)(ws + O_W3T), (u16*)(ws + O_HID), bid); PH_END
    PH_BEGIN(20) run_res(lds, (const u16*)(ws + O_HID), (const u16*)(ws + O_W4T), FF, (u16*)(ws + O_PRE), nullptr, (const u16*)(ws + O_H), 0.5f, bid, 1); PH_END
    PH_BEGIN(21) phase_ln((const u16*)(ws + O_PRE), P.in[26], P.in[27], (u16*)(ws + O_H), dout, gw, ngw, lane);
        run_fin(lds, (const u16*)(ws + O_PB), (const u16*)(ws + O_WPT), 256, 0, dout, (u16*)(ws + O_PPROJ), bid); PH_END
    PH_BEGIN(23) run_fin(lds, (const u16*)(ws + O_H), (const u16*)(ws + O_WGT), DM, 1, dout, (u16*)(ws + O_PPROJ), bid); PH_END
}

constexpr int LDS_BYTES = pg8::STAGE_BYTES + 16;

extern "C" void kernel_launch(void* const* d_in, const int* in_sizes, int n_in, void* d_out, int out_size, void* d_ws, size_t ws_size, hipStream_t stream) {
    static int grid = 0;
    if (grid == 0) {
        if (n_in != 30 || out_size != MTOK * DM || ws_size < WS_NEED) { fprintf(stderr, "kernel_launch: unexpected shapes (n_in %d out %d ws %zu)\n", n_in, out_size, ws_size); grid = -1; return; }
        int dev = 0, cus = 0, per_cu = 0;
        (void)hipGetDevice(&dev); (void)hipDeviceGetAttribute(&cus, hipDeviceAttributeMultiprocessorCount, dev);
        if (hipFuncSetAttribute((const void*)mega, hipFuncAttributeMaxDynamicSharedMemorySize, LDS_BYTES) != hipSuccess) { fprintf(stderr, "kernel_launch: hipFuncSetAttribute failed\n"); grid = -1; return; }
        (void)hipOccupancyMaxActiveBlocksPerMultiprocessor(&per_cu, (const void*)mega, 512, LDS_BYTES);
        (void)hipGetLastError();
        if (cus != 256 || per_cu < 1) { fprintf(stderr, "kernel_launch: needs 256 CUs with one resident workgroup each (cus %d per_cu %d)\n", cus, per_cu); grid = -1; return; }
        grid = 256;
    }
    if (grid < 0) return;
    if (hipMemsetAsync((char*)d_ws + O_BAR, 0, XCD_BAR_WORDS * 4, stream) != hipSuccess) { fprintf(stderr, "kernel_launch: memset of barrier words failed\n"); return; }
    Params p{};
    for (int i = 0; i < 30; ++i) p.in[i] = (const float*)d_in[i];
    p.out = (float*)d_out; p.ws = (unsigned char*)d_ws;
    void* args[] = {&p};
    hipError_t e = hipLaunchCooperativeKernel((const void*)mega, dim3(grid), dim3(512), args, LDS_BYTES, stream);
    if (e != hipSuccess) fprintf(stderr, "cooperative launch failed: %s\n", hipGetErrorString(e));
}
```

```cpp
#include <hip/hip_runtime.h>
#include <hip/hip_cooperative_groups.h>
#include <cstdio>
namespace cg = cooperative_groups;

#define LAS __attribute__((address_space(3)))
typedef unsigned short u16;
typedef short bf16x8 __attribute__((ext_vector_type(8)));
typedef float f32x4 __attribute__((ext_vector_type(4)));
typedef float f32x2 __attribute__((ext_vector_type(2)));
typedef unsigned u32x4 __attribute__((ext_vector_type(4)));
typedef unsigned u32x2 __attribute__((ext_vector_type(2)));
typedef _Float16 h16x4 __attribute__((ext_vector_type(4)));
typedef _Float16 h16x8 __attribute__((ext_vector_type(8)));

constexpr int MTOK = 65536, DM = 1024, FF = 2816, SEQ = 8192, MIXN = 6912;
constexpr float DN_ALPHA = 1.189207115f;
constexpr float LN_EPS = 1e-5f;
constexpr float DECAY_SCALE = 0.60653066f;

constexpr size_t MiB = 1ull << 20;
constexpr size_t O_W1T = 0;
constexpr size_t O_W2T = O_W1T + 5632ull * 1024 * 2;
constexpr size_t O_WMT = O_W2T + 1024ull * 2816 * 2;
constexpr size_t O_W3T = O_WMT + 6912ull * 1024 * 2;
constexpr size_t O_W4T = O_W3T + 5632ull * 1024 * 2;
constexpr size_t O_WLT = O_W4T + 1024ull * 2816 * 2;
constexpr size_t O_WBR = O_WLT + 1536ull * 256 * 2;
constexpr size_t O_WBT = O_WBR + 1024ull * 512 * 2;
constexpr size_t O_WMO = O_WBT + 1024ull * 1024 * 2;
constexpr size_t O_WGT = O_WMO + 1024ull * 1024 * 2;
constexpr size_t O_WPT = O_WGT + 1024ull * 1024 * 2;
static_assert(O_WPT + 1024ull * 256 * 2 <= 64 * MiB, "weights");
constexpr size_t O_BAR = 60 * MiB;
constexpr size_t O_CS = 64 * MiB;
constexpr size_t O_PB = 96 * MiB;
constexpr size_t O_H = 128 * MiB;
constexpr size_t O_XB = 256 * MiB;
constexpr size_t O_HID = 384 * MiB;
constexpr size_t O_ALORA = 256 * MiB;
constexpr size_t O_WBUF = 608 * MiB;
constexpr size_t O_ABUF = 672 * MiB;
constexpr size_t O_GBUF = 736 * MiB;
constexpr size_t O_YRAW = 288 * MiB;
constexpr size_t O_Y = 832 * MiB;
constexpr size_t O_QROT = 256 * MiB;
constexpr size_t O_KROT = 320 * MiB;
constexpr size_t O_KTZ = 384 * MiB;
constexpr size_t O_VT = 448 * MiB;
constexpr size_t O_GSILU = 576 * MiB;
constexpr size_t O_RT = 704 * MiB;
constexpr size_t O_TMP = 256 * MiB;
constexpr size_t O_MERGED = 512 * MiB;
constexpr size_t O_PPROJ = 384 * MiB;
constexpr size_t O_PRE = 256 * MiB;
constexpr size_t WS_NEED = 1024 * MiB;
static_assert(O_ABUF == O_WBUF + 64 * MiB && O_GBUF == O_ABUF + 64 * MiB, "EpiLora addresses W/A/G by stride");

struct Params { const float* in[30]; float* out; unsigned char* ws; };

__device__ __forceinline__ float bf2f(u16 v) { return __uint_as_float((unsigned)v << 16); }
__device__ __forceinline__ float bflo(unsigned v) { return __uint_as_float(v << 16); }
__device__ __forceinline__ float bfhi(unsigned v) { return __uint_as_float(v & 0xffff0000u); }
__device__ __forceinline__ f32x4 ld_bf4(const u16* p) { const u32x2 t = *(const u32x2*)p; return (f32x4){bflo(t.x), bfhi(t.x), bflo(t.y), bfhi(t.y)}; }
__device__ __forceinline__ unsigned cvt_pk_bf16(float lo, float hi) { unsigned r; asm volatile("v_cvt_pk_bf16_f32 %0, %1, %2" : "=v"(r) : "v"(lo), "v"(hi)); return r; }
__device__ __forceinline__ float sigm(float x) { return __builtin_amdgcn_rcpf(1.f + __builtin_amdgcn_exp2f(-1.44269504f * x)); }
__device__ __forceinline__ float siluf(float x) { return x * sigm(x); }
#define DPP_ADD(x, ctrl) ((x) + __builtin_bit_cast(float, __builtin_amdgcn_update_dpp(0, __builtin_bit_cast(int, (x)), (ctrl), 0xF, 0xF, true)))
__device__ __forceinline__ float red16(float x) {
    x = DPP_ADD(x, 0xB1); x = DPP_ADD(x, 0x4E); x = DPP_ADD(x, 0x141); x = DPP_ADD(x, 0x140); return x;
}
__device__ __forceinline__ float wave_sum(float v) {
#pragma unroll
    for (int o = 1; o < 64; o <<= 1) v += __shfl_xor(v, o);
    return v;
}

namespace pg8 {
constexpr int BM = 256, BK = 64, HALF = 128, HTB = HALF * BK * 2, STAGE_BYTES = 8 * HTB, NXCD = 8, WGM = 8;
__device__ __forceinline__ int lds_byte(int r, int c) { const int st = (r >> 4) * 2 + (c >> 5), rr = r & 15, cc = c & 31, ob = rr * 64 + cc * 2; return st * 1024 + (ob ^ (((ob >> 9) & 1) << 5)); }
__device__ __forceinline__ void stage_rc(int b, int& R, int& C) { const int st = b / 1024, sb = b % 1024, swz = sb ^ (((sb >> 9) & 1) << 5); R = (st >> 1) * 16 + swz / 64; C = (st & 1) * 32 + (swz % 64) / 2; }
__device__ __forceinline__ int perm32(int rho) { const int n = rho >> 4, i = rho & 15; return 8 * (i >> 2) + 4 * n + (i & 3); }
struct Unit { int pm, pn, part; };
struct Gemm { const u16* A; const u16* Bt; int lda, ldb, K; };
struct StaticOrder {
    int nM, nN, nwg, G, c, rev;
    __device__ void init(int M, int N, int G_, int c_, int rev_ = 0) { nM = M / BM; nN = N / BM; nwg = nM * nN; G = G_; c = c_; rev = rev_; }
    __device__ bool next(int i, Unit& u) const {
        const long L = (long)i * G + c; if (L >= nwg) return false;
        int wgid = (int)L; { const int q = nwg / NXCD, r = nwg % NXCD, xcd = wgid % NXCD, off = wgid / NXCD; wgid = (xcd < r ? xcd * (q + 1) : r * (q + 1) + (xcd - r) * q) + off; }
        const int nig = WGM * nN, gid = wgid / nig, fm = gid * WGM, gsz = (nM - fm) < WGM ? (nM - fm) : WGM;
        u.pm = fm + ((wgid % nig) % gsz); u.pn = (wgid % nig) / gsz; if (rev) u.pm = nM - 1 - u.pm; return true;
    }
};

template <class Epi, bool SPLIT = false>
__device__ __forceinline__ void gemm_phase(LAS unsigned char* lds, const Gemm g, const StaticOrder& S, const Epi& E, int splitK = 0) {
    int tid_ = threadIdx.x; asm volatile("" : "+v"(tid_));
    const int tid = tid_, wid = __builtin_amdgcn_readfirstlane(tid >> 6), lane = tid & 63, wr = wid >> 2, wc = wid & 3, fr = lane & 15, fq = lane >> 4;
    int K_ = g.K, lda_ = g.lda, ldb_ = g.ldb; asm volatile("" : "+s"(K_), "+s"(lda_), "+s"(ldb_));
    const int K = K_;
    int nt = SPLIT ? splitK / BK : K / BK;
    unsigned voffA[2], voffB[2];
#pragma unroll
    for (int i = 0; i < 2; ++i) { int R, C; stage_rc(tid * 16 + i * 8192, R, C); const int Rb = Epi::PERM ? ((R & ~31) + perm32(R & 31)) : R;
        voffA[i] = (unsigned)(R * lda_ + C) * 2u; voffB[i] = (unsigned)(Rb * ldb_ + C) * 2u; }
    const size_t kstep = (size_t)(BK * 2);
    const size_t hstepA = (size_t)HALF * lda_ * 2, hstepB = (size_t)HALF * ldb_ * 2;
    const size_t tstepA = 2 * hstepA, tstepB = 2 * hstepB;
    const unsigned ldsw = (unsigned)wid * 1024u;
    const int aoff = lds_byte(wr * 64 + fr, fq * 8), boff = lds_byte(wc * 32 + fr, fq * 8);
#define PG8_SA(b, h) (((b) * 2 + (h)) * HTB)
#define PG8_SB(b, h) ((4 + (b) * 2 + (h)) * HTB)
#define PG8_STAGE(bufoff, gbase, voff) do { _Pragma("unroll") for (int _i = 0; _i < 2; ++_i) \
        __builtin_amdgcn_global_load_lds((const unsigned*)((const char*)(gbase) + (voff)[_i]), (LAS unsigned*)(lds + (bufoff) + ldsw + _i * 8192), 16, 0, 0); } while (0)
#define PG8_LDA(dst, b, h) do { _Pragma("unroll") for (int m = 0; m < 4; ++m) _Pragma("unroll") for (int k = 0; k < 2; ++k) dst[m][k] = *(const LAS bf16x8*)(lds + PG8_SA(b, h) + aoff + m * 2048 + k * 1024); } while (0)
#define PG8_LDB(dst, b, h) do { _Pragma("unroll") for (int n = 0; n < 2; ++n) _Pragma("unroll") for (int k = 0; k < 2; ++k) dst[n][k] = *(const LAS bf16x8*)(lds + PG8_SB(b, h) + boff + n * 2048 + k * 1024); } while (0)
#define PG8_MMA(ai, bj, At, Bt) do { __builtin_amdgcn_s_setprio(1); _Pragma("unroll") for (int m = 0; m < 4; ++m) _Pragma("unroll") for (int n = 0; n < 2; ++n) _Pragma("unroll") for (int k = 0; k < 2; ++k) \
        acc[ai][bj][m][n] = __builtin_amdgcn_mfma_f32_16x16x32_bf16(Bt[n][k], At[m][k], acc[ai][bj][m][n], 0, 0, 0); __builtin_amdgcn_s_setprio(0); } while (0)
#define PG8_WAIT_V(n) asm volatile("s_waitcnt vmcnt(" #n ")" ::: "memory")
#define PG8_WAIT_L(n) asm volatile("s_waitcnt lgkmcnt(" #n ")" ::: "memory")
#define PG8_BAR __builtin_amdgcn_s_barrier()
#define PG8_SCHED __builtin_amdgcn_sched_barrier(0)
    Unit cur, nxt; int ui = 0;
    cur.part = 0; nxt.part = 0;
    if (!S.next(0, cur)) return;
    f32x4 acc[2][2][4][2];
#pragma unroll
    for (int a = 0; a < 2; ++a)
#pragma unroll
        for (int b = 0; b < 2; ++b)
#pragma unroll
            for (int m = 0; m < 4; ++m)
#pragma unroll
                for (int n = 0; n < 2; ++n) acc[a][b][m][n] = (f32x4){0.f, 0.f, 0.f, 0.f};
    bf16x8 At[4][2], B0[2][2], B1[2][2];
    const char* cA = (const char*)g.A + (size_t)cur.pm * tstepA; const char* cB = (const char*)g.Bt + (size_t)cur.pn * tstepB;
    const size_t poff = (size_t)splitK * 2;
    PG8_STAGE(PG8_SB(0, 0), cB, voffB); PG8_STAGE(PG8_SA(0, 0), cA, voffA); PG8_STAGE(PG8_SB(0, 1), cB + hstepB, voffB); PG8_STAGE(PG8_SA(0, 1), cA + hstepA, voffA);
    if (wr == 1) PG8_BAR;
    PG8_WAIT_V(4); PG8_BAR;
    PG8_STAGE(PG8_SB(1, 0), cB + kstep, voffB); PG8_STAGE(PG8_SA(1, 0), cA + kstep, voffA); PG8_STAGE(PG8_SB(1, 1), cB + hstepB + kstep, voffB);
    PG8_WAIT_V(6); PG8_BAR;
    for (;;) {
        bool has_next;
        if constexpr (SPLIT) { has_next = S.next((ui + 1) >> 1, nxt); nxt.part = (ui + 1) & 1; } else has_next = S.next(ui + 1, nxt);
        const char* nA = has_next ? (const char*)g.A + (size_t)nxt.pm * tstepA + (SPLIT && nxt.part ? poff : 0) : cA;
        const char* nB = has_next ? (const char*)g.Bt + (size_t)nxt.pn * tstepB + (SPLIT && nxt.part ? poff : 0) : cB;
        for (int t = 0; t < nt; t += 2) {
            const bool last = (t == nt - 2);
            const char* a1 = cA + (size_t)(t + 1) * kstep;
            const char* a2 = last ? nA : cA + (size_t)(t + 2) * kstep; const char* b2 = last ? nB : cB + (size_t)(t + 2) * kstep;
            const char* a3 = a2 + kstep; const char* b3 = b2 + kstep;
            PG8_LDB(B0, 0, 0); PG8_SCHED; PG8_LDA(At, 0, 0); PG8_STAGE(PG8_SA(1, 1), a1 + hstepA, voffA);
            PG8_WAIT_L(8); PG8_BAR; PG8_WAIT_L(0); PG8_MMA(0, 0, At, B0); PG8_BAR; PG8_SCHED;
            PG8_LDB(B1, 0, 1); PG8_STAGE(PG8_SB(0, 0), b2, voffB);
            PG8_BAR; PG8_WAIT_L(0); PG8_MMA(0, 1, At, B1); PG8_BAR;
            PG8_LDA(At, 0, 1); PG8_STAGE(PG8_SA(0, 0), a2, voffA);
            PG8_BAR; PG8_WAIT_L(0); PG8_MMA(1, 0, At, B0); PG8_BAR; PG8_SCHED;
            PG8_STAGE(PG8_SB(0, 1), b2 + hstepB, voffB);
            PG8_WAIT_V(6); PG8_BAR; PG8_MMA(1, 1, At, B1); PG8_BAR;
            PG8_LDB(B0, 1, 0); PG8_SCHED; PG8_LDA(At, 1, 0); PG8_STAGE(PG8_SA(0, 1), a2 + hstepA, voffA);
            PG8_WAIT_L(8); PG8_BAR; PG8_WAIT_L(0); PG8_MMA(0, 0, At, B0); PG8_BAR; PG8_SCHED;
            PG8_LDB(B1, 1, 1); PG8_STAGE(PG8_SB(1, 0), b3, voffB);
            PG8_BAR; PG8_WAIT_L(0); PG8_MMA(0, 1, At, B1); PG8_BAR;
            PG8_LDA(At, 1, 1); PG8_STAGE(PG8_SA(1, 0), a3, voffA);
            PG8_BAR; PG8_WAIT_L(0); PG8_MMA(1, 0, At, B0); PG8_BAR; PG8_SCHED;
            PG8_STAGE(PG8_SB(1, 1), b3 + hstepB, voffB);
            PG8_WAIT_V(6); PG8_BAR; PG8_MMA(1, 1, At, B1); PG8_BAR;
        }
        E(acc, cur, wr, wc, fr, fq);
        if (!has_next) break;
        if (!SPLIT || cur.part == 1) {
#pragma unroll
            for (int a = 0; a < 2; ++a)
#pragma unroll
                for (int b = 0; b < 2; ++b)
#pragma unroll
                    for (int m = 0; m < 4; ++m)
#pragma unroll
                        for (int n = 0; n < 2; ++n) acc[a][b][m][n] = (f32x4){0.f, 0.f, 0.f, 0.f};
        }
        cur = nxt; cA = nA; cB = nB; ++ui;
        if constexpr (SPLIT) nt = cur.part ? (K - splitK) / BK : splitK / BK;
    }
    PG8_WAIT_V(0);
    if (wr == 0) PG8_BAR;
    PG8_BAR;
#undef PG8_SA
#undef PG8_SB
#undef PG8_STAGE
#undef PG8_LDA
#undef PG8_LDB
#undef PG8_MMA
#undef PG8_WAIT_V
#undef PG8_WAIT_L
#undef PG8_BAR
#undef PG8_SCHED
}
}
using pg8::Unit;
typedef f32x4 AccT[2][2][4][2];

struct EpiFfnIn {
    static constexpr bool PERM = true;
    u16* hid;
    __device__ __forceinline__ void operator()(const AccT& acc, const Unit& u, int wr, int wc, int fr, int fq) const {
        const int row0 = u.pm * 256 + wr * 64 + fr, col0 = u.pn * 128 + wc * 32 + 8 * fq;
#pragma unroll
        for (int ai = 0; ai < 2; ++ai)
#pragma unroll
            for (int m = 0; m < 4; ++m) {
                u16* rowp = hid + (size_t)(row0 + ai * 128 + m * 16) * FF + col0;
                const f32x4 g0 = acc[ai][0][m][0], g1 = acc[ai][0][m][1], u0 = acc[ai][1][m][0], u1 = acc[ai][1][m][1];
                u32x4 w;
                w.x = cvt_pk_bf16(siluf(g0[0]) * u0[0], siluf(g0[1]) * u0[1]); w.y = cvt_pk_bf16(siluf(g0[2]) * u0[2], siluf(g0[3]) * u0[3]);
                w.z = cvt_pk_bf16(siluf(g1[0]) * u1[0], siluf(g1[1]) * u1[1]); w.w = cvt_pk_bf16(siluf(g1[2]) * u1[2], siluf(g1[3]) * u1[3]);
                *(u32x4*)rowp = w;
            }
    }
};
struct EpiRes {
    static constexpr bool PERM = false;
    u16* pre; const float* resf; const u16* resb; float alpha, scale;
    __device__ __forceinline__ void operator()(const AccT& acc, const Unit& u, int wr, int wc, int fr, int fq) const {
        const int row0 = u.pm * 256 + wr * 64 + fr, col0 = u.pn * 256 + wc * 32 + 4 * fq;
#pragma unroll
        for (int ai = 0; ai < 2; ++ai)
#pragma unroll
            for (int m = 0; m < 4; ++m) {
                const size_t off = (size_t)(row0 + ai * 128 + m * 16) * DM + col0;
#pragma unroll
                for (int bj = 0; bj < 2; ++bj)
#pragma unroll
                    for (int n = 0; n < 2; ++n) {
                        f32x4 r;
                        if (resf) r = *(const f32x4*)(resf + off + bj * 128 + n * 16);
                        else r = ld_bf4(resb + off + bj * 128 + n * 16);
                        const f32x4 o = r * alpha + acc[ai][bj][m][n] * scale;
                        u32x2 w; w.x = cvt_pk_bf16(o[0], o[1]); w.y = cvt_pk_bf16(o[2], o[3]);
                        *(u32x2*)(pre + off + bj * 128 + n * 16) = w;
                    }
                asm volatile("" ::: "memory");
            }
    }
};
struct EpiMix {
    static constexpr bool PERM = true;
    int pn0; u16* zr; u16* qrot; u16* krot; u16* ktz; u16* vt; u16* gsilu; u16* gate; const f32x2* cs;
    __device__ __forceinline__ void operator()(const AccT& acc, const Unit& u, int wr, int wc, int fr, int fq) const {
        const int T = pn0 + u.pn;
        const int row0 = u.pm * 256 + wr * 64 + fr, c8 = wc * 32 + 8 * fq;
        if (T < 7 || T >= 15) {
            u16* base; int ld, colt, act;
            if (T < 7) { base = zr; ld = 1792; colt = T * 256; act = 0; }
            else if (T < 19) { base = gsilu; ld = 1024; colt = (T - 15) * 256; act = 1; }
            else { base = gate; ld = 2048; colt = (T - 19) * 256; act = 2; }
#pragma unroll
            for (int ai = 0; ai < 2; ++ai)
#pragma unroll
                for (int m = 0; m < 4; ++m) {
                    u16* rowp = base + (size_t)(row0 + ai * 128 + m * 16) * ld + colt + c8;
#pragma unroll
                    for (int bj = 0; bj < 2; ++bj) {
                        f32x4 v0 = acc[ai][bj][m][0], v1 = acc[ai][bj][m][1];
                        if (act == 1) {
#pragma unroll
                            for (int j = 0; j < 4; ++j) { v0[j] = siluf(v0[j]); v1[j] = siluf(v1[j]); }
                        } else if (act == 2) {
#pragma unroll
                            for (int j = 0; j < 4; ++j) { v0[j] = sigm(v0[j]); v1[j] = sigm(v1[j]); }
                        }
                        u32x4 w; w.x = cvt_pk_bf16(v0[0], v0[1]); w.y = cvt_pk_bf16(v0[2], v0[3]); w.z = cvt_pk_bf16(v1[0], v1[1]); w.w = cvt_pk_bf16(v1[2], v1[3]);
                        *(u32x4*)(rowp + bj * 128) = w;
                    }
                    asm volatile("" ::: "memory");
                }
        } else if (T < 11) {
            const bool isk = T >= 9; const int t = isk ? T - 9 : T - 7;
            const int head = 2 * t + (wc >> 1), idx0 = 32 * (wc & 1) + 8 * fq;
            const float sc = isk ? 0.08838834764831845f : 1.0f;
            const float l2g = __log2f(1.0f - __builtin_amdgcn_exp2f((float)(-5 - head)));
#pragma unroll
            for (int ai = 0; ai < 2; ++ai)
#pragma unroll
                for (int m = 0; m < 4; ++m) {
                    const int row = row0 + ai * 128 + m * 16;
                    const f32x4* cp = (const f32x4*)(cs + (size_t)row * 64 + idx0);
                    float o1[8], o2[8];
#pragma unroll
                    for (int q = 0; q < 4; ++q) {
                        const f32x4 c2 = cp[q];
                        const int n = q >> 1, j = (q & 1) * 2;
                        const float xa = acc[ai][0][m][n][j], xb = acc[ai][1][m][n][j], ya = acc[ai][0][m][n][j + 1], yb = acc[ai][1][m][n][j + 1];
                        o1[2 * q] = (xa * c2[0] - xb * c2[1]) * sc; o2[2 * q] = (xb * c2[0] + xa * c2[1]) * sc;
                        o1[2 * q + 1] = (ya * c2[2] - yb * c2[3]) * sc; o2[2 * q + 1] = (yb * c2[2] + ya * c2[3]) * sc;
                    }
                    u16* np = (isk ? krot : qrot) + (size_t)row * 512 + head * 128 + idx0;
                    u32x4 w; w.x = cvt_pk_bf16(o1[0], o1[1]); w.y = cvt_pk_bf16(o1[2], o1[3]); w.z = cvt_pk_bf16(o1[4], o1[5]); w.w = cvt_pk_bf16(o1[6], o1[7]);
                    *(u32x4*)np = w;
                    w.x = cvt_pk_bf16(o2[0], o2[1]); w.y = cvt_pk_bf16(o2[2], o2[3]); w.z = cvt_pk_bf16(o2[4], o2[5]); w.w = cvt_pk_bf16(o2[6], o2[7]);
                    *(u32x4*)(np + 64) = w;
                    if (isk) {
                        const int b = row >> 13, s = row & 8191, chunk = s >> 7, mm = s & 127;
                        const float zeta = __builtin_amdgcn_exp2f(l2g * (float)(127 - mm));
                        u16* tp = ktz + ((size_t)((b * 4 + head) * 64 + chunk) * 128 + idx0) * 128 + mm;
#pragma unroll
                        for (int i = 0; i < 8; ++i) {
                            tp[(size_t)i * 128] = (u16)(cvt_pk_bf16(o1[i] * zeta, 0.f) & 0xffffu);
                            tp[(size_t)(64 + i) * 128] = (u16)(cvt_pk_bf16(o2[i] * zeta, 0.f) & 0xffffu);
                        }
                    }
                    asm volatile("" ::: "memory");
                }
        } else {
            const int head = T - 11;
#pragma unroll
            for (int ai = 0; ai < 2; ++ai)
#pragma unroll
                for (int m = 0; m < 4; ++m) {
                    const int row = row0 + ai * 128 + m * 16;
                    const int b = row >> 13, s = row & 8191, chunk = s >> 7, mm = s & 127;
                    u16* tp = vt + ((size_t)((b * 4 + head) * 64 + chunk) * 256 + c8) * 128 + mm;
#pragma unroll
                    for (int bj = 0; bj < 2; ++bj)
#pragma unroll
                        for (int n = 0; n < 2; ++n)
#pragma unroll
                            for (int j = 0; j < 4; ++j)
                                tp[(size_t)(bj * 128 + 4 * n + j) * 128] = (u16)(cvt_pk_bf16(acc[ai][bj][m][n][j], 0.f) & 0xffffu);
                    asm volatile("" ::: "memory");
                }
        }
    }
};
struct EpiLora {
    static constexpr bool PERM = true;
    _Float16* wbuf; _Float16* abuf; _Float16* gbuf; const float* w0; const float* a0;
    __device__ __forceinline__ void operator()(const AccT& acc, const Unit& u, int wr, int wc, int fr, int fq) const {
        const int kind = u.pn >> 1;
        const int row0 = u.pm * 256 + wr * 64 + fr, ch0 = (u.pn & 1) * 256 + wc * 32 + 8 * fq;
        _Float16* dst = wbuf + (size_t)kind * (size_t)(32u << 20);
        const float* bias = kind == 0 ? w0 : a0;
#pragma unroll
        for (int bj = 0; bj < 2; ++bj) {
            const int ch = ch0 + bj * 128;
            f32x4 b0 = {0.f, 0.f, 0.f, 0.f}, b1 = b0;
            if (kind < 2) { b0 = *(const f32x4*)(bias + ch); b1 = *(const f32x4*)(bias + ch + 4); }
#pragma unroll
            for (int ai = 0; ai < 2; ++ai)
#pragma unroll
                for (int m = 0; m < 4; ++m) {
                    const int row = row0 + ai * 128 + m * 16;
                    f32x4 v0 = acc[ai][bj][m][0] + b0, v1 = acc[ai][bj][m][1] + b1;
                    if (kind < 2) {
#pragma unroll
                        for (int j = 0; j < 4; ++j) { v0[j] = sigm(v0[j]); v1[j] = sigm(v1[j]); }
                    }
                    if (kind == 0) {
#pragma unroll
                        for (int j = 0; j < 4; ++j) { v0[j] = __builtin_amdgcn_exp2f(-DECAY_SCALE * 1.44269504f * v0[j]); v1[j] = __builtin_amdgcn_exp2f(-DECAY_SCALE * 1.44269504f * v1[j]); }
                    }
                    *(h16x8*)(dst + (size_t)row * 512 + ch) = (h16x8){(_Float16)v0[0], (_Float16)v0[1], (_Float16)v0[2], (_Float16)v0[3], (_Float16)v1[0], (_Float16)v1[1], (_Float16)v1[2], (_Float16)v1[3]};
                    asm volatile("" ::: "memory"); __builtin_amdgcn_sched_barrier(0);
                }
        }
    }
};
struct EpiBr {
    static constexpr bool PERM = true;
    const u16* gate; u16* merged;
    __device__ __forceinline__ void operator()(AccT& acc, const Unit& u, int wr, int wc, int fr, int fq) const {
        if (u.part == 0) scale(acc, u, wr, wc, fr, fq); else store(acc, u, wr, wc, fr, fq);
    }
    __device__ __forceinline__ void scale(AccT& acc, const Unit& u, int wr, int wc, int fr, int fq) const {
        const int row0 = u.pm * 256 + wr * 64 + fr, col0 = u.pn * 256 + wc * 32 + 8 * fq;
#pragma unroll
        for (int ai = 0; ai < 2; ++ai)
#pragma unroll
            for (int m = 0; m < 4; ++m) {
                const int row = row0 + ai * 128 + m * 16;
#pragma unroll
                for (int bj = 0; bj < 2; ++bj) {
                    const int c = col0 + bj * 128;
                    const u32x4 g1 = *(const u32x4*)(gate + (size_t)row * 2048 + c), g2 = *(const u32x4*)(gate + (size_t)row * 2048 + 1024 + c);
                    f32x4 r0, r1;
                    r0[0] = bflo(g1.x) * __builtin_amdgcn_rcpf(bflo(g2.x)); r0[1] = bfhi(g1.x) * __builtin_amdgcn_rcpf(bfhi(g2.x));
                    r0[2] = bflo(g1.y) * __builtin_amdgcn_rcpf(bflo(g2.y)); r0[3] = bfhi(g1.y) * __builtin_amdgcn_rcpf(bfhi(g2.y));
                    r1[0] = bflo(g1.z) * __builtin_amdgcn_rcpf(bflo(g2.z)); r1[1] = bfhi(g1.z) * __builtin_amdgcn_rcpf(bfhi(g2.z));
                    r1[2] = bflo(g1.w) * __builtin_amdgcn_rcpf(bflo(g2.w)); r1[3] = bfhi(g1.w) * __builtin_amdgcn_rcpf(bfhi(g2.w));
                    acc[ai][bj][m][0] = acc[ai][bj][m][0] * r0; acc[ai][bj][m][1] = acc[ai][bj][m][1] * r1;
                    asm volatile("" ::: "memory"); __builtin_amdgcn_sched_barrier(0);
                }
            }
    }
    __device__ __forceinline__ void store(const AccT& acc, const Unit& u, int wr, int wc, int fr, int fq) const {
        const int row0 = u.pm * 256 + wr * 64 + fr, col0 = u.pn * 256 + wc * 32 + 8 * fq;
#pragma unroll
        for (int ai = 0; ai < 2; ++ai)
#pragma unroll
            for (int m = 0; m < 4; ++m) {
                const int row = row0 + ai * 128 + m * 16;
#pragma unroll
                for (int bj = 0; bj < 2; ++bj) {
                    const int c = col0 + bj * 128;
                    const u32x4 gv = *(const u32x4*)(gate + (size_t)row * 2048 + 1024 + c);
                    const f32x4 g0 = {bflo(gv.x), bfhi(gv.x), bflo(gv.y), bfhi(gv.y)}, g1 = {bflo(gv.z), bfhi(gv.z), bflo(gv.w), bfhi(gv.w)};
                    const f32x4 v0 = g0 * acc[ai][bj][m][0], v1 = g1 * acc[ai][bj][m][1];
                    u32x4 w; w.x = cvt_pk_bf16(v0[0], v0[1]); w.y = cvt_pk_bf16(v0[2], v0[3]); w.z = cvt_pk_bf16(v1[0], v1[1]); w.w = cvt_pk_bf16(v1[2], v1[3]);
                    *(u32x4*)(merged + (size_t)row * DM + c) = w;
                }
                asm volatile("" ::: "memory");
            }
    }
};
struct EpiFin {
    static constexpr bool PERM = false;
    int mode; float* out; u16* pproj;
    __device__ __forceinline__ void operator()(const AccT& acc, const Unit& u, int wr, int wc, int fr, int fq) const {
        const int row0 = u.pm * 256 + wr * 64 + fr, col0 = u.pn * 256 + wc * 32 + 4 * fq;
#pragma unroll
        for (int ai = 0; ai < 2; ++ai)
#pragma unroll
            for (int m = 0; m < 4; ++m) {
                const size_t off = (size_t)(row0 + ai * 128 + m * 16) * DM + col0;
#pragma unroll
                for (int bj = 0; bj < 2; ++bj)
#pragma unroll
                    for (int n = 0; n < 2; ++n) {
                        const size_t o = off + bj * 128 + n * 16;
                        const f32x4 a = acc[ai][bj][m][n];
                        if (mode == 0) { u32x2 w; w.x = cvt_pk_bf16(a[0], a[1]); w.y = cvt_pk_bf16(a[2], a[3]); *(u32x2*)(pproj + o) = w; }
                        else {
                            const f32x4 pp = ld_bf4(pproj + o), h = *(const f32x4*)(out + o);
                            f32x4 r; r[0] = h[0] + sigm(a[0]) * pp[0]; r[1] = h[1] + sigm(a[1]) * pp[1]; r[2] = h[2] + sigm(a[2]) * pp[2]; r[3] = h[3] + sigm(a[3]) * pp[3];
                            *(f32x4*)(out + o) = r;
                        }
                    }
                asm volatile("" ::: "memory");
            }
    }
};

__device__ __forceinline__ int map_row(int mode, int n) {
    if (mode == 1) { const int bj = n >= FF ? 1 : 0, cc = n - bj * FF; return (cc >> 7) * 256 + bj * 128 + (cc & 127); }
    if (mode == 2) {
        if (n < 1792 || n >= 2816) return n;
        const int base = n < 2304 ? 1792 : 2304, c = n - base, head = c >> 7, half = (c >> 6) & 1, idx = c & 63;
        return base + 256 * (head >> 1) + 128 * half + 64 * (head & 1) + idx;
    }
    return n;
}
__device__ __forceinline__ void conv_weight(const float* W, int K, int N, u16* dst, int mode, size_t gtid, size_t gth, int ldk = 0) {
    if (ldk == 0) ldk = K;
    const size_t total = (size_t)N * (K >> 3);
    for (size_t idx = gtid; idx < total; idx += gth) {
        const int n = (int)(idx % N), kc = (int)(idx / N);
        const float* s = W + (size_t)(kc * 8) * N + n;
        float v[8];
#pragma unroll
        for (int i = 0; i < 8; ++i) v[i] = s[(size_t)i * N];
        u32x4 w; w.x = cvt_pk_bf16(v[0], v[1]); w.y = cvt_pk_bf16(v[2], v[3]); w.z = cvt_pk_bf16(v[4], v[5]); w.w = cvt_pk_bf16(v[6], v[7]);
        *(u32x4*)(dst + (size_t)map_row(mode, n) * ldk + kc * 8) = w;
    }
}
__device__ __forceinline__ void conv_rows(const float* __restrict__ src, u16* __restrict__ dst, size_t n8, size_t gtid, size_t gth) {
    for (size_t i = gtid; i < n8; i += 4 * gth) {
        f32x4 a[4], b[4];
#pragma unroll
        for (int u = 0; u < 4; ++u) { const size_t j = i + u * gth; if (j < n8) { a[u] = *(const f32x4*)(src + j * 8); b[u] = *(const f32x4*)(src + j * 8 + 4); } }
#pragma unroll
        for (int u = 0; u < 4; ++u) { const size_t j = i + u * gth; if (j < n8) {
            u32x4 w; w.x = cvt_pk_bf16(a[u][0], a[u][1]); w.y = cvt_pk_bf16(a[u][2], a[u][3]); w.z = cvt_pk_bf16(b[u][0], b[u][1]); w.w = cvt_pk_bf16(b[u][2], b[u][3]);
            *(u32x4*)(dst + j * 8) = w; } }
    }
}
__device__ __forceinline__ void phase_convert(const Params& P, size_t gtid, size_t gth) {
    unsigned char* ws = P.ws;
    conv_rows(P.in[1], (u16*)(ws + O_PB), (size_t)MTOK * 256 / 8, gtid, gth);
    conv_weight(P.in[5], DM, 2 * FF, (u16*)(ws + O_W1T), 1, gtid, gth);
    conv_weight(P.in[6], FF, DM, (u16*)(ws + O_W2T), 0, gtid, gth);
    conv_weight(P.in[7], DM, MIXN, (u16*)(ws + O_WMT), 2, gtid, gth);
    conv_weight(P.in[24], DM, 2 * FF, (u16*)(ws + O_W3T), 1, gtid, gth);
    conv_weight(P.in[25], FF, DM, (u16*)(ws + O_W4T), 0, gtid, gth);
    conv_weight(P.in[19], 512, DM, (u16*)(ws + O_WBR), 0, gtid, gth, 1536);
    conv_weight(P.in[20], DM, DM, (u16*)(ws + O_WBR) + 512, 0, gtid, gth, 1536);
    conv_weight(P.in[21], DM, DM, (u16*)(ws + O_WMO), 0, gtid, gth);
    conv_weight(P.in[29], DM, DM, (u16*)(ws + O_WGT), 0, gtid, gth);
    conv_weight(P.in[28], 256, DM, (u16*)(ws + O_WPT), 0, gtid, gth);
    {
        u16* dst = (u16*)(ws + O_WLT);
        for (size_t idx = gtid; idx < 1536 * 32; idx += gth) {
            const int n = (int)(idx % 1536), kc = (int)(idx / 1536), k0 = kc * 8;
            float v[8];
#pragma unroll
            for (int i = 0; i < 8; ++i) v[i] = 0.f;
            if (n < 512) { if (k0 < 64) {
#pragma unroll
                for (int i = 0; i < 8; ++i) v[i] = P.in[10][(size_t)(k0 + i) * 512 + n]; } }
            else if (n < 1024) { if (k0 >= 64 && k0 < 128) {
#pragma unroll
                for (int i = 0; i < 8; ++i) v[i] = P.in[12][(size_t)(k0 - 64 + i) * 512 + (n - 512)]; } }
            else { if (k0 >= 128) {
#pragma unroll
                for (int i = 0; i < 8; ++i) v[i] = P.in[13][(size_t)(k0 - 128 + i) * 512 + (n - 1024)]; } }
            u32x4 w; w.x = cvt_pk_bf16(v[0], v[1]); w.y = cvt_pk_bf16(v[2], v[3]); w.z = cvt_pk_bf16(v[4], v[5]); w.w = cvt_pk_bf16(v[6], v[7]);
            *(u32x4*)(dst + (size_t)n * 256 + k0) = w;
        }
    }
    {
        f32x2* cs = (f32x2*)(ws + O_CS); const int* pos = (const int*)P.in[2];
        for (size_t idx = gtid; idx < (size_t)MTOK * 64; idx += gth) {
            const int tok = (int)(idx >> 6), i = (int)(idx & 63);
            const float invf = exp2f(-(float)i * (13.287712379549449f / 64.0f));
            const float ang = (float)pos[tok] * invf;
            const double a = (double)ang; const double kq = rint(a * 0.6366197723675814); const float r = (float)(a - kq * 1.5707963267948966);
            const int q = (int)((long long)kq & 3);
            const float r2 = r * r;
            const float sn = r + r * r2 * (-1.6666667e-1f + r2 * (8.3333333e-3f + r2 * (-1.9841270e-4f + r2 * 2.7557319e-6f)));
            const float cn = 1.0f + r2 * (-0.5f + r2 * (4.1666668e-2f + r2 * (-1.3888889e-3f + r2 * (2.4801587e-5f - r2 * 2.7557319e-7f))));
            float c, s;
            if (q == 0) { c = cn; s = sn; } else if (q == 1) { c = -sn; s = cn; } else if (q == 2) { c = -cn; s = -sn; } else { c = sn; s = -cn; }
            cs[idx] = (f32x2){c, s};
        }
    }
    conv_rows(P.in[0], (u16*)(ws + O_XB), (size_t)MTOK * DM / 8, gtid, gth);
}

__device__ __forceinline__ void phase_ln(const u16* pre, const float* g, const float* b, u16* hb, float* hf, int gw, int ngw, int lane) {
    f32x4 gv[4], bv[4];
#pragma unroll
    for (int j = 0; j < 4; ++j) { gv[j] = *(const f32x4*)(g + 4 * lane + 256 * j); bv[j] = *(const f32x4*)(b + 4 * lane + 256 * j); }
    for (int row = gw; row < MTOK; row += 2 * ngw) {
        const int row2 = row + ngw;
        const u16* xr = pre + (size_t)row * DM + 4 * lane; const u16* xr2 = pre + (size_t)row2 * DM + 4 * lane;
        f32x4 v[4], v2[4]; float s = 0.f, t = 0.f;
#pragma unroll
        for (int j = 0; j < 4; ++j) { v[j] = ld_bf4(xr + 256 * j); v2[j] = ld_bf4(xr2 + 256 * j); }
#pragma unroll
        for (int j = 0; j < 4; ++j) { s += (v[j][0] + v[j][1]) + (v[j][2] + v[j][3]); t += (v2[j][0] + v2[j][1]) + (v2[j][2] + v2[j][3]); }
        const float mean = wave_sum(s) * (1.f / DM), mean2 = wave_sum(t) * (1.f / DM); float s2 = 0.f, t2 = 0.f;
#pragma unroll
        for (int j = 0; j < 4; ++j) { v[j] = v[j] - mean; s2 += (v[j][0] * v[j][0] + v[j][1] * v[j][1]) + (v[j][2] * v[j][2] + v[j][3] * v[j][3]);
                                      v2[j] = v2[j] - mean2; t2 += (v2[j][0] * v2[j][0] + v2[j][1] * v2[j][1]) + (v2[j][2] * v2[j][2] + v2[j][3] * v2[j][3]); }
        const float rstd = 1.0f / sqrtf(wave_sum(s2) * (1.f / DM) + LN_EPS), rstd2 = 1.0f / sqrtf(wave_sum(t2) * (1.f / DM) + LN_EPS);
#pragma unroll
        for (int j = 0; j < 4; ++j) {
            const f32x4 o = v[j] * rstd * gv[j] + bv[j], o2 = v2[j] * rstd2 * gv[j] + bv[j];
            u32x2 w; w.x = cvt_pk_bf16(o[0], o[1]); w.y = cvt_pk_bf16(o[2], o[3]);
            *(u32x2*)(hb + (size_t)row * DM + 4 * lane + 256 * j) = w;
            w.x = cvt_pk_bf16(o2[0], o2[1]); w.y = cvt_pk_bf16(o2[2], o2[3]);
            *(u32x2*)(hb + (size_t)row2 * DM + 4 * lane + 256 * j) = w;
            if (hf) { *(f32x4*)(hf + (size_t)row * DM + 4 * lane + 256 * j) = o; *(f32x4*)(hf + (size_t)row2 * DM + 4 * lane + 256 * j) = o2; }
        }
    }
}

__device__ __forceinline__ void phase_lora_prep(const u16* __restrict__ zr, const float* __restrict__ mu, u16* __restrict__ alora, size_t gtid, size_t gth) {
    const int c = (int)(gtid & 31) * 8;
    const f32x4 m0 = *(const f32x4*)(mu + 1536 + c), m1 = *(const f32x4*)(mu + 1536 + c + 4);
    for (size_t idx = gtid; idx < (size_t)MTOK * 32; idx += 4 * gth) {
        u32x4 z[4], zp[4];
#pragma unroll
        for (int u = 0; u < 4; ++u) {
            const int tok = (int)((idx + u * gth) >> 5);
            z[u] = *(const u32x4*)(zr + (size_t)tok * 1792 + 1536 + c);
            zp[u] = ((tok & (SEQ - 1)) != 0) ? *(const u32x4*)(zr + (size_t)(tok - 1) * 1792 + 1536 + c) : (u32x4){0u, 0u, 0u, 0u};
        }
#pragma unroll
        for (int u = 0; u < 4; ++u) {
            const int tok = (int)((idx + u * gth) >> 5);
            const f32x4 a0 = {bflo(z[u].x), bfhi(z[u].x), bflo(z[u].y), bfhi(z[u].y)}, a1 = {bflo(z[u].z), bfhi(z[u].z), bflo(z[u].w), bfhi(z[u].w)};
            const f32x4 p0 = {bflo(zp[u].x), bfhi(zp[u].x), bflo(zp[u].y), bfhi(zp[u].y)}, p1 = {bflo(zp[u].z), bfhi(zp[u].z), bflo(zp[u].w), bfhi(zp[u].w)};
            f32x4 v0 = a0 + (p0 - a0) * m0, v1 = a1 + (p1 - a1) * m1;
            if (c < 64) {
#pragma unroll
                for (int j = 0; j < 4; ++j) { v0[j] = 2.f * sigm(2.f * v0[j]) - 1.f; v1[j] = 2.f * sigm(2.f * v1[j]) - 1.f; }
            } else if (c >= 128) {
#pragma unroll
                for (int j = 0; j < 4; ++j) { v0[j] = sigm(v0[j]); v1[j] = sigm(v1[j]); }
            }
            u32x4 w; w.x = cvt_pk_bf16(v0[0], v0[1]); w.y = cvt_pk_bf16(v0[2], v0[3]); w.z = cvt_pk_bf16(v1[0], v1[1]); w.w = cvt_pk_bf16(v1[2], v1[3]);
            *(u32x4*)(alora + (size_t)tok * 256 + c) = w;
        }
    }
}
struct RwkvConst { f32x4 mur, muk, muv, kk_, ka_; };
__device__ __forceinline__ RwkvConst rwkv_const(const float* mu, const float* k_k, const float* k_a, int ch) {
    RwkvConst c; c.mur = *(const f32x4*)(mu + ch); c.muk = *(const f32x4*)(mu + 512 + ch); c.muv = *(const f32x4*)(mu + 1024 + ch); c.kk_ = *(const f32x4*)(k_k + ch); c.ka_ = *(const f32x4*)(k_a + ch); return c;
}
struct RwkvRaw { u32x2 zr_, zk_, zv_, pr_, pk_, pv_; h16x4 ah; };
__device__ __forceinline__ f32x4 bf4(const u32x2 t) { return (f32x4){bflo(t.x), bfhi(t.x), bflo(t.y), bfhi(t.y)}; }
__device__ __forceinline__ RwkvRaw rwkv_load(const u16* zr, const _Float16* abuf, int tok, int ch) {
    const bool first = (tok & (SEQ - 1)) == 0;
    const u16* zt = zr + (size_t)tok * 1792 + ch; const u16* zq = first ? zt : zt - 1792;
    RwkvRaw w; w.zr_ = *(const u32x2*)zt; w.zk_ = *(const u32x2*)(zt + 512); w.zv_ = *(const u32x2*)(zt + 1024);
    w.pr_ = *(const u32x2*)zq; w.pk_ = *(const u32x2*)(zq + 512); w.pv_ = *(const u32x2*)(zq + 1024);
    w.ah = *(const h16x4*)(abuf + (size_t)tok * 512 + ch);
    return w;
}
__device__ __forceinline__ void rwkv_compute(const RwkvRaw& w, int tok, const RwkvConst& c, f32x4& r, f32x4& kh, f32x4& v, f32x4& kk, f32x4& bb) {
    const bool first = (tok & (SEQ - 1)) == 0;
    r = bf4(w.zr_); f32x4 k = bf4(w.zk_); v = bf4(w.zv_);
    f32x4 rp = bf4(w.pr_), kp = bf4(w.pk_), vp = bf4(w.pv_);
    if (first) { rp = (f32x4){0.f, 0.f, 0.f, 0.f}; kp = rp; vp = rp; }
    r = r + (rp - r) * c.mur; k = k + (kp - k) * c.muk; v = v + (vp - v) * c.muv;
    const f32x4 a = {(float)w.ah[0], (float)w.ah[1], (float)w.ah[2], (float)w.ah[3]};
    kk = k * c.kk_;
    const float ss = red16((kk[0] * kk[0] + kk[1] * kk[1]) + (kk[2] * kk[2] + kk[3] * kk[3]));
    kk = kk * __builtin_amdgcn_rsqf(fmaxf(ss, 1e-24f));
    kh = k * (1.0f + (a - 1.0f) * c.ka_); bb = kk * a;
}
__device__ __forceinline__ void rwkv_prep(const u16* zr, const _Float16* abuf, int tok, int ch, const RwkvConst& c, f32x4& r, f32x4& kh, f32x4& v, f32x4& kk, f32x4& bb) {
    const RwkvRaw w = rwkv_load(zr, abuf, tok, ch); rwkv_compute(w, tok, c, r, kh, v, kk, bb);
}
__device__ __forceinline__ void scan_load(const u16* zr, const _Float16* wbuf, const _Float16* abuf, int tok0, int pst, int pch, int c, RwkvRaw (&raw)[4], h16x4 (&wv)[4]) {
#pragma unroll
    for (int half = 0; half < 4; ++half) {
        const int tok = tok0 + c * 64 + pst + 16 * half;
        raw[half] = rwkv_load(zr, abuf, tok, pch);
        wv[half] = *(const h16x4*)(wbuf + (size_t)tok * 512 + pch);
    }
}
__device__ __forceinline__ void scan_write(LAS _Float16* lds, const RwkvConst& rc, int tok0, int pst, int pks, int c, int bufi, const RwkvRaw (&raw)[4], const h16x4 (&wv)[4]) {
    LAS _Float16* bp = lds + bufi * (64 * 384);
#pragma unroll
    for (int half = 0; half < 4; ++half) {
        const int st = pst + 16 * half, tok = tok0 + c * 64 + st;
        f32x4 r, kh, v, kk, bb; rwkv_compute(raw[half], tok, rc, r, kh, v, kk, bb);
        LAS _Float16* sp = bp + st * 384 + 4 * pks;
        *(LAS h16x4*)(sp) = wv[half];
        *(LAS h16x4*)(sp + 64) = (h16x4){(_Float16)kk[0], (_Float16)kk[1], (_Float16)kk[2], (_Float16)kk[3]};
        *(LAS h16x4*)(sp + 128) = (h16x4){(_Float16)bb[0], (_Float16)bb[1], (_Float16)bb[2], (_Float16)bb[3]};
        *(LAS h16x4*)(sp + 192) = (h16x4){(_Float16)kh[0], (_Float16)kh[1], (_Float16)kh[2], (_Float16)kh[3]};
        *(LAS h16x4*)(sp + 256) = (h16x4){(_Float16)r[0], (_Float16)r[1], (_Float16)r[2], (_Float16)r[3]};
        *(LAS h16x4*)(sp + 320) = (h16x4){(_Float16)v[0], (_Float16)v[1], (_Float16)v[2], (_Float16)v[3]};
    }
}
__device__ __forceinline__ float fmix_lo(float a, unsigned h, float c) { float d; asm("v_fma_mix_f32 %0, %1, %2, %3 op_sel_hi:[0,1,0]" : "=v"(d) : "v"(a), "v"(h), "v"(c)); return d; }
__device__ __forceinline__ float fmix_hi(float a, unsigned h, float c) { float d; asm("v_fma_mix_f32 %0, %1, %2, %3 op_sel:[0,1,0] op_sel_hi:[0,1,0]" : "=v"(d) : "v"(a), "v"(h), "v"(c)); return d; }
__device__ __forceinline__ float fmix2_lo(unsigned a, unsigned h, float c) { float d; asm("v_fma_mix_f32 %0, %1, %2, %3 op_sel_hi:[1,1,0]" : "=v"(d) : "v"(a), "v"(h), "v"(c)); return d; }
__device__ __forceinline__ float fmix2_hi(unsigned a, unsigned h, float c) { float d; asm("v_fma_mix_f32 %0, %1, %2, %3 op_sel:[0,1,0] op_sel_hi:[1,1,0]" : "=v"(d) : "v"(a), "v"(h), "v"(c)); return d; }
__device__ __forceinline__ void scan_step_asm(float& s0, float& s1, float& s2, float& s3, float& q0, float& q1,
                                              unsigned kkx, unsigned kky, unsigned wx, unsigned wy, unsigned khx, unsigned khy, unsigned bbx, unsigned bby, unsigned rx, unsigned ry, unsigned v) {
    float p0, p1, u0, u1, u2, u3;
    asm("v_fma_mix_f32 %[p0], %[s0], %[kkx], 0 op_sel_hi:[0,1,0]\n\t"
        "v_fma_mix_f32 %[p0], %[s1], %[kkx], %[p0] op_sel:[0,1,0] op_sel_hi:[0,1,0]\n\t"
        "v_fma_mix_f32 %[p0], %[s2], %[kky], %[p0] op_sel_hi:[0,1,0]\n\t"
        "v_fma_mix_f32 %[p0], %[s3], %[kky], %[p0] op_sel:[0,1,0] op_sel_hi:[0,1,0]\n\t"
        "v_fma_mix_f32 %[u0], %[s0], %[wx], 0 op_sel_hi:[0,1,0]\n\t"
        "v_fma_mix_f32 %[u1], %[s1], %[wx], 0 op_sel:[0,1,0] op_sel_hi:[0,1,0]\n\t"
        "v_add_f32_dpp %[p0], %[p0], %[p0] quad_perm:[1,0,3,2] row_mask:0xf bank_mask:0xf bound_ctrl:1\n\t"
        "v_fma_mix_f32 %[u2], %[s2], %[wy], 0 op_sel_hi:[0,1,0]\n\t"
        "v_fma_mix_f32 %[u3], %[s3], %[wy], 0 op_sel:[0,1,0] op_sel_hi:[0,1,0]\n\t"
        "v_add_f32_dpp %[p0], %[p0], %[p0] quad_perm:[2,3,0,1] row_mask:0xf bank_mask:0xf bound_ctrl:1\n\t"
        "v_fma_mix_f32 %[u0], %[v], %[khx], %[u0] op_sel_hi:[1,1,0]\n\t"
        "v_fma_mix_f32 %[u1], %[v], %[khx], %[u1] op_sel:[0,1,0] op_sel_hi:[1,1,0]\n\t"
        "v_add_f32_dpp %[p0], %[p0], %[p0] row_half_mirror row_mask:0xf bank_mask:0xf bound_ctrl:1\n\t"
        "v_fma_mix_f32 %[u2], %[v], %[khy], %[u2] op_sel_hi:[1,1,0]\n\t"
        "v_fma_mix_f32 %[u3], %[v], %[khy], %[u3] op_sel:[0,1,0] op_sel_hi:[1,1,0]\n\t"
        "v_add_f32_dpp %[p0], %[p0], %[p0] row_mirror row_mask:0xf bank_mask:0xf bound_ctrl:1\n\t"
        "v_xor_b32 %[p1], 0x80000000, %[p0]\n\t"
        "v_fma_mix_f32 %[s0], %[p1], %[bbx], %[u0] op_sel_hi:[0,1,0]\n\t"
        "v_fma_mix_f32 %[s1], %[p1], %[bbx], %[u1] op_sel:[0,1,0] op_sel_hi:[0,1,0]\n\t"
        "v_fma_mix_f32 %[s2], %[p1], %[bby], %[u2] op_sel_hi:[0,1,0]\n\t"
        "v_fma_mix_f32 %[s3], %[p1], %[bby], %[u3] op_sel:[0,1,0] op_sel_hi:[0,1,0]\n\t"
        "v_fma_mix_f32 %[q0], %[s0], %[rx], 0 op_sel_hi:[0,1,0]\n\t"
        "v_fma_mix_f32 %[q0], %[s1], %[rx], %[q0] op_sel:[0,1,0] op_sel_hi:[0,1,0]\n\t"
        "v_fma_mix_f32 %[q0], %[s2], %[ry], %[q0] op_sel_hi:[0,1,0]\n\t"
        "v_fma_mix_f32 %[q0], %[s3], %[ry], %[q0] op_sel:[0,1,0] op_sel_hi:[0,1,0]"
        : [s0] "+v"(s0), [s1] "+v"(s1), [s2] "+v"(s2), [s3] "+v"(s3), [q0] "=&v"(q0),
          [p0] "=&v"(p0), [p1] "=&v"(p1), [u0] "=&v"(u0), [u1] "=&v"(u1), [u2] "=&v"(u2), [u3] "=&v"(u3)
        : [kkx] "v"(kkx), [kky] "v"(kky), [wx] "v"(wx), [wy] "v"(wy), [khx] "v"(khx), [khy] "v"(khy), [bbx] "v"(bbx), [bby] "v"(bby), [rx] "v"(rx), [ry] "v"(ry), [v] "v"(v));
    q1 = 0.f;
}
constexpr int TCH = 64;
constexpr int SCH = 6 * 64;
__device__ __forceinline__ void phase_scan(LAS unsigned char* ldsb, const u16* zr, const _Float16* wbuf, const _Float16* abuf, const float* mu, const float* k_k, const float* k_a,
                                           float* yraw, int tid, int bid) {
    LAS _Float16* lds = (LAS _Float16*)ldsb;
    LAS float* ypart = (LAS float*)(ldsb + 2 * TCH * SCH * 2);
    const int wid = tid >> 6, lane = tid & 63;
    const int blk = bid, xcd = blk & 7, slot = blk >> 3, bh = xcd * 8 + (slot >> 2), quarter = slot & 3;
    const int b = bh >> 3, h = bh & 7, tok0 = b * SEQ;
    const bool comp = wid < 4;
    const int rowl = quarter * 16 + (wid & 3) * 4 + (lane >> 4), ks = lane & 15;
    constexpr int NCH = SEQ / TCH;
    const int p = tid & 255, pst = p >> 4, pks = p & 15, pch = h * 64 + 4 * pks;
    RwkvConst rc = rwkv_const(mu, k_k, k_a, pch);
    RwkvRaw raw[4]; h16x4 wv[4];
    if (!comp) { scan_load(zr, wbuf, abuf, tok0, pst, pch, 0, raw, wv); scan_write(lds, rc, tok0, pst, pks, 0, 0, raw, wv); scan_load(zr, wbuf, abuf, tok0, pst, pch, 1, raw, wv); }
    __syncthreads();
    float s0 = 0.f, s1 = 0.f, s2 = 0.f, s3 = 0.f;
    LAS float* ypw = ypart + (wid & 3) * (32 * 64);
#define SCAN_LD(W, KK, BB, KH, R, V, st) do { const LAS _Float16* sp_ = bp + (st) * SCH; W = *(const LAS u32x2*)(sp_ + 4 * ks); KK = *(const LAS u32x2*)(sp_ + 64 + 4 * ks); \
        BB = *(const LAS u32x2*)(sp_ + 128 + 4 * ks); KH = *(const LAS u32x2*)(sp_ + 192 + 4 * ks); R = *(const LAS u32x2*)(sp_ + 256 + 4 * ks); V = *(const LAS unsigned short*)(sp_ + 320 + rowl); } while (0)
#pragma nounroll
    for (int c = 0; c < NCH; ++c) {
        if (!comp) {
            if (c + 1 < NCH) scan_write(lds, rc, tok0, pst, pks, c + 1, (c + 1) & 1, raw, wv);
            if (c + 2 < NCH) scan_load(zr, wbuf, abuf, tok0, pst, pch, c + 2, raw, wv);
        }
        else {
            const LAS _Float16* bp = lds + (c & 1) * (TCH * SCH);
            u32x2 w, kk, bb, kh, r; unsigned v;
            SCAN_LD(w, kk, bb, kh, r, v, 0);
#pragma unroll
            for (int st = 0; st < TCH; ++st) {
                u32x2 nw, nkk, nbb, nkh, nr; unsigned nv;
                if (st + 1 < TCH) SCAN_LD(nw, nkk, nbb, nkh, nr, nv, st + 1);
                float q0, q1;
                scan_step_asm(s0, s1, s2, s3, q0, q1, kk.x, kk.y, w.x, w.y, kh.x, kh.y, bb.x, bb.y, r.x, r.y, v);
                ypw[(st & 31) * 64 + lane] = q0;
                if (st + 1 < TCH) { w = nw; kk = nkk; bb = nbb; kh = nkh; r = nr; v = nv; }
                if ((st & 31) == 31) {
#pragma unroll
                    for (int i = 0; i < 2; ++i) {
                        const int pp = lane + 64 * i, st2 = pp >> 2, rw = pp & 3;
                        const LAS f32x4* q = (const LAS f32x4*)(ypw + st2 * 64 + rw * 16);
                        const f32x4 a0 = q[0], a1 = q[1], a2 = q[2], a3 = q[3];
                        const f32x4 sm = (a0 + a1) + (a2 + a3);
                        yraw[(size_t)(tok0 + c * TCH + (st - 31) + st2) * 512 + h * 64 + quarter * 16 + (wid & 3) * 4 + rw] = (sm[0] + sm[1]) + (sm[2] + sm[3]);
                    }
                }
            }
        }
        asm volatile("s_waitcnt lgkmcnt(0)" ::: "memory"); __builtin_amdgcn_s_barrier(); asm volatile("" ::: "memory");
    }
#undef SCAN_LD
}
__device__ __forceinline__ void phase_rwkv_out(const float* __restrict__ yraw, const u16* __restrict__ zr, const _Float16* __restrict__ abuf, const _Float16* __restrict__ gbuf,
                                               const float* __restrict__ mu, const float* __restrict__ k_k, const float* __restrict__ k_a, const float* __restrict__ r_k,
                                               const float* __restrict__ gn_g, const float* __restrict__ gn_b, u16* __restrict__ yout, size_t gtid, size_t gth) {
    const int hk = (int)(gtid & 127), head = hk >> 4, ks = hk & 15, ch = head * 64 + ks * 4;
    const RwkvConst rc = rwkv_const(mu, k_k, k_a, ch);
    const f32x4 rk = *(const f32x4*)(r_k + ch), gg = *(const f32x4*)(gn_g + ch), gb = *(const f32x4*)(gn_b + ch);
#pragma unroll 2
    for (size_t idx = gtid; idx < (size_t)MTOK * 128; idx += gth) {
        const int tok = (int)(idx >> 7);
        const f32x4 y = *(const f32x4*)(yraw + (size_t)tok * 512 + ch);
        const h16x4 gh = *(const h16x4*)(gbuf + (size_t)tok * 512 + ch);
        f32x4 r, kh, v, kk, bb; rwkv_prep(zr, abuf, tok, ch, rc, r, kh, v, kk, bb);
        const float mean = red16((y[0] + y[1]) + (y[2] + y[3])) * (1.f / 64.f);
        const f32x4 d = y - mean;
        const float var = red16((d[0] * d[0] + d[1] * d[1]) + (d[2] * d[2] + d[3] * d[3])) * (1.f / 64.f);
        const float rstd = 1.0f / sqrtf(var + 64e-5f);
        const float bs = red16((r[0] * kh[0] * rk[0] + r[1] * kh[1] * rk[1]) + (r[2] * kh[2] * rk[2] + r[3] * kh[3] * rk[3]));
        float o[4];
#pragma unroll
        for (int j = 0; j < 4; ++j) o[j] = (d[j] * rstd * gg[j] + gb[j] + bs * v[j]) * (float)gh[j];
        u32x2 w; w.x = cvt_pk_bf16(o[0], o[1]); w.y = cvt_pk_bf16(o[2], o[3]);
        *(u32x2*)(yout + (size_t)tok * 1536 + ch) = w;
    }
}

__device__ __forceinline__ bf16x8 ldfrag(const u16* p) { return *(const bf16x8*)p; }
__device__ __forceinline__ void r1_issue(LAS unsigned char* lds, int it, int bid, int wid, int fr, int fq, const u16* ktz) {
    const int itc = it > 7 ? 7 : it, item = itc * 256 + bid;
    const u16* src = ktz + (size_t)item * 16384 + (size_t)(16 * wid + fr) * 128 + 8 * fq;
    LAS unsigned char* dst = lds + (it % 3) * 32768 + wid * 4096;
#pragma unroll
    for (int k = 0; k < 4; ++k) __builtin_amdgcn_global_load_lds((const unsigned*)(src + 32 * k), (LAS unsigned*)(dst + k * 1024), 16, 0, 0);
}
__device__ __forceinline__ void phase_r1(LAS unsigned char* lds, const u16* vt, const u16* ktz, u16* ut, int wid_, int lane, int bid) {
    const int wid = __builtin_amdgcn_readfirstlane(wid_), fr = lane & 15, fq = lane >> 4;
    r1_issue(lds, 0, bid, wid, fr, fq, ktz); r1_issue(lds, 1, bid, wid, fr, fq, ktz); r1_issue(lds, 2, bid, wid, fr, fq, ktz);
    bf16x8 xf[2][4];
    {
        const u16* V = vt + (size_t)bid * 32768 + (size_t)(wid * 32) * 128;
#pragma unroll
        for (int i = 0; i < 2; ++i)
#pragma unroll
            for (int k = 0; k < 4; ++k) xf[i][k] = ldfrag(V + (size_t)(16 * i + fr) * 128 + 32 * k + 8 * fq);
    }
#pragma unroll 1
    for (int it = 0; it < 8; ++it) {
        const int item = it * 256 + bid;
        asm volatile("s_waitcnt vmcnt(8)" ::: "memory");
        asm volatile("s_waitcnt lgkmcnt(0)" ::: "memory"); __builtin_amdgcn_s_barrier(); asm volatile("" ::: "memory");
        const LAS unsigned char* kb = lds + (it % 3) * 32768 + lane * 16;
        f32x4 acc[2][8];
#pragma unroll
        for (int i = 0; i < 2; ++i)
#pragma unroll
            for (int j = 0; j < 8; ++j) acc[i][j] = (f32x4){0.f, 0.f, 0.f, 0.f};
#pragma unroll
        for (int k = 0; k < 4; ++k)
#pragma unroll
            for (int j = 0; j < 8; ++j) {
                const bf16x8 yf = *(const LAS bf16x8*)(kb + (j * 4 + k) * 1024);
#pragma unroll
                for (int i = 0; i < 2; ++i) acc[i][j] = __builtin_amdgcn_mfma_f32_16x16x32_bf16(yf, xf[i][k], acc[i][j], 0, 0, 0);
            }
        u16* U = ut + (size_t)item * 256 * 128 + (size_t)(wid * 32) * 128;
#pragma unroll
        for (int i = 0; i < 2; ++i)
#pragma unroll
            for (int j = 0; j < 8; ++j) { u32x2 w; w.x = cvt_pk_bf16(acc[i][j][0], acc[i][j][1]); w.y = cvt_pk_bf16(acc[i][j][2], acc[i][j][3]);
                *(u32x2*)(U + (size_t)(16 * i + fr) * 128 + 16 * j + 4 * fq) = w; }
        {
            const int itn = it < 7 ? it + 1 : 7;
            const u16* V = vt + (size_t)(itn * 256 + bid) * 32768 + (size_t)(wid * 32) * 128;
#pragma unroll
            for (int i = 0; i < 2; ++i)
#pragma unroll
                for (int k = 0; k < 4; ++k) xf[i][k] = ldfrag(V + (size_t)(16 * i + fr) * 128 + 32 * k + 8 * fq);
        }
        asm volatile("s_waitcnt lgkmcnt(0)" ::: "memory"); __builtin_amdgcn_s_barrier(); asm volatile("" ::: "memory");
        r1_issue(lds, it + 3, bid, wid, fr, fq, ktz);
    }
    asm volatile("s_waitcnt vmcnt(0)" ::: "memory");
    asm volatile("s_waitcnt lgkmcnt(0)" ::: "memory"); __builtin_amdgcn_s_barrier(); asm volatile("" ::: "memory");
}
__device__ __forceinline__ void phase_r2(u16* rt, size_t gtid, size_t gth) {
    for (size_t idx = gtid; idx < (size_t)32 * 8192; idx += gth) {
        const int bh = (int)(idx >> 13), off = (int)(idx & 8191) * 4, head = bh & 3;
        const float cd = __builtin_amdgcn_exp2f(128.f * __log2f(1.0f - __builtin_amdgcn_exp2f((float)(-5 - head))));
        f32x4 R = {0.f, 0.f, 0.f, 0.f};
        u16* rp = rt + (size_t)bh * 64 * 32768 + off;
#pragma unroll 8
        for (int c = 0; c < 64; ++c) {
            const f32x4 uv = ld_bf4(rp + (size_t)c * 32768);
            u32x2 w; w.x = cvt_pk_bf16(R[0], R[1]); w.y = cvt_pk_bf16(R[2], R[3]);
            *(u32x2*)(rp + (size_t)c * 32768) = w;
            R = R * cd + uv;
        }
    }
}
#define R3_WAITV(n) asm volatile("s_waitcnt vmcnt(" #n ")" ::: "memory")
#define R3_BAR() do { asm volatile("s_waitcnt lgkmcnt(0)" ::: "memory"); __builtin_amdgcn_s_barrier(); asm volatile("" ::: "memory"); } while (0)
__device__ __forceinline__ void r3_issue(LAS unsigned char* lds, int g, int bid, int wid, int fr, int fq, const u16* krot, const u16* rt, const u16* vt) {
    int it = g / 5; const int st = g - it * 5; it = it > 7 ? 7 : it;
    const int item = it * 256 + bid, bh = item >> 6, chunk = item & 63, b = bh >> 2, head = bh & 3, tok0 = b * SEQ + chunk * 128;
    const u16* src;
    if (st == 0) src = krot + (size_t)(tok0 + 16 * wid + fr) * 512 + head * 128 + 8 * fq;
    else src = (wid < 4 ? rt : vt) + (size_t)item * 32768 + (size_t)(16 * (4 * (st - 1) + (wid & 3)) + fr) * 128 + 8 * fq;
    LAS unsigned char* dst = lds + (g % 3) * 32768 + wid * 4096;
#pragma unroll
    for (int k = 0; k < 4; ++k) __builtin_amdgcn_global_load_lds((const unsigned*)(src + 32 * k), (LAS unsigned*)(dst + k * 1024), 16, 0, 0);
}
__device__ __forceinline__ void phase_r3(LAS unsigned char* lds, const u16* qrot, const u16* krot, const u16* vt, const u16* rt, const u16* gsilu, u16* yret, int wid_, int lane, int bid) {
    const int wid = __builtin_amdgcn_readfirstlane(wid_), fr = lane & 15, fq = lane >> 4;
    LAS unsigned char* Pw = lds + 98304 + (16 * wid + fr) * 256;
    const int nK = (wid >> 1) + 1;
    const int n = 16 * wid + fr;
    r3_issue(lds, 0, bid, wid, fr, fq, krot, rt, vt); r3_issue(lds, 1, bid, wid, fr, fq, krot, rt, vt); r3_issue(lds, 2, bid, wid, fr, fq, krot, rt, vt);
#pragma unroll 1
    for (int it = 0; it < 8; ++it) {
        const int item = it * 256 + bid, bh = item >> 6, chunk = item & 63, b = bh >> 2, head = bh & 3, tok0 = b * SEQ + chunk * 128, g0 = it * 5;
        const float l2g = __log2f(1.0f - __builtin_amdgcn_exp2f((float)(-5 - head)));
        bf16x8 qf[4];
#pragma unroll
        for (int k = 0; k < 4; ++k) qf[k] = ldfrag(qrot + (size_t)(tok0 + n) * 512 + head * 128 + 32 * k + 8 * fq);
        R3_WAITV(8); R3_BAR();
        {
            const LAS unsigned char* kb = lds + (g0 % 3) * 32768 + lane * 16;
            for (int j = 0; j < 2 * nK; ++j) {
                f32x4 sc = {0.f, 0.f, 0.f, 0.f};
#pragma unroll
                for (int k = 0; k < 4; ++k) { const bf16x8 kf = *(const LAS bf16x8*)(kb + (j * 4 + k) * 1024); sc = __builtin_amdgcn_mfma_f32_16x16x32_bf16(kf, qf[k], sc, 0, 0, 0); }
                float pv[4];
#pragma unroll
                for (int r = 0; r < 4; ++r) { const int m = 16 * j + 4 * fq + r; pv[r] = (m <= n) ? sc[r] * __builtin_amdgcn_exp2f(l2g * (float)(n - m)) : 0.f; }
                u32x2 w; w.x = cvt_pk_bf16(pv[0], pv[1]); w.y = cvt_pk_bf16(pv[2], pv[3]);
                *(LAS u32x2*)(Pw + (16 * j + 4 * fq) * 2) = w;
            }
        }
        R3_BAR(); r3_issue(lds, g0 + 3, bid, wid, fr, fq, krot, rt, vt);
        f32x4 acc[16];
        const float xi = __builtin_amdgcn_exp2f(l2g * (float)(n + 1));
#pragma unroll
        for (int q = 0; q < 4; ++q) {
            R3_WAITV(8); R3_BAR();
            const LAS unsigned char* sb = lds + ((g0 + 1 + q) % 3) * 32768 + lane * 16;
#pragma unroll
            for (int jj = 0; jj < 4; ++jj) {
                f32x4 a = {0.f, 0.f, 0.f, 0.f};
#pragma unroll
                for (int k = 0; k < 4; ++k) { const bf16x8 rf = *(const LAS bf16x8*)(sb + (jj * 4 + k) * 1024); a = __builtin_amdgcn_mfma_f32_16x16x32_bf16(rf, qf[k], a, 0, 0, 0); }
                acc[4 * q + jj] = a * xi;
            }
            for (int k = 0; k < nK; ++k) {
                const bf16x8 pf = *(const LAS bf16x8*)(Pw + (32 * k + 8 * fq) * 2);
#pragma unroll
                for (int jj = 0; jj < 4; ++jj) { const bf16x8 vf = *(const LAS bf16x8*)(sb + (16 + jj * 4 + k) * 1024); acc[4 * q + jj] = __builtin_amdgcn_mfma_f32_16x16x32_bf16(vf, pf, acc[4 * q + jj], 0, 0, 0); }
            }
            R3_BAR(); r3_issue(lds, g0 + 4 + q, bid, wid, fr, fq, krot, rt, vt);
        }
        float s1 = 0.f;
#pragma unroll
        for (int j = 0; j < 16; ++j) s1 += (acc[j][0] + acc[j][1]) + (acc[j][2] + acc[j][3]);
        s1 += __shfl_xor(s1, 16); s1 += __shfl_xor(s1, 32);
        const float mean = s1 * (1.f / 256.f);
        float s2 = 0.f;
#pragma unroll
        for (int j = 0; j < 16; ++j) { acc[j] = acc[j] - mean; s2 += (acc[j][0] * acc[j][0] + acc[j][1] * acc[j][1]) + (acc[j][2] * acc[j][2] + acc[j][3] * acc[j][3]); }
        s2 += __shfl_xor(s2, 16); s2 += __shfl_xor(s2, 32);
        const float rstd = 1.0f / sqrtf(s2 * (1.f / 256.f) + LN_EPS);
        const u16* gp = gsilu + (size_t)(tok0 + n) * 1024 + head * 256 + 4 * fq;
        u16* op = yret + (size_t)(tok0 + n) * 1536 + head * 256 + 4 * fq;
#pragma unroll
        for (int j = 0; j < 16; ++j) {
            const f32x4 gv = ld_bf4(gp + 16 * j);
            const f32x4 o = acc[j] * rstd * gv;
            u32x2 w; w.x = cvt_pk_bf16(o[0], o[1]); w.y = cvt_pk_bf16(o[2], o[3]);
            *(u32x2*)(op + 16 * j) = w;
        }
    }
    R3_WAITV(0); R3_BAR();
}

#define XB_TMO      128
#define XB_XCNT(j)  (256  + 64 * (j))
#define XB_XSUB(j)  (1280 + 64 * (j))
#define XB_XGEN(j)  (2304 + 64 * (j))
#define XB_TOP      3328
#define XB_TOPGEN   3392
#define XCD_BAR_WORDS 3456
#define XB_SPIN_CAP (1u << 22)
__device__ __forceinline__ unsigned xb_ld(unsigned* p)              { return __hip_atomic_load(p, __ATOMIC_RELAXED, __HIP_MEMORY_SCOPE_AGENT); }
__device__ __forceinline__ unsigned xb_add(unsigned* p, unsigned v) { return __hip_atomic_fetch_add(p, v, __ATOMIC_RELAXED, __HIP_MEMORY_SCOPE_AGENT); }
__device__ __forceinline__ unsigned xb_xcc_id() { return (unsigned)__builtin_amdgcn_s_getreg((3 << 11) | 20) & 0xFu; }
#define XB_SPIN(cond, bar) do { unsigned _sp = 0; while (cond) { __builtin_amdgcn_s_sleep(1); \
    if ((++_sp & 255u) == 0u) { if (xb_ld(&(bar)[XB_TMO])) break; if (_sp > XB_SPIN_CAP) { atomicAdd(&(bar)[XB_TMO], 1u); break; } } } } while (0)
struct XcdBarrier { unsigned* bar; unsigned x; volatile LAS unsigned* st; };
__device__ __forceinline__ XcdBarrier xcd_barrier_post(unsigned* bar, volatile LAS unsigned* st) {
    XcdBarrier b; b.bar = bar; b.x = xb_xcc_id(); b.st = st;
    if (threadIdx.x == 0) (void)xb_add(&bar[XB_XCNT(b.x)], 1u);
    return b;
}
__device__ __forceinline__ void xcd_barrier_complete(unsigned* bar, unsigned x, unsigned& nloc, unsigned& nx) {
    const unsigned G = gridDim.x * gridDim.y * gridDim.z;
    unsigned sum, cnt, mine, sp = 0u;
    for (;;) {
        sum = 0u; cnt = 0u; mine = 0u;
#pragma unroll
        for (unsigned j = 0; j < 16; ++j) { const unsigned c = xb_ld(&bar[XB_XCNT(j)]); sum += c; cnt += (c > 0u) ? 1u : 0u; mine = (j == x) ? c : mine; }
        if (sum == G) break;
        __builtin_amdgcn_s_sleep(1);
        if ((++sp & 255u) == 0u) { if (xb_ld(&bar[XB_TMO])) break; if (sp > XB_SPIN_CAP) { atomicAdd(&bar[XB_TMO], 1u); break; } }
    }
    nloc = mine > 0u ? mine : 1u; nx = cnt > 0u ? cnt : 1u;
}
__device__ __forceinline__ void xcd_barrier(const XcdBarrier& b) {
    asm volatile("s_waitcnt vmcnt(0)" ::: "memory");
    __syncthreads();
    if (threadIdx.x == 0) {
        unsigned* bar = b.bar;
        __builtin_amdgcn_s_waitcnt(0);
        unsigned nloc = b.st[0], nx = b.st[1];
        if (nloc == 0u) { xcd_barrier_complete(bar, b.x, nloc, nx); b.st[0] = nloc; b.st[1] = nx; }
        const unsigned old = xb_add(&bar[XB_XSUB(b.x)], 1u);
        const unsigned gen = old / nloc;
        if (old + 1u == (gen + 1u) * nloc) {
            __builtin_amdgcn_fence(__ATOMIC_RELEASE, "agent");
            asm volatile("s_waitcnt vmcnt(0)" ::: "memory");
            const unsigned og = xb_add(&bar[XB_TOP], 1u);
            const unsigned tg = og / nx;
            if (og + 1u == (tg + 1u) * nx) xb_add(&bar[XB_TOPGEN], 1u);
            else XB_SPIN(xb_ld(&bar[XB_TOPGEN]) == tg, bar);
            __builtin_amdgcn_fence(__ATOMIC_ACQUIRE, "agent");
            xb_add(&bar[XB_XGEN(b.x)], 1u);
            asm volatile("s_waitcnt vmcnt(0)" ::: "memory");
        } else {
            XB_SPIN(xb_ld(&bar[XB_XGEN(b.x)]) == gen, bar);
            __builtin_amdgcn_fence(__ATOMIC_ACQUIRE, "agent");
            asm volatile("s_waitcnt vmcnt(0)" ::: "memory");
        }
    }
    __syncthreads();
}

#ifndef PHMASK
#define PHMASK 0xFFFFFF
#endif
#define PH_ON(p) ((PHMASK >> (p)) & 1)
#ifndef REPMASK
#define REPMASK 0
#endif
#define PH_BEGIN(p) _Pragma("nounroll") for (int rep_ = 0; rep_ < (int)PH_ON(p) * (1 + (int)((REPMASK >> (p)) & 1)); ++rep_) { int tid = threadIdx.x; asm volatile("" : "+v"(tid)); int bid = blockIdx.x; asm volatile("" : "+s"(bid)); \
        size_t zoff_ = 0; asm volatile("" : "+s"(zoff_)); unsigned char* ws = P.ws + zoff_; float* dout = (float*)((unsigned char*)P.out + zoff_);     \
        const int wid = tid >> 6, lane = tid & 63; const size_t gtid = (size_t)bid * 512 + tid, gth = (size_t)gridDim.x * 512; const int gw = bid * 8 + wid, ngw = gridDim.x * 8; \
        (void)wid; (void)lane; (void)gtid; (void)gth; (void)gw; (void)ngw; (void)ws; (void)dout;
#define PH_END xcd_barrier(xb); }

__device__ __forceinline__ void run_ffn_in(LAS unsigned char* lds, const u16* A, const u16* Wt, u16* hid, int bid) {
    pg8::Gemm g{A, Wt, DM, DM, DM}; pg8::StaticOrder S; S.init(MTOK, 2 * FF, gridDim.x, bid);
    EpiFfnIn E{hid}; pg8::gemm_phase(lds, g, S, E);
}
__device__ __forceinline__ void run_res(LAS unsigned char* lds, const u16* A, const u16* Wt, int K, u16* pre, const float* resf, const u16* resb, float scale, int bid, int rev = 0) {
    pg8::Gemm g{A, Wt, K, K, K}; pg8::StaticOrder S; S.init(MTOK, DM, gridDim.x, bid, rev);
    EpiRes E{pre, resf, resb, DN_ALPHA, scale}; pg8::gemm_phase(lds, g, S, E);
}
__device__ __forceinline__ void run_mix(LAS unsigned char* lds, unsigned char* ws, float* dout, int pn0, int npn, int bid) {
    pg8::Gemm g{(const u16*)(ws + O_H), (const u16*)(ws + O_WMT) + (size_t)pn0 * 256 * DM, DM, DM, DM};
    pg8::StaticOrder S; S.init(MTOK, npn * 256, gridDim.x, bid);
    EpiMix E{pn0, (u16*)dout, (u16*)(ws + O_QROT), (u16*)(ws + O_KROT), (u16*)(ws + O_KTZ), (u16*)(ws + O_VT), (u16*)(ws + O_GSILU), (u16*)dout, (const f32x2*)(ws + O_CS)};
    pg8::gemm_phase(lds, g, S, E);
}
__device__ __forceinline__ void run_fin(LAS unsigned char* lds, const u16* A, const u16* Wt, int K, int mode, float* out, u16* pproj, int bid) {
    pg8::Gemm g{A, Wt, K, K, K}; pg8::StaticOrder S; S.init(MTOK, DM, gridDim.x, bid);
    EpiFin E{mode, out, pproj}; pg8::gemm_phase(lds, g, S, E);
}

__global__ void __launch_bounds__(512, 2) mega(Params P) {
    extern __shared__ __attribute__((aligned(16))) unsigned char smem[];
    LAS unsigned char* lds = (LAS unsigned char*)smem;
    cg::grid_group grid = cg::this_grid();
    volatile LAS unsigned* xst = (volatile LAS unsigned*)(lds + pg8::STAGE_BYTES);
    if (threadIdx.x == 0) { xst[0] = 0u; xst[1] = 0u; }
    __syncthreads();
    const XcdBarrier xb = xcd_barrier_post((unsigned*)(P.ws + O_BAR), xst);
    if (P.ws == nullptr) grid.sync();

    PH_BEGIN(0) phase_convert(P, gtid, gth); PH_END
    PH_BEGIN(1) run_ffn_in(lds, (const u16*)(ws + O_XB), (const u16*)(ws + O_W1T), (u16*)(ws + O_HID), bid); PH_END
    PH_BEGIN(2) run_res(lds, (const u16*)(ws + O_HID), (const u16*)(ws + O_W2T), FF, (u16*)(ws + O_PRE), P.in[0], nullptr, 0.5f, bid, 1); PH_END
    PH_BEGIN(3) phase_ln((const u16*)(ws + O_PRE), P.in[3], P.in[4], (u16*)(ws + O_H), nullptr, gw, ngw, lane); PH_END
    PH_BEGIN(4) run_mix(lds, ws, dout, 0, 7, bid); PH_END
    PH_BEGIN(5) phase_lora_prep((const u16*)dout, P.in[8], (u16*)(ws + O_ALORA), gtid, gth); PH_END
    PH_BEGIN(6) {
        pg8::Gemm g{(const u16*)(ws + O_ALORA), (const u16*)(ws + O_WLT), 256, 256, 256};
        pg8::StaticOrder S; S.init(MTOK, 1536, gridDim.x, bid);
        EpiLora E{(_Float16*)(ws + O_WBUF), (_Float16*)(ws + O_ABUF), (_Float16*)(ws + O_GBUF), P.in[9], P.in[11]};
        pg8::gemm_phase(lds, g, S, E);
    } PH_END
    PH_BEGIN(8) phase_scan(lds, (const u16*)dout, (const _Float16*)(ws + O_WBUF), (const _Float16*)(ws + O_ABUF), P.in[8], P.in[14], P.in[15], (float*)(ws + O_YRAW), tid, bid); PH_END
    PH_BEGIN(9) phase_rwkv_out((const float*)(ws + O_YRAW), (const u16*)dout, (const _Float16*)(ws + O_ABUF), (const _Float16*)(ws + O_GBUF), P.in[8], P.in[14], P.in[15], P.in[16], P.in[17], P.in[18], (u16*)(ws + O_Y), gtid, gth); PH_END
    PH_BEGIN(10) run_mix(lds, ws, dout, 7, 20, bid); PH_END
    PH_BEGIN(11) phase_r1(lds, (const u16*)(ws + O_VT), (const u16*)(ws + O_KTZ), (u16*)(ws + O_RT), wid, lane, bid); PH_END
    PH_BEGIN(12) phase_r2((u16*)(ws + O_RT), gtid, gth); PH_END
    PH_BEGIN(13) phase_r3(lds, (const u16*)(ws + O_QROT), (const u16*)(ws + O_KROT), (const u16*)(ws + O_VT), (const u16*)(ws + O_RT), (const u16*)(ws + O_GSILU), (u16*)(ws + O_Y) + 512, wid, lane, bid); PH_END
    PH_BEGIN(15) {
        pg8::Gemm g{(const u16*)(ws + O_Y), (const u16*)(ws + O_WBR), 1536, 1536, 1536};
        pg8::StaticOrder S; S.init(MTOK, DM, gridDim.x, bid);
        EpiBr E{(const u16*)dout, (u16*)(ws + O_MERGED)};
        pg8::gemm_phase<EpiBr, true>(lds, g, S, E, 512);
    } PH_END
    PH_BEGIN(17) run_res(lds, (const u16*)(ws + O_MERGED), (const u16*)(ws + O_WMO), DM, (u16*)(ws + O_PRE), nullptr, (const u16*)(ws + O_H), 1.0f, bid); PH_END
    PH_BEGIN(18) phase_ln((const u16*)(ws + O_PRE), P.in[22], P.in[23], (u16*)(ws + O_H), nullptr, gw, ngw, lane); PH_END
    PH_BEGIN(19) run_ffn_in(lds, (const u16*)(ws + O_H), (const u16*)(ws + O_W3T), (u16*)(ws + O_HID), bid); PH_END
    PH_BEGIN(20) run_res(lds, (const u16*)(ws + O_HID), (const u16*)(ws + O_W4T), FF, (u16*)(ws + O_PRE), nullptr, (const u16*)(ws + O_H), 0.5f, bid, 1); PH_END
    PH_BEGIN(21) phase_ln((const u16*)(ws + O_PRE), P.in[26], P.in[27], (u16*)(ws + O_H), dout, gw, ngw, lane);
        run_fin(lds, (const u16*)(ws + O_PB), (const u16*)(ws + O_WPT), 256, 0, dout, (u16*)(ws + O_PPROJ), bid); PH_END
    PH_BEGIN(23) run_fin(lds, (const u16*)(ws + O_H), (const u16*)(ws + O_WGT), DM, 1, dout, (u16*)(ws + O_PPROJ), bid); PH_END
}

constexpr int LDS_BYTES = pg8::STAGE_BYTES + 16;

extern "C" void kernel_launch(void* const* d_in, const int* in_sizes, int n_in, void* d_out, int out_size, void* d_ws, size_t ws_size, hipStream_t stream) {
    static int grid = 0;
    if (grid == 0) {
        if (n_in != 30 || out_size != MTOK * DM || ws_size < WS_NEED) { fprintf(stderr, "kernel_launch: unexpected shapes (n_in %d out %d ws %zu)\n", n_in, out_size, ws_size); grid = -1; return; }
        int dev = 0, cus = 0, per_cu = 0;
        (void)hipGetDevice(&dev); (void)hipDeviceGetAttribute(&cus, hipDeviceAttributeMultiprocessorCount, dev);
        if (hipFuncSetAttribute((const void*)mega, hipFuncAttributeMaxDynamicSharedMemorySize, LDS_BYTES) != hipSuccess) { fprintf(stderr, "kernel_launch: hipFuncSetAttribute failed\n"); grid = -1; return; }
        (void)hipOccupancyMaxActiveBlocksPerMultiprocessor(&per_cu, (const void*)mega, 512, LDS_BYTES);
        (void)hipGetLastError();
        if (cus != 256 || per_cu < 1) { fprintf(stderr, "kernel_launch: needs 256 CUs with one resident workgroup each (cus %d per_cu %d)\n", cus, per_cu); grid = -1; return; }
        grid = 256;
    }
    if (grid < 0) return;
    if (hipMemsetAsync((char*)d_ws + O_BAR, 0, XCD_BAR_WORDS * 4, stream) != hipSuccess) { fprintf(stderr, "kernel_launch: memset of barrier words failed\n"); return; }
    Params p{};
    for (int i = 0; i < 30; ++i) p.in[i] = (const float*)d_in[i];
    p.out = (float*)d_out; p.ws = (unsigned char*)d_ws;
    void* args[] = {&p};
    hipError_t e = hipLaunchCooperativeKernel((const void*)mega, dim3(grid), dim3(512), args, LDS_BYTES, stream);
    if (e != hipSuccess) fprintf(stderr, "cooperative launch failed: %s\n", hipGetErrorString(e));
}
```
